# Optimizing an MI355X kernel written in HIP

```python
import jax, jax.numpy as jnp
from jax import lax
import numpy as np

D_MODEL = 1024
BATCH = 8
SEQ = 2048
DEPTH = 1

D_MIX = D_MODEL
D_ATTN = D_MIX // 2
D_POOL = D_MIX - D_ATTN
HEAD_DIM = 64
N_HEADS = D_ATTN // HEAD_DIM
POOL_WINDOWS = (2, 4, 8, 16)
N_POOL_GROUPS = len(POOL_WINDOWS)
POOL_GROUP_DIM = D_POOL // N_POOL_GROUPS
Q_BLOCK = 128
EPS = 1e-6
D_IN = 4 * D_ATTN + 2 * D_POOL

kernel_name = "stickbreak_pool_hybrid_block"


def rms_norm(x, g):
    xf = x.astype(jnp.float32)
    y = xf * lax.rsqrt(jnp.mean(xf * xf, axis=-1, keepdims=True) + EPS)
    return (y * g.astype(jnp.float32)).astype(x.dtype)


def stick_breaking_attention(q, k, v):
    B, H, S, Dh = q.shape
    nb = S // Q_BLOCK
    qf = q.astype(jnp.float32) * (Dh ** -0.5)
    kb = k.astype(jnp.float32).reshape(B, H, nb, Q_BLOCK, Dh).transpose(2, 0, 1, 3, 4)
    vb = v.astype(jnp.float32).reshape(B, H, nb, Q_BLOCK, Dh).transpose(2, 0, 1, 3, 4)
    offs = jnp.arange(Q_BLOCK, dtype=jnp.int32)
    outs = []
    for i in range(nb):
        q_i = qf[:, :, i * Q_BLOCK:(i + 1) * Q_BLOCK]
        q_pos = i * Q_BLOCK + offs

        def step(carry, xs, q_i=q_i, q_pos=q_pos):
            acc, log_rem = carry
            k_j, v_j, j = xs
            k_pos = j * Q_BLOCK + offs
            mask = k_pos[None, :] < q_pos[:, None]
            z = jnp.einsum('bhqd,bhkd->bhqk', q_i, k_j)
            log_one_minus = jnp.where(mask, jax.nn.log_sigmoid(-z), 0.0)
            later = lax.cumsum(log_one_minus, axis=3, reverse=True) - log_one_minus
            log_w = jax.nn.log_sigmoid(z) + later + log_rem
            w = jnp.where(mask, jnp.exp(log_w), 0.0)
            acc = acc + jnp.einsum('bhqk,bhkd->bhqd', w, v_j)
            log_rem = log_rem + jnp.sum(log_one_minus, axis=3, keepdims=True)
            return (acc, log_rem), None

        idx = jnp.arange(i, -1, -1, dtype=jnp.int32)
        init = (jnp.zeros((B, H, Q_BLOCK, Dh), jnp.float32),
                jnp.zeros((B, H, Q_BLOCK, 1), jnp.float32))
        (acc, _), _ = lax.scan(step, init, (kb[idx], vb[idx], idx))
        outs.append(acc)
    return jnp.concatenate(outs, axis=2).astype(v.dtype)


def multiscale_causal_pool(u):
    B, S, _ = u.shape
    uf = u.astype(jnp.float32).reshape(B, S, N_POOL_GROUPS, POOL_GROUP_DIM)
    cs = jnp.concatenate([jnp.zeros((B, 1, N_POOL_GROUPS, POOL_GROUP_DIM), jnp.float32),
                          jnp.cumsum(uf, axis=1)], axis=1)
    t = jnp.arange(S, dtype=jnp.int32)[:, None]
    win = jnp.array(POOL_WINDOWS, dtype=jnp.int32)[None, :]
    lo = jnp.maximum(t + 1 - win, 0)
    grp = jnp.arange(N_POOL_GROUPS, dtype=jnp.int32)[None, :]
    window_sum = cs[:, 1:] - cs[:, lo, grp]
    count = (t + 1 - lo).astype(jnp.float32)
    pooled = window_sum / count[None, :, :, None] - uf
    return pooled.astype(u.dtype)


def setup_inputs(seed: int = 0) -> dict:
    key = jax.random.key(seed)
    ks = jax.random.split(key, 14)
    L = DEPTH
    x = jax.random.normal(ks[0], (BATCH, SEQ, D_MODEL), jnp.float32)
    c = jax.random.normal(ks[1], (BATCH, D_MODEL), jnp.float32)
    w_ada = jax.random.normal(ks[2], (L, D_MODEL, 3 * D_MODEL), jnp.float32) * (0.5 * D_MODEL ** -0.5)
    b_ada = jax.random.normal(ks[3], (L, 3 * D_MODEL), jnp.float32) * 0.02
    norm_g = 1.0 + 0.02 * jax.random.normal(ks[4], (L, D_MODEL), jnp.float32)
    w_in = jax.random.normal(ks[5], (L, D_MODEL, D_IN), jnp.float32) * (D_MODEL ** -0.5)
    q_norm_g = 1.0 + 0.02 * jax.random.normal(ks[6], (L, HEAD_DIM), jnp.float32)
    k_norm_g = 1.0 + 0.02 * jax.random.normal(ks[7], (L, HEAD_DIM), jnp.float32)
    w_pool = jax.random.normal(ks[8], (L, N_POOL_GROUPS, POOL_GROUP_DIM, POOL_GROUP_DIM), jnp.float32) * (POOL_GROUP_DIM ** -0.5)
    b_pool = jax.random.normal(ks[9], (L, N_POOL_GROUPS, POOL_GROUP_DIM), jnp.float32) * 0.02
    pool_scale = 1.0 + 0.1 * jax.random.normal(ks[10], (L, D_POOL), jnp.float32)
    w_out = jax.random.normal(ks[11], (L, D_MIX, D_MODEL), jnp.float32) * (D_MIX ** -0.5)
    return {"x": x, "c": c, "w_ada": w_ada, "b_ada": b_ada, "norm_g": norm_g,
            "w_in": w_in, "q_norm_g": q_norm_g, "k_norm_g": k_norm_g,
            "w_pool": w_pool, "b_pool": b_pool, "pool_scale": pool_scale, "w_out": w_out}


def reference(x, c, w_ada, b_ada, norm_g, w_in, q_norm_g, k_norm_g,
              w_pool, b_pool, pool_scale, w_out):
    B, S, D = x.shape
    h = x
    c_act = jax.nn.silu(c)
    for l in range(DEPTH):
        mod = c_act @ w_ada[l] + b_ada[l]
        shift, scale, gate = jnp.split(mod, 3, axis=-1)
        hn = rms_norm(h, norm_g[l]) * (1.0 + scale[:, None, :]) + shift[:, None, :]

        proj = hn @ w_in[l]
        q, k, v, g_attn, u, g_pool = jnp.split(
            proj, [D_ATTN, 2 * D_ATTN, 3 * D_ATTN, 4 * D_ATTN, 4 * D_ATTN + D_POOL], axis=-1)

        q = rms_norm(q.reshape(B, S, N_HEADS, HEAD_DIM), q_norm_g[l]).transpose(0, 2, 1, 3)
        k = rms_norm(k.reshape(B, S, N_HEADS, HEAD_DIM), k_norm_g[l]).transpose(0, 2, 1, 3)
        v = v.reshape(B, S, N_HEADS, HEAD_DIM).transpose(0, 2, 1, 3)
        attn = stick_breaking_attention(q, k, v).transpose(0, 2, 1, 3).reshape(B, S, D_ATTN)
        attn = attn * jax.nn.silu(g_attn)

        pooled = multiscale_causal_pool(u)
        pooled = jnp.einsum('bsgc,gcd->bsgd', pooled, w_pool[l]) + b_pool[l]
        pool_out = pooled.reshape(B, S, D_POOL) * pool_scale[l]
        pool_out = pool_out * jax.nn.silu(g_pool)

        y = jnp.concatenate([attn, pool_out], axis=-1) @ w_out[l]
        h = h + gate[:, None, :] * y
    return h
```

```cpp
#include <hip/hip_runtime.h>
#include <hip/hip_cooperative_groups.h>
#include <cstdio>
#include <cstdint>
namespace cg = cooperative_groups;
#ifndef MK_COOP
#define MK_COOP 0
#endif
#ifndef MK_EARLY
#define MK_EARLY false
#endif
#define PG8_SP2 true
#define PG8_ALIGN true
namespace pg8 {
#define PG8_LAS __attribute__((address_space(3)))
typedef unsigned short bf16_t;
typedef short bf16x8 __attribute__((ext_vector_type(8)));
typedef float f32x4 __attribute__((ext_vector_type(4)));
typedef unsigned u32x4 __attribute__((ext_vector_type(4)));
constexpr int BM = 256, BK = 64, HALF = 128, HTB = HALF * BK * 2  , STAGE_BYTES = 8 * HTB, NXCD = 8, WGM = 8;

__host__ __device__ __forceinline__ int lds_byte(int r, int c) { const int st = (r >> 4) * 2 + (c >> 5), rr = r & 15, cc = c & 31, ob = rr * 64 + cc * 2; return st * 1024 + (ob ^ (((ob >> 9) & 1) << 5)); }
__host__ __device__ __forceinline__ void stage_rc(int b, int& R, int& C) { const int st = b / 1024, sb = b % 1024, swz = sb ^ (((sb >> 9) & 1) << 5); R = (st >> 1) * 16 + swz / 64; C = (st & 1) * 32 + (swz % 64) / 2; }
__host__ __device__ __forceinline__ int perm32(int rho) { const int n = rho >> 4, i = rho & 15; return 8 * (i >> 2) + 4 * n + (i & 3); }

struct Unit { int pm, pn; };
struct Gemm { const bf16_t* A; const bf16_t* Bt; int M, N, K; };

struct StaticOrder {
    int nM, nN, nwg, G, c;
    __host__ __device__ void init(int M, int N, int G_, int c_) { nM = M / BM; nN = N / BM; nwg = nM * nN; G = G_; c = c_; }
    __host__ __device__ bool next(int i, Unit& u) const {
        const long L = (long)i * G + c; if (L >= nwg) return false;
        int wgid = (int)L; { const int q = nwg / NXCD, r = nwg % NXCD, xcd = wgid % NXCD, off = wgid / NXCD; wgid = (xcd < r ? xcd * (q + 1) : r * (q + 1) + (xcd - r) * q) + off; }
        const int nig = WGM * nN, gid = wgid / nig, fm = gid * WGM, gsz = (nM - fm) < WGM ? (nM - fm) : WGM;
        u.pm = fm + ((wgid % nig) % gsz); u.pn = (wgid % nig) / gsz; return true;
    }
    __device__ __forceinline__ void a_ready(const Unit&) const {}
    __device__ __forceinline__ void done(const Unit&) const {}
};
__device__ __forceinline__ unsigned cvt_pk_bf16(float lo, float hi) { unsigned r; asm volatile("v_cvt_pk_bf16_f32 %0, %1, %2" : "=v"(r) : "v"(lo), "v"(hi)); return r; }
typedef float f32x2 __attribute__((ext_vector_type(2)));
__device__ __forceinline__ float silu_f(float v) { return v * __builtin_amdgcn_rcpf(1.0f + __builtin_amdgcn_exp2f(-1.4426950408889634f * v)); }
constexpr float QSCALE = 0.125f * 1.4426950408889634f;
struct EpiInProj {
    static constexpr bool PERM = true, AFTER_DRAIN = false;
    bf16_t* base; size_t stride; const float* gq; const float* gk;
    __device__ __forceinline__ void operator()(const f32x4 (&acc)[2][2][4][2], const Unit& u, int wr, int wc, int fr, int fq) const {
        const int type = u.pn >> 1;
        bf16_t* O = base + (size_t)type * stride;
        const int row0 = u.pm * BM + wr * 64 + fr;
        const int col0 = (u.pn & 1) * 256 + wc * 64 + 8 * fq;
        if (type < 2) {
            const float* g = type == 0 ? gq : gk; const float s = type == 0 ? QSCALE : 1.0f;
            f32x4 gs[2][2];
#pragma unroll
            for (int bj = 0; bj < 2; ++bj)
#pragma unroll
                for (int n = 0; n < 2; ++n) gs[bj][n] = *(const f32x4*)(g + 32 * bj + 8 * fq + 4 * n) * s;
#pragma unroll
            for (int ai = 0; ai < 2; ++ai)
#pragma unroll
                for (int m = 0; m < 4; ++m) {
                    float ss = 0.f;
#pragma unroll
                    for (int bj = 0; bj < 2; ++bj)
#pragma unroll
                        for (int n = 0; n < 2; ++n) { const f32x4 x = acc[ai][bj][m][n]; ss += (x[0] * x[0] + x[1] * x[1]) + (x[2] * x[2] + x[3] * x[3]); }
                    ss += __shfl_xor(ss, 16); ss += __shfl_xor(ss, 32);
                    const float inv = 1.0f / sqrtf(ss * (1.0f / 64.0f) + 1e-6f);
                    bf16_t* rowp = O + (size_t)(row0 + ai * HALF + m * 16) * 512 + col0;
#pragma unroll
                    for (int bj = 0; bj < 2; ++bj) { const f32x4 v0 = acc[ai][bj][m][0] * inv * gs[bj][0], v1 = acc[ai][bj][m][1] * inv * gs[bj][1];
                        u32x4 w; w.x = cvt_pk_bf16(v0[0], v0[1]); w.y = cvt_pk_bf16(v0[2], v0[3]); w.z = cvt_pk_bf16(v1[0], v1[1]); w.w = cvt_pk_bf16(v1[2], v1[3]);
                        *(u32x4*)(rowp + bj * 32) = w; }
                }
        } else {
            const bool act = (type == 3) || (type == 5);
#pragma unroll
            for (int ai = 0; ai < 2; ++ai)
#pragma unroll
                for (int m = 0; m < 4; ++m) {
                    bf16_t* rowp = O + (size_t)(row0 + ai * HALF + m * 16) * 512 + col0;
#pragma unroll
                    for (int bj = 0; bj < 2; ++bj) { f32x4 v0 = acc[ai][bj][m][0], v1 = acc[ai][bj][m][1];
                        if (act) { v0 = (f32x4){silu_f(v0[0]), silu_f(v0[1]), silu_f(v0[2]), silu_f(v0[3])}; v1 = (f32x4){silu_f(v1[0]), silu_f(v1[1]), silu_f(v1[2]), silu_f(v1[3])}; }
                        u32x4 w; w.x = cvt_pk_bf16(v0[0], v0[1]); w.y = cvt_pk_bf16(v0[2], v0[3]); w.z = cvt_pk_bf16(v1[0], v1[1]); w.w = cvt_pk_bf16(v1[2], v1[3]);
                        *(u32x4*)(rowp + bj * 32) = w; }
                }
        }
    }
};
struct EpiOutRes {
    static constexpr bool PERM = false, AFTER_DRAIN = false;
    const float* x; float* out; const float* gate;
    __device__ __forceinline__ void operator()(const f32x4 (&acc)[2][2][4][2], const Unit& u, int wr, int wc, int fr, int fq) const {
        const int col0 = u.pn * BM + wc * 32 + 4 * fq;
        const float* gp = gate + (size_t)((u.pm * BM) >> 11) * 3072 + col0;
        f32x4 gv[2][2];
#pragma unroll
        for (int bj = 0; bj < 2; ++bj)
#pragma unroll
            for (int n = 0; n < 2; ++n) gv[bj][n] = *(const f32x4*)(gp + bj * HALF + n * 16);
#pragma unroll
        for (int ai = 0; ai < 2; ++ai)
#pragma unroll
            for (int m = 0; m < 4; ++m) { const size_t off = (size_t)(u.pm * BM + ai * HALF + wr * 64 + m * 16 + fr) * 1024 + col0;
#pragma unroll
                for (int bj = 0; bj < 2; ++bj)
#pragma unroll
                    for (int n = 0; n < 2; ++n) { const f32x4 xv = *(const f32x4*)(x + off + bj * HALF + n * 16);
                        *(f32x4*)(out + off + bj * HALF + n * 16) = xv + gv[bj][n] * acc[ai][bj][m][n]; } }
    }
};
template <class Epi, class Sched, bool ALIGN_EPI = false, bool SP2 = false>
__device__ __forceinline__ void gemm_phase(PG8_LAS unsigned char* lds, const Gemm g, const Sched& S, const Epi& E) {
    const int tid = threadIdx.x, wid = __builtin_amdgcn_readfirstlane(tid >> 6), lane = tid & 63, wr = wid >> 2, wc = wid & 3, fr = lane & 15, fq = lane >> 4;
    const int K = g.K, nt = K / BK;
    unsigned voffA[2], voffB[2];
#pragma unroll
    for (int i = 0; i < 2; ++i) { int R, C; stage_rc(tid * 16 + i * 8192, R, C); const int Rb = Epi::PERM ? ((R & ~31) + perm32(R & 31)) : R;
        voffA[i] = (unsigned)(R * K + C) * 2u; voffB[i] = (unsigned)(Rb * K + C) * 2u; }
    const size_t kstep = (size_t)(BK * 2);
    const size_t hstep = (size_t)HALF * K * 2;
    const size_t tstep = 2 * hstep;
    const unsigned ldsw = (unsigned)wid * 1024u;
    const int aoff = lds_byte(wr * 64 + fr, fq * 8), boff = lds_byte(wc * 32 + fr, fq * 8);
#define PG8_SA(b, h) (((b) * 2 + (h)) * HTB)
#define PG8_SB(b, h) ((4 + (b) * 2 + (h)) * HTB)
#define PG8_STAGE(bufoff, gbase, voff) do { _Pragma("unroll") for (int _i = 0; _i < 2; ++_i) \
        __builtin_amdgcn_global_load_lds((const unsigned*)((const char*)(gbase) + (voff)[_i]), (PG8_LAS unsigned*)(lds + (bufoff) + ldsw + _i * 8192), 16, 0, 0); } while (0)
#define PG8_LDA(dst, b, h) do { _Pragma("unroll") for (int m = 0; m < 4; ++m) _Pragma("unroll") for (int k = 0; k < 2; ++k) dst[m][k] = *(const PG8_LAS bf16x8*)(lds + PG8_SA(b, h) + aoff + m * 2048 + k * 1024); } while (0)
#define PG8_LDB(dst, b, h) do { _Pragma("unroll") for (int n = 0; n < 2; ++n) _Pragma("unroll") for (int k = 0; k < 2; ++k) dst[n][k] = *(const PG8_LAS bf16x8*)(lds + PG8_SB(b, h) + boff + n * 2048 + k * 1024); } while (0)
#define PG8_MMA(ai, bj, At, Bt) do { __builtin_amdgcn_s_setprio(1); _Pragma("unroll") for (int m = 0; m < 4; ++m) _Pragma("unroll") for (int n = 0; n < 2; ++n) _Pragma("unroll") for (int k = 0; k < 2; ++k) \
        acc[ai][bj][m][n] = __builtin_amdgcn_mfma_f32_16x16x32_bf16(Bt[n][k], At[m][k], acc[ai][bj][m][n], 0, 0, 0); __builtin_amdgcn_s_setprio(0); } while (0)
#define PG8_WAIT_V(n) asm volatile("s_waitcnt vmcnt(" #n ")" ::: "memory")
#define PG8_WAIT_L(n) asm volatile("s_waitcnt lgkmcnt(" #n ")" ::: "memory")
#define PG8_BAR __builtin_amdgcn_s_barrier()
#define PG8_SCHED __builtin_amdgcn_sched_barrier(0)
    Unit cur, nxt; int ui = 0;
    if (!S.next(0, cur)) return;
    f32x4 acc[2][2][4][2];
#pragma unroll
    for (int a = 0; a < 2; ++a)
#pragma unroll
        for (int b = 0; b < 2; ++b)
#pragma unroll
            for (int m = 0; m < 4; ++m)
#pragma unroll
                for (int n = 0; n < 2; ++n) acc[a][b][m][n] = (f32x4){0.f, 0.f, 0.f, 0.f};
    bf16x8 At[4][2], B0[2][2], B1[2][2];
    const char* cA = (const char*)g.A + (size_t)cur.pm * tstep; const char* cB = (const char*)g.Bt + (size_t)cur.pn * tstep;
    S.a_ready(cur);
    if constexpr (SP2) {
        PG8_STAGE(PG8_SB(0, 0), cB, voffB); PG8_STAGE(PG8_SB(0, 1), cB + hstep, voffB); PG8_STAGE(PG8_SA(0, 0), cA, voffA); PG8_STAGE(PG8_SA(0, 1), cA + hstep, voffA);
        if (wr == 1) PG8_BAR;
        PG8_WAIT_V(2); PG8_BAR;
        PG8_STAGE(PG8_SB(1, 0), cB + kstep, voffB); PG8_STAGE(PG8_SA(1, 0), cA + kstep, voffA); PG8_STAGE(PG8_SB(1, 1), cB + hstep + kstep, voffB);
        PG8_WAIT_V(6); PG8_BAR;
    } else {
        PG8_STAGE(PG8_SB(0, 0), cB, voffB); PG8_STAGE(PG8_SA(0, 0), cA, voffA); PG8_STAGE(PG8_SB(0, 1), cB + hstep, voffB); PG8_STAGE(PG8_SA(0, 1), cA + hstep, voffA);
        if (wr == 1) PG8_BAR;
        PG8_WAIT_V(4); PG8_BAR;
        PG8_STAGE(PG8_SB(1, 0), cB + kstep, voffB); PG8_STAGE(PG8_SA(1, 0), cA + kstep, voffA); PG8_STAGE(PG8_SB(1, 1), cB + hstep + kstep, voffB);
        PG8_WAIT_V(6); PG8_BAR;
    }
    for (;;) {
        const bool has_next = S.next(ui + 1, nxt);
        const char* nA = has_next ? (const char*)g.A + (size_t)nxt.pm * tstep : cA; const char* nB = has_next ? (const char*)g.Bt + (size_t)nxt.pn * tstep : cB;
        for (int t = 0; t < nt; t += 2) {
            const bool last = (t == nt - 2);
            const char* a1 = cA + (size_t)(t + 1) * kstep;
            const char* a2 = last ? nA : cA + (size_t)(t + 2) * kstep; const char* b2 = last ? nB : cB + (size_t)(t + 2) * kstep;
            const char* a3 = a2 + kstep; const char* b3 = b2 + kstep;
            if (last && has_next) S.a_ready(nxt);
            if constexpr (SP2) {
            PG8_LDB(B0, 0, 0); PG8_LDB(B1, 0, 1); PG8_SCHED; PG8_LDA(At, 0, 0); PG8_STAGE(PG8_SA(1, 1), a1 + hstep, voffA);
            PG8_WAIT_V(8); PG8_WAIT_L(0); PG8_BAR; PG8_MMA(0, 0, At, B0); PG8_MMA(0, 1, At, B1); PG8_BAR; PG8_SCHED;
            PG8_LDA(At, 0, 1); PG8_STAGE(PG8_SB(0, 0), b2, voffB); PG8_STAGE(PG8_SB(0, 1), b2 + hstep, voffB); PG8_STAGE(PG8_SA(0, 0), a2, voffA);
            PG8_WAIT_V(8); PG8_WAIT_L(0); PG8_BAR; PG8_MMA(1, 0, At, B0); PG8_MMA(1, 1, At, B1); PG8_BAR; PG8_SCHED;
            PG8_LDB(B0, 1, 0); PG8_LDB(B1, 1, 1); PG8_SCHED; PG8_LDA(At, 1, 0); PG8_STAGE(PG8_SA(0, 1), a2 + hstep, voffA);
            PG8_WAIT_V(8); PG8_WAIT_L(0); PG8_BAR; PG8_MMA(0, 0, At, B0); PG8_MMA(0, 1, At, B1); PG8_BAR; PG8_SCHED;
            PG8_LDA(At, 1, 1); PG8_STAGE(PG8_SB(1, 0), b3, voffB); PG8_STAGE(PG8_SB(1, 1), b3 + hstep, voffB); PG8_STAGE(PG8_SA(1, 0), a3, voffA);
            PG8_WAIT_V(8); PG8_WAIT_L(0); PG8_BAR; PG8_MMA(1, 0, At, B0); PG8_MMA(1, 1, At, B1); PG8_BAR; PG8_SCHED;
            } else {
            PG8_LDB(B0, 0, 0); PG8_SCHED; PG8_LDA(At, 0, 0); PG8_STAGE(PG8_SA(1, 1), a1 + hstep, voffA);
            PG8_WAIT_L(8); PG8_BAR; PG8_WAIT_L(0); PG8_MMA(0, 0, At, B0); PG8_BAR; PG8_SCHED;
            PG8_LDB(B1, 0, 1); PG8_STAGE(PG8_SB(0, 0), b2, voffB);
            PG8_BAR; PG8_WAIT_L(0); PG8_MMA(0, 1, At, B1); PG8_BAR;
            PG8_LDA(At, 0, 1); PG8_STAGE(PG8_SA(0, 0), a2, voffA);
            PG8_BAR; PG8_WAIT_L(0); PG8_MMA(1, 0, At, B0); PG8_BAR; PG8_SCHED;
            PG8_STAGE(PG8_SB(0, 1), b2 + hstep, voffB);
            PG8_WAIT_V(6); PG8_BAR; PG8_MMA(1, 1, At, B1); PG8_BAR;
            PG8_LDB(B0, 1, 0); PG8_SCHED; PG8_LDA(At, 1, 0); PG8_STAGE(PG8_SA(0, 1), a2 + hstep, voffA);
            PG8_WAIT_L(8); PG8_BAR; PG8_WAIT_L(0); PG8_MMA(0, 0, At, B0); PG8_BAR; PG8_SCHED;
            PG8_LDB(B1, 1, 1); PG8_STAGE(PG8_SB(1, 0), b3, voffB);
            PG8_BAR; PG8_WAIT_L(0); PG8_MMA(0, 1, At, B1); PG8_BAR;
            PG8_LDA(At, 1, 1); PG8_STAGE(PG8_SA(1, 0), a3, voffA);
            PG8_BAR; PG8_WAIT_L(0); PG8_MMA(1, 0, At, B0); PG8_BAR; PG8_SCHED;
            PG8_STAGE(PG8_SB(1, 1), b3 + hstep, voffB);
            PG8_WAIT_V(6); PG8_BAR; PG8_MMA(1, 1, At, B1); PG8_BAR;
            }
        }
        if constexpr (ALIGN_EPI) { if (wr == 0) PG8_BAR; }
        if constexpr (!Epi::AFTER_DRAIN) { E(acc, cur, wr, wc, fr, fq); S.done(cur); }
        if (!has_next) break;
#pragma unroll
        for (int a = 0; a < 2; ++a)
#pragma unroll
            for (int b = 0; b < 2; ++b)
#pragma unroll
                for (int m = 0; m < 4; ++m)
#pragma unroll
                    for (int n = 0; n < 2; ++n) acc[a][b][m][n] = (f32x4){0.f, 0.f, 0.f, 0.f};
        cur = nxt; cA = nA; cB = nB; ++ui;
        if constexpr (ALIGN_EPI) { if (wr == 1) PG8_BAR; }
    }
    PG8_WAIT_V(0);
    if constexpr (!ALIGN_EPI) { if (wr == 0) PG8_BAR; }
    PG8_BAR;
    if constexpr (Epi::AFTER_DRAIN) { E.fused(acc, cur, wr, wc, fr, fq, lds, wid, lane); S.done(cur); }
#undef PG8_SA
#undef PG8_SB
#undef PG8_STAGE
#undef PG8_LDA
#undef PG8_LDB
#undef PG8_MMA
#undef PG8_WAIT_V
#undef PG8_WAIT_L
#undef PG8_BAR
#undef PG8_SCHED
}
}

constexpr int NWAVES = 8;
constexpr int BATCH = 8, SEQ = 2048, DM = 1024, M = BATCH * SEQ, DIN = 3072, DH = 64, NH = 8, DA = 512;
constexpr size_t MiB = 1u << 20;
constexpr size_t WS_CTL = 0, CTL_ZERO_BYTES = 64 * 1024;
constexpr size_t WS_MOD = 1 * MiB;
constexpr size_t WS_WIN = 2 * MiB;
constexpr size_t WS_WOUT = 8 * MiB;
constexpr size_t WS_WPOOL = 10 * MiB;
constexpr size_t WS_XN = 16 * MiB;
constexpr size_t WS_PROJ = 48 * MiB;
constexpr size_t PROJ_STRIDE = (size_t)M * 512;
constexpr size_t WS_CAT = 144 * MiB;
constexpr size_t WS_END = 176 * MiB;
constexpr int RING_BYTES = 131072, MISC_OFF = RING_BYTES + 320, LDS_BYTES = 147456;
constexpr int CW_BAR = 1024;

#define GAS __attribute__((address_space(1)))
#define LAS __attribute__((address_space(3)))
typedef unsigned short bf16;
typedef unsigned v4u __attribute__((ext_vector_type(4)));
typedef unsigned v2u __attribute__((ext_vector_type(2)));
typedef float f32x4 __attribute__((ext_vector_type(4)));
typedef float f32x16 __attribute__((ext_vector_type(16)));
typedef short bf16x8 __attribute__((ext_vector_type(8)));
typedef short s16x4 __attribute__((ext_vector_type(4)));
#define LDS_WAIT() asm volatile("s_waitcnt lgkmcnt(0)" ::: "memory")
#define VM_WAIT() asm volatile("s_waitcnt vmcnt(0)" ::: "memory")
__device__ __forceinline__ unsigned pk2(float lo, float hi) { return pg8::cvt_pk_bf16(lo, hi); }
__device__ __forceinline__ float bf_lo(unsigned u) { return __builtin_bit_cast(float, u << 16); }
__device__ __forceinline__ float bf_hi(unsigned u) { return __builtin_bit_cast(float, u & 0xffff0000u); }

namespace att {
constexpr int PITCH = 512, QB = 256, KVBLK = 64, SLOTB = 8192, LDS_K = 0, LDS_V = 2 * SLOTB, LDS_FLAG = 4 * SLOTB;
#define ATT_WAIT_BAR() asm volatile("s_waitcnt vmcnt(0) lgkmcnt(0)\n\ts_barrier" ::: "memory")
__device__ __forceinline__ void glds16(const void* gsrc, unsigned lds_dst) { unsigned keep;
    asm volatile("s_mov_b32 %0, m0\n\ts_mov_b32 m0, %2\n\ts_nop 0\n\tglobal_load_lds_dwordx4 %1, off\n\ts_mov_b32 m0, %0" : "=&s"(keep) : "v"(gsrc), "s"(lds_dst) : "memory"); }
typedef short v4i16_t __attribute__((ext_vector_type(4)));
__device__ __forceinline__ s16x4 vtr(LAS const char* p) { return __builtin_bit_cast(s16x4, __builtin_amdgcn_ds_read_tr16_b64_v4i16((LAS v4i16_t*)p)); }

template <bool EARLY>
__device__ __forceinline__ void attn_unit(int b, int h, int qb, const bf16* Q, const bf16* K, const bf16* V, const bf16* GA, bf16* CAT, LAS char* shm) {
    const int tid = threadIdx.x, lane = tid & 63, r32 = lane & 31, hi = lane >> 5; const int wid = __builtin_amdgcn_readfirstlane(tid >> 6);
    const long rowbase = (long)b * SEQ; const int q0 = qb * QB;
    const bf16* Qw = Q + (rowbase + q0 + wid * 32) * PITCH + h * DH;
    const bf16* Kh = K + rowbase * PITCH + h * DH; const bf16* Vh = V + rowbase * PITCH + h * DH;
    const unsigned lds0 = (unsigned)(uintptr_t)shm;
    const bf16* ksrc = Kh + (long)lane * PITCH + wid * 8;
    const bf16* vsrc = Vh + (long)(16 * (wid & 3) + (lane >> 2)) * PITCH + (wid >> 2) * 32 + (lane & 3) * 8;
    const unsigned kdst = lds0 + LDS_K + wid * 1024, vdst = lds0 + LDS_V + wid * 1024;
#define DMA_KV(t, slot) do { glds16(ksrc + (long)(t) * KVBLK * PITCH, (unsigned)__builtin_amdgcn_readfirstlane(kdst + (slot) * SLOTB)); \
                             glds16(vsrc + (long)(t) * KVBLK * PITCH, (unsigned)__builtin_amdgcn_readfirstlane(vdst + (slot) * SLOTB)); } while (0)
    LAS const char* kp0 = shm + LDS_K + hi * 1024 + r32 * 16;
    LAS const char* vp0 = shm + LDS_V + ((lane >> 4) & 1) * 32 + (lane & 3) * 8 + (4 * hi + ((lane & 15) >> 2)) * 64;
    volatile LAS unsigned* flags = (volatile LAS unsigned*)(shm + LDS_FLAG);
    const int NT = (q0 + QB) / KVBLK;
    DMA_KV(NT - 1, 0);
    bf16x8 qr[4];
#pragma unroll
    for (int d0 = 0; d0 < 4; ++d0) qr[d0] = *reinterpret_cast<const bf16x8*>(&Qw[(long)r32 * PITCH + d0 * 16 + hi * 8]);
    f32x16 o[2]; o[0] = f32x16{}; o[1] = f32x16{};
    float carry = 1.0f;
    const int qwmin = q0 + wid * 32, qabs = qwmin + r32;
    if (EARLY) { if (tid < 16) flags[tid] = 0u; }
    int it = 0;
    for (int t = NT - 1; t >= 0; --t, ++it) {
        const int slot = it & 1;
        ATT_WAIT_BAR();
        if (EARLY) { bool alldead = true;
#pragma unroll
            for (int w = 0; w < 8; ++w) alldead = alldead && (flags[(slot ^ 1) * 8 + w] != 0u);
            if (it > 0 && alldead) break; }
        if (t > 0) DMA_KV(t - 1, slot ^ 1);
        const int kv0 = t * KVBLK;
        bool dead = false;
        if (EARLY) dead = __all(carry < 1e-30f);
        if (kv0 < qwmin + 31 && !dead) {
            LAS const char* kp = kp0 + slot * SLOTB;
            f32x16 p0 = f32x16{}, p1 = f32x16{};
#pragma unroll
            for (int d0 = 0; d0 < 4; ++d0) {
                const bf16x8 b0 = *(LAS const bf16x8*)(kp + d0 * 2048), b1 = *(LAS const bf16x8*)(kp + d0 * 2048 + 512);
                p0 = __builtin_amdgcn_mfma_f32_32x32x16_bf16(b0, qr[d0], p0, 0, 0, 0);
                p1 = __builtin_amdgcn_mfma_f32_32x32x16_bf16(b1, qr[d0], p1, 0, 0, 0);
            }
            const bool needmask = (kv0 + KVBLK - 1 >= qwmin);
            float G[8];
#pragma unroll
            for (int half = 0; half < 2; ++half) {
#pragma unroll
                for (int i = 0; i < 4; ++i) {
                    float rr[4], be[4];
#pragma unroll
                    for (int j = 0; j < 4; ++j) {
                        const float z = half ? p1[4 * i + j] : p0[4 * i + j];
                        const float e = __builtin_amdgcn_exp2f(z);
                        float rv = __builtin_amdgcn_rcpf(1.0f + e); float bv = e * rv;
                        if (needmask) { const int kv = kv0 + 32 * half + 8 * i + 4 * hi + j; if (kv >= qabs) { rv = 1.0f; bv = 0.0f; } }
                        rr[j] = rv; be[j] = bv;
                    }
                    const float s2 = rr[3], s1 = s2 * rr[2], s0 = s1 * rr[1];
                    G[half * 4 + i] = s0 * rr[0];
                    be[2] *= s2; be[1] *= s1; be[0] *= s0;
#pragma unroll
                    for (int j = 0; j < 4; ++j) { if (half) p1[4 * i + j] = be[j]; else p0[4 * i + j] = be[j]; }
                }
            }
            float F[8]; float run = carry;
#pragma unroll
            for (int p = 7; p >= 0; --p) {
                auto sw = __builtin_amdgcn_permlane32_swap(__float_as_uint(G[p]), __float_as_uint(G[p]), false, false);
                const float g0 = __uint_as_float(sw[0]), g1 = __uint_as_float(sw[1]);
                const float partner = hi ? 1.0f : g1;
                F[p] = run * partner;
                run = run * (g0 * g1);
            }
            carry = run;
            unsigned pw[4][4];
#pragma unroll
            for (int half = 0; half < 2; ++half)
#pragma unroll
                for (int i = 0; i < 4; ++i) {
                    const float f = F[half * 4 + i];
                    float w0, w1, w2, w3;
                    if (half) { w0 = p1[4 * i] * f; w1 = p1[4 * i + 1] * f; w2 = p1[4 * i + 2] * f; w3 = p1[4 * i + 3] * f; }
                    else      { w0 = p0[4 * i] * f; w1 = p0[4 * i + 1] * f; w2 = p0[4 * i + 2] * f; w3 = p0[4 * i + 3] * f; }
                    pw[2 * half + (i >> 1)][2 * (i & 1)] = pk2(w0, w1); pw[2 * half + (i >> 1)][2 * (i & 1) + 1] = pk2(w2, w3);
                }
            LAS const char* vp = vp0 + slot * SLOTB;
#pragma unroll
            for (int d0 = 0; d0 < 2; ++d0)
#pragma unroll
                for (int ks = 0; ks < 4; ++ks) {
                    const s16x4 lo = vtr(vp + d0 * 4096 + ks * 1024), hh = vtr(vp + d0 * 4096 + ks * 1024 + 512);
                    const bf16x8 vf = (bf16x8){lo[0], lo[1], lo[2], lo[3], hh[0], hh[1], hh[2], hh[3]};
                    const v4u pwv = (v4u){pw[ks][0], pw[ks][1], pw[ks][2], pw[ks][3]};
                    o[d0] = __builtin_amdgcn_mfma_f32_32x32x16_bf16(vf, __builtin_bit_cast(bf16x8, pwv), o[d0], 0, 0, 0);
                }
        }
        if (EARLY) { const bool dd = __all(carry < 1e-30f); if (lane == 0) flags[slot * 8 + wid] = dd ? 1u : 0u; }
    }
    const long tok = rowbase + qabs;
    const bf16* gap = GA + tok * PITCH + h * DH; bf16* op = CAT + tok * DM + h * DH;
#pragma unroll
    for (int d0 = 0; d0 < 2; ++d0)
#pragma unroll
        for (int i = 0; i < 4; ++i) { const int d = 32 * d0 + 8 * i + 4 * hi;
            const v2u g = *(const v2u*)(gap + d);
            v2u w; w.x = pk2(o[d0][4 * i] * bf_lo(g.x), o[d0][4 * i + 1] * bf_hi(g.x)); w.y = pk2(o[d0][4 * i + 2] * bf_lo(g.y), o[d0][4 * i + 3] * bf_hi(g.y));
            *(v2u*)(op + d) = w; }
    ATT_WAIT_BAR();
#undef DMA_KV
}
#undef ATT_WAIT_BAR
}

namespace pool {
constexpr int UP = 272;
__device__ __forceinline__ void pool_unit(int pm, int g, const bf16* U, const bf16* GP, const bf16* WpT, const float* bp, const float* ps, bf16* CAT, LAS char* shm) {
    const int tid = threadIdx.x, lane = tid & 63, r32 = lane & 31, hi = lane >> 5; const int wid = __builtin_amdgcn_readfirstlane(tid >> 6);
    const int t0 = pm * 256, tpos0 = t0 & (SEQ - 1);
    for (int c = tid; c < 271 * 16; c += NWAVES * 64) { const int row = c >> 4, ch = c & 15;
        v4u v = (v4u){0u, 0u, 0u, 0u};
        if (tpos0 - 15 + row >= 0) v = *(const v4u*)(U + (size_t)(t0 - 15 + row) * 512 + g * 128 + ch * 8);
        *(LAS v4u*)(shm + row * UP + ch * 16) = v; }
    __syncthreads();
    const int win = 2 << g;
    const int r = wid * 32 + r32, tpos = tpos0 + r;
    const float inv = 1.0f / (float)(tpos + 1 < win ? tpos + 1 : win);
    f32x16 acc[4]; acc[0] = f32x16{}; acc[1] = f32x16{}; acc[2] = f32x16{}; acc[3] = f32x16{};
    const bf16* wbase = WpT + (size_t)g * 16384 + (size_t)r32 * 128 + 8 * hi;
#pragma unroll 1
    for (int s = 0; s < 8; ++s) {
        LAS const char* up = shm + (r + 15) * UP + (16 * s + 8 * hi) * 2;
        const v4u ut = *(LAS const v4u*)up;
        float sum[8] = {bf_lo(ut.x), bf_hi(ut.x), bf_lo(ut.y), bf_hi(ut.y), bf_lo(ut.z), bf_hi(ut.z), bf_lo(ut.w), bf_hi(ut.w)};
        float tk[8];
#pragma unroll
        for (int j = 0; j < 8; ++j) tk[j] = sum[j];
        for (int i = 1; i < win; ++i) { const v4u v = *(LAS const v4u*)(up - i * UP);
            sum[0] += bf_lo(v.x); sum[1] += bf_hi(v.x); sum[2] += bf_lo(v.y); sum[3] += bf_hi(v.y); sum[4] += bf_lo(v.z); sum[5] += bf_hi(v.z); sum[6] += bf_lo(v.w); sum[7] += bf_hi(v.w); }
        v4u pf; pf.x = pk2(sum[0] * inv - tk[0], sum[1] * inv - tk[1]); pf.y = pk2(sum[2] * inv - tk[2], sum[3] * inv - tk[3]);
        pf.z = pk2(sum[4] * inv - tk[4], sum[5] * inv - tk[5]); pf.w = pk2(sum[6] * inv - tk[6], sum[7] * inv - tk[7]);
        const bf16x8 pfr = __builtin_bit_cast(bf16x8, pf);
#pragma unroll
        for (int n = 0; n < 4; ++n) { const bf16x8 wf = *(const bf16x8*)(wbase + (size_t)n * 32 * 128 + 16 * s);
            acc[n] = __builtin_amdgcn_mfma_f32_32x32x16_bf16(wf, pfr, acc[n], 0, 0, 0); }
    }
    const size_t tok = (size_t)t0 + r;
#pragma unroll
    for (int n = 0; n < 4; ++n)
#pragma unroll
        for (int i = 0; i < 4; ++i) { const int col = g * 128 + 32 * n + 8 * i + 4 * hi;
            const f32x4 bv = *(const f32x4*)(bp + col), sv = *(const f32x4*)(ps + col);
            const v2u gv = *(const v2u*)(GP + tok * 512 + col);
            v2u w; w.x = pk2((acc[n][4 * i] + bv[0]) * sv[0] * bf_lo(gv.x), (acc[n][4 * i + 1] + bv[1]) * sv[1] * bf_hi(gv.x));
            w.y = pk2((acc[n][4 * i + 2] + bv[2]) * sv[2] * bf_lo(gv.y), (acc[n][4 * i + 3] + bv[3]) * sv[3] * bf_hi(gv.y));
            *(v2u*)(CAT + tok * DM + 512 + col) = w; }
    __syncthreads();
}
}

__device__ __forceinline__ float wave_sum(float v) {
#pragma unroll
    for (int o = 1; o < 64; o <<= 1) v += __shfl_xor(v, o);
    return v;
}
template <bool PERMN>
__device__ __forceinline__ void p0_transpose_item(const float* W, int K, int N, bf16* WT, LAS float* scr, int item, int lane) {
    const int nblk = N / 32, kb = item / nblk, nb = item % nblk, k0 = 64 * kb, n0 = 32 * nb;
#pragma unroll 8
    for (int i = 0; i < 32; ++i) { const int kk = 2 * i + (lane >> 5); scr[kk * 33 + (lane & 31)] = W[(size_t)(k0 + kk) * N + n0 + (lane & 31)]; }
    LDS_WAIT(); asm volatile("" ::: "memory");
    const int c = lane & 7;
#pragma unroll
    for (int j = 0; j < 4; ++j) { const int n = (lane >> 3) + 8 * j; const LAS float* s = scr + (8 * c) * 33 + n;
        v4u o; o.x = pk2(s[0 * 33], s[1 * 33]); o.y = pk2(s[2 * 33], s[3 * 33]); o.z = pk2(s[4 * 33], s[5 * 33]); o.w = pk2(s[6 * 33], s[7 * 33]);
        int na = n0 + n;
        if (PERMN) na = (na & ~255) + 128 * ((na >> 5) & 1) + 32 * ((na >> 6) & 3) + (na & 31);
        *(GAS v4u*)(WT + (size_t)na * K + k0 + 8 * c) = o; }
    LDS_WAIT(); asm volatile("" ::: "memory");
}

struct Args { const float* in[12]; float* out; unsigned char* ws; int ph_lo, ph_hi; int coop, pad; };
constexpr int N_PHASES = 5;

__global__ void __launch_bounds__(NWAVES * 64, 2) hybrid_fwd(Args args) {
    extern __shared__ __attribute__((aligned(16))) unsigned char lds[];
    LAS unsigned char* L = (LAS unsigned char*)lds;
    const int tid = threadIdx.x, lane = tid & 63, wave = __builtin_amdgcn_readfirstlane(tid >> 6);
    const int G = gridDim.x, bx = blockIdx.x;
    const int vcu = (G % 8 == 0) ? (bx % 8) * (G / 8) + bx / 8 : bx;
    const float* x = args.in[0]; const float* c = args.in[1]; const float* w_ada = args.in[2]; const float* b_ada = args.in[3]; const float* norm_g = args.in[4];
    const float* w_in = args.in[5]; const float* qg = args.in[6]; const float* kg = args.in[7]; const float* w_pool = args.in[8]; const float* b_pool = args.in[9];
    const float* pool_scale = args.in[10]; const float* w_out = args.in[11];
    unsigned char* ws = args.ws;
    float* mod = (float*)(ws + WS_MOD);
    bf16* Win_t = (bf16*)(ws + WS_WIN); bf16* Wout_t = (bf16*)(ws + WS_WOUT); bf16* WpT = (bf16*)(ws + WS_WPOOL);
    bf16* XN = (bf16*)(ws + WS_XN); bf16* PROJ = (bf16*)(ws + WS_PROJ); bf16* CAT = (bf16*)(ws + WS_CAT);
    const int lo = args.ph_lo, hi = args.ph_hi;
#define IN(k) (lo <= (k) && (k) < hi)
#define BOTH(k) (IN(k) && IN((k) + 1))
#if MK_COOP
#define GRID_BAR() do { cg::this_grid().sync(); } while (0)
#else
#define GRID_BAR() do { } while (0)
#endif
    const int gw = vcu * NWAVES + wave, NGW = G * NWAVES;

    if (IN(0)) {
        LAS float* cact = (LAS float*)L;
        LAS float* red = (LAS float*)(L + 32768);
        for (int i = tid; i < BATCH * DM; i += NWAVES * 64) { const float v = c[i]; cact[i] = v / (1.0f + __expf(-v)); }
        __syncthreads();
        for (int cgp = bx; cgp < 256; cgp += G) {
            const int kq = tid >> 2, cq = tid & 3;
            float a[8][3];
#pragma unroll
            for (int b = 0; b < 8; ++b) { a[b][0] = 0.f; a[b][1] = 0.f; a[b][2] = 0.f; }
#pragma unroll
            for (int kk = 0; kk < 8; ++kk) { const int k = kq * 8 + kk; const float* wr = w_ada + (size_t)k * DIN + cgp * 12 + cq * 3;
                const float w0 = wr[0], w1 = wr[1], w2 = wr[2];
#pragma unroll
                for (int b = 0; b < 8; ++b) { const float ca = cact[b * DM + k]; a[b][0] += ca * w0; a[b][1] += ca * w1; a[b][2] += ca * w2; } }
#pragma unroll
            for (int b = 0; b < 8; ++b)
#pragma unroll
                for (int j = 0; j < 3; ++j) { float v = a[b][j]; v += __shfl_xor(v, 4); v += __shfl_xor(v, 8); v += __shfl_xor(v, 16); v += __shfl_xor(v, 32);
                    if (lane < 4) red[wave * 96 + b * 12 + cq * 3 + j] = v; }
            __syncthreads();
            if (tid < 96) { float s = 0.f;
#pragma unroll
                for (int w = 0; w < 8; ++w) s += red[w * 96 + tid];
                const int b = tid / 12, n = cgp * 12 + tid % 12; mod[b * DIN + n] = s + b_ada[n]; }
            __syncthreads();
        }
        LAS float* scr = (LAS float*)(L + wave * 16384);
        constexpr int I_IN = (DM / 64) * (DIN / 32), I_OUT = (DM / 64) * (DM / 32), I_P = 4 * (128 / 64) * (128 / 32);
        for (int it = gw; it < I_IN + I_OUT + I_P; it += NGW) {
            int r = it;
            if (r < I_IN) { p0_transpose_item<true>(w_in, DM, DIN, Win_t, scr, r, lane); continue; } r -= I_IN;
            if (r < I_OUT) { p0_transpose_item<false>(w_out, DM, DM, Wout_t, scr, r, lane); continue; } r -= I_OUT;
            const int g = r >> 3; p0_transpose_item<false>(w_pool + (size_t)g * 16384, 128, 128, WpT + (size_t)g * 16384, scr, r & 7, lane);
        }
        if (BOTH(0)) GRID_BAR();
    }
    if (IN(1)) {
        for (int m = gw; m < M; m += NGW) {
            const float* mb = mod + (size_t)(m >> 11) * DIN;
            const GAS f32x4* xr = (const GAS f32x4*)(x + (size_t)m * DM) + lane;
            f32x4 v[4]; float s = 0.f;
#pragma unroll
            for (int j = 0; j < 4; ++j) { v[j] = xr[64 * j]; s += (v[j].x * v[j].x + v[j].y * v[j].y) + (v[j].z * v[j].z + v[j].w * v[j].w); }
            const float inv = 1.0f / sqrtf(wave_sum(s) * (1.0f / DM) + 1e-6f);
            GAS unsigned long long* o8 = (GAS unsigned long long*)(XN + (size_t)m * DM) + lane;
#pragma unroll
            for (int j = 0; j < 4; ++j) { const int k = 4 * lane + 256 * j;
                const f32x4 gg = *(const f32x4*)(norm_g + k), sh = *(const f32x4*)(mb + k), sc = *(const f32x4*)(mb + DM + k);
                const f32x4 y = v[j] * inv * gg * (sc + 1.0f) + sh;
                o8[64 * j] = (unsigned long long)pk2(y.x, y.y) | ((unsigned long long)pk2(y.z, y.w) << 32); }
        }
        if (BOTH(1)) GRID_BAR();
    }
    if (IN(2)) {
        pg8::Gemm g{XN, Win_t, M, DIN, DM}; pg8::StaticOrder S; S.init(M, DIN, G, bx);
        pg8::EpiInProj E{PROJ, PROJ_STRIDE, qg, kg};
        pg8::gemm_phase<pg8::EpiInProj, pg8::StaticOrder, true, true>(L, g, S, E);
        if (BOTH(2)) GRID_BAR();
    }
    if (IN(3)) {
        const bf16* Qb = PROJ; const bf16* Kb = PROJ + PROJ_STRIDE; const bf16* Vb = PROJ + 2 * PROJ_STRIDE; const bf16* GAb = PROJ + 3 * PROJ_STRIDE;
        const bf16* Ub = PROJ + 4 * PROJ_STRIDE; const bf16* GPb = PROJ + 5 * PROJ_STRIDE;
        for (int i = vcu; i < 256; i += G) {
            const int bh = i >> 2, s = i & 3;
            att::attn_unit<MK_EARLY>(bh >> 3, bh & 7, 7 - s, Qb, Kb, Vb, GAb, CAT, (LAS char*)L);
            att::attn_unit<MK_EARLY>(bh >> 3, bh & 7, s, Qb, Kb, Vb, GAb, CAT, (LAS char*)L);
            pool::pool_unit(i >> 2, i & 3, Ub, GPb, WpT, b_pool, pool_scale, CAT, (LAS char*)L);
        }
        if (BOTH(3)) GRID_BAR();
    }
    if (IN(4)) {
        pg8::Gemm g{CAT, Wout_t, M, DM, DM}; pg8::StaticOrder S; S.init(M, DM, G, bx);
        pg8::EpiOutRes E{x, args.out, mod + 2 * DM};
        pg8::gemm_phase<pg8::EpiOutRes, pg8::StaticOrder, true, true>(L, g, S, E);
    }
#undef IN
#undef BOTH
}

extern "C" void kernel_launch(void* const* d_in, const int* in_sizes, int n_in, void* d_out, int out_size, void* d_ws, size_t ws_size, hipStream_t stream) {
    static int grid = 0;
    if (grid == 0) {
        if (n_in != 12 || out_size != M * DM || ws_size < WS_END) { fprintf(stderr, "kernel_launch: unexpected shapes (n_in %d out %d ws %zu)\n", n_in, out_size, ws_size); grid = -1; return; }
        int dev = 0, cus = 0, per_cu = 0;
        if (hipGetDevice(&dev) != hipSuccess || hipDeviceGetAttribute(&cus, hipDeviceAttributeMultiprocessorCount, dev) != hipSuccess) { grid = -1; return; }
        if (hipFuncSetAttribute((const void*)hybrid_fwd, hipFuncAttributeMaxDynamicSharedMemorySize, LDS_BYTES) != hipSuccess) { fprintf(stderr, "kernel_launch: hipFuncSetAttribute failed\n"); grid = -1; return; }
        if (hipOccupancyMaxActiveBlocksPerMultiprocessor(&per_cu, (const void*)hybrid_fwd, NWAVES * 64, LDS_BYTES) != hipSuccess || per_cu < 1) { fprintf(stderr, "kernel_launch: occupancy query says %d\n", per_cu); per_cu = 1; }
        (void)hipGetLastError();
        grid = cus;
    }
    if (grid < 0) return;
    Args a{};
    for (int i = 0; i < 12; ++i) a.in[i] = (const float*)d_in[i];
    a.out = (float*)d_out; a.ws = (unsigned char*)d_ws;
#if MK_COOP
    a.ph_lo = 0; a.ph_hi = N_PHASES; a.coop = 1;
    void* kargs[] = {&a};
    hipError_t e = hipLaunchCooperativeKernel((const void*)hybrid_fwd, dim3(grid), dim3(NWAVES * 64), kargs, LDS_BYTES, stream);
    if (e != hipSuccess) fprintf(stderr, "kernel_launch: cooperative launch failed: %s (grid %d)\n", hipGetErrorString(e), grid);
#else
    for (int p = 0; p < N_PHASES; ++p) { a.ph_lo = p; a.ph_hi = p + 1; a.coop = 0;
        hipLaunchKernelGGL(hybrid_fwd, dim3(grid), dim3(NWAVES * 64), LDS_BYTES, stream, a); }
#endif
}
```

```cpp
#include <hip/hip_runtime.h>
#include <hip/hip_cooperative_groups.h>
#include <cstdio>
#include <cstdint>
namespace cg = cooperative_groups;
#ifndef MK_COOP
#define MK_COOP 1
#endif
#ifndef MK_EARLY
#define MK_EARLY true
#endif
#define PG8_SP2 true
#define PG8_ALIGN true
#ifndef MK_REP0
#define MK_REP0 1
#endif
#ifndef MK_REP1
#define MK_REP1 1
#endif
#ifndef MK_REP2
#define MK_REP2 1
#endif
#ifndef MK_REP3
#define MK_REP3 1
#endif
#ifndef MK_REP4
#define MK_REP4 1
#endif
#ifndef MK_REP3A
#define MK_REP3A 1
#endif
#ifndef MK_REP3P
#define MK_REP3P 1
#endif
namespace pg8 {
#define PG8_LAS __attribute__((address_space(3)))
typedef unsigned short bf16_t;
typedef short bf16x8 __attribute__((ext_vector_type(8)));
typedef float f32x4 __attribute__((ext_vector_type(4)));
typedef unsigned u32x4 __attribute__((ext_vector_type(4)));
constexpr int BM = 256, BK = 64, HALF = 128, HTB = HALF * BK * 2  , STAGE_BYTES = 8 * HTB, NXCD = 8, WGM = 8;

__host__ __device__ __forceinline__ int lds_byte(int r, int c) { const int st = (r >> 4) * 2 + (c >> 5), rr = r & 15, cc = c & 31, ob = rr * 64 + cc * 2; return st * 1024 + (ob ^ (((ob >> 9) & 1) << 5)); }
__host__ __device__ __forceinline__ void stage_rc(int b, int& R, int& C) { const int st = b / 1024, sb = b % 1024, swz = sb ^ (((sb >> 9) & 1) << 5); R = (st >> 1) * 16 + swz / 64; C = (st & 1) * 32 + (swz % 64) / 2; }
__host__ __device__ __forceinline__ int perm32(int rho) { const int n = rho >> 4, i = rho & 15; return 8 * (i >> 2) + 4 * n + (i & 3); }

struct Unit { int pm, pn; };
struct Gemm { const bf16_t* A; const bf16_t* Bt; int M, N, K; };

struct StaticOrder {
    int nM, nN, nwg, G, c;
    __host__ __device__ void init(int M, int N, int G_, int c_) { nM = M / BM; nN = N / BM; nwg = nM * nN; G = G_; c = c_; }
    __host__ __device__ bool next(int i, Unit& u) const {
        const long L = (long)i * G + c; if (L >= nwg) return false;
        int wgid = (int)L; { const int q = nwg / NXCD, r = nwg % NXCD, xcd = wgid % NXCD, off = wgid / NXCD; wgid = (xcd < r ? xcd * (q + 1) : r * (q + 1) + (xcd - r) * q) + off; }
        const int nig = WGM * nN, gid = wgid / nig, fm = gid * WGM, gsz = (nM - fm) < WGM ? (nM - fm) : WGM;
        u.pm = fm + ((wgid % nig) % gsz); u.pn = (wgid % nig) / gsz; return true;
    }
    __device__ __forceinline__ void a_ready(const Unit&) const {}
    __device__ __forceinline__ void done(const Unit&) const {}
};
__device__ __forceinline__ unsigned cvt_pk_bf16(float lo, float hi) { unsigned r; asm volatile("v_cvt_pk_bf16_f32 %0, %1, %2" : "=v"(r) : "v"(lo), "v"(hi)); return r; }
typedef float f32x2 __attribute__((ext_vector_type(2)));
__device__ __forceinline__ float silu_f(float v) { return v * __builtin_amdgcn_rcpf(1.0f + __builtin_amdgcn_exp2f(-1.4426950408889634f * v)); }
constexpr float QSCALE = 0.125f * 1.4426950408889634f;
__device__ __forceinline__ size_t hm_off(int row, int head) { return ((size_t)((row >> 11) * 8 + head) * 2048 + (row & 2047)) * 64; }
struct EpiInProj {
    static constexpr bool PERM = true, AFTER_DRAIN = false;
    bf16_t* base; size_t stride; const float* gq; const float* gk;
    __device__ __forceinline__ void operator()(const f32x4 (&acc)[2][2][4][2], const Unit& u, int wr, int wc, int fr, int fq) const {
        const int type = u.pn >> 1;
        bf16_t* O = base + (size_t)type * stride;
        const int row0 = u.pm * BM + wr * 64 + fr;
        const int col0 = (u.pn & 1) * 256 + wc * 64 + 8 * fq;
        if (type < 2) {
            const float* g = type == 0 ? gq : gk; const float s = type == 0 ? QSCALE : 1.0f;
            f32x4 gs[2][2];
#pragma unroll
            for (int bj = 0; bj < 2; ++bj)
#pragma unroll
                for (int n = 0; n < 2; ++n) gs[bj][n] = *(const f32x4*)(g + 32 * bj + 8 * fq + 4 * n) * s;
#pragma unroll
            for (int ai = 0; ai < 2; ++ai)
#pragma unroll
                for (int m = 0; m < 4; ++m) {
                    float ss = 0.f;
#pragma unroll
                    for (int bj = 0; bj < 2; ++bj)
#pragma unroll
                        for (int n = 0; n < 2; ++n) { const f32x4 x = acc[ai][bj][m][n]; ss += (x[0] * x[0] + x[1] * x[1]) + (x[2] * x[2] + x[3] * x[3]); }
                    ss += __shfl_xor(ss, 16); ss += __shfl_xor(ss, 32);
                    const float inv = 1.0f / sqrtf(ss * (1.0f / 64.0f) + 1e-6f);
                    bf16_t* rowp = O + hm_off(row0 + ai * HALF + m * 16, (u.pn & 1) * 4 + wc) + 8 * fq;
#pragma unroll
                    for (int bj = 0; bj < 2; ++bj) { const f32x4 v0 = acc[ai][bj][m][0] * inv * gs[bj][0], v1 = acc[ai][bj][m][1] * inv * gs[bj][1];
                        u32x4 w; w.x = cvt_pk_bf16(v0[0], v0[1]); w.y = cvt_pk_bf16(v0[2], v0[3]); w.z = cvt_pk_bf16(v1[0], v1[1]); w.w = cvt_pk_bf16(v1[2], v1[3]);
                        *(u32x4*)(rowp + bj * 32) = w; }
                }
        } else {
            const bool act = (type == 3) || (type == 5);
#pragma unroll
            for (int ai = 0; ai < 2; ++ai)
#pragma unroll
                for (int m = 0; m < 4; ++m) {
                    bf16_t* rowp = (type == 2) ? O + hm_off(row0 + ai * HALF + m * 16, (u.pn & 1) * 4 + wc) + 8 * fq : O + (size_t)(row0 + ai * HALF + m * 16) * 512 + col0;
#pragma unroll
                    for (int bj = 0; bj < 2; ++bj) { f32x4 v0 = acc[ai][bj][m][0], v1 = acc[ai][bj][m][1];
                        if (act) { v0 = (f32x4){silu_f(v0[0]), silu_f(v0[1]), silu_f(v0[2]), silu_f(v0[3])}; v1 = (f32x4){silu_f(v1[0]), silu_f(v1[1]), silu_f(v1[2]), silu_f(v1[3])}; }
                        u32x4 w; w.x = cvt_pk_bf16(v0[0], v0[1]); w.y = cvt_pk_bf16(v0[2], v0[3]); w.z = cvt_pk_bf16(v1[0], v1[1]); w.w = cvt_pk_bf16(v1[2], v1[3]);
                        *(u32x4*)(rowp + bj * 32) = w; }
                }
        }
    }
};
struct EpiOutRes {
    static constexpr bool PERM = false, AFTER_DRAIN = false;
    const float* x; float* out; const float* gate;
    __device__ __forceinline__ void operator()(const f32x4 (&acc)[2][2][4][2], const Unit& u, int wr, int wc, int fr, int fq) const {
        const int col0 = u.pn * BM + wc * 32 + 4 * fq;
        const float* gp = gate + (size_t)((u.pm * BM) >> 11) * 3072 + col0;
        f32x4 gv[2][2];
#pragma unroll
        for (int bj = 0; bj < 2; ++bj)
#pragma unroll
            for (int n = 0; n < 2; ++n) gv[bj][n] = *(const f32x4*)(gp + bj * HALF + n * 16);
#pragma unroll
        for (int ai = 0; ai < 2; ++ai)
#pragma unroll
            for (int m = 0; m < 4; ++m) { const size_t off = (size_t)(u.pm * BM + ai * HALF + wr * 64 + m * 16 + fr) * 1024 + col0;
#pragma unroll
                for (int bj = 0; bj < 2; ++bj)
#pragma unroll
                    for (int n = 0; n < 2; ++n) { const f32x4 xv = *(const f32x4*)(x + off + bj * HALF + n * 16);
                        *(f32x4*)(out + off + bj * HALF + n * 16) = xv + gv[bj][n] * acc[ai][bj][m][n]; } }
    }
};
template <class Epi, class Sched, bool ALIGN_EPI = false, bool SP2 = false>
__device__ __forceinline__ void gemm_phase(PG8_LAS unsigned char* lds, const Gemm g, const Sched& S, const Epi& E) {
    const int tid = threadIdx.x, wid = __builtin_amdgcn_readfirstlane(tid >> 6), lane = tid & 63, wr = wid >> 2, wc = wid & 3, fr = lane & 15, fq = lane >> 4;
    const int K = g.K, nt = K / BK;
    unsigned voffA[2], voffB[2];
#pragma unroll
    for (int i = 0; i < 2; ++i) { int R, C; stage_rc(tid * 16 + i * 8192, R, C); const int Rb = Epi::PERM ? ((R & ~31) + perm32(R & 31)) : R;
        voffA[i] = (unsigned)(R * K + C) * 2u; voffB[i] = (unsigned)(Rb * K + C) * 2u; }
    const size_t kstep = (size_t)(BK * 2);
    const size_t hstep = (size_t)HALF * K * 2;
    const size_t tstep = 2 * hstep;
    const unsigned ldsw = (unsigned)wid * 1024u;
    const int aoff = lds_byte(wr * 64 + fr, fq * 8), boff = lds_byte(wc * 32 + fr, fq * 8);
#define PG8_SA(b, h) (((b) * 2 + (h)) * HTB)
#define PG8_SB(b, h) ((4 + (b) * 2 + (h)) * HTB)
#define PG8_STAGE(bufoff, gbase, voff) do { _Pragma("unroll") for (int _i = 0; _i < 2; ++_i) \
        __builtin_amdgcn_global_load_lds((const unsigned*)((const char*)(gbase) + (voff)[_i]), (PG8_LAS unsigned*)(lds + (bufoff) + ldsw + _i * 8192), 16, 0, 0); } while (0)
#define PG8_LDA(dst, b, h) do { _Pragma("unroll") for (int m = 0; m < 4; ++m) _Pragma("unroll") for (int k = 0; k < 2; ++k) dst[m][k] = *(const PG8_LAS bf16x8*)(lds + PG8_SA(b, h) + aoff + m * 2048 + k * 1024); } while (0)
#define PG8_LDB(dst, b, h) do { _Pragma("unroll") for (int n = 0; n < 2; ++n) _Pragma("unroll") for (int k = 0; k < 2; ++k) dst[n][k] = *(const PG8_LAS bf16x8*)(lds + PG8_SB(b, h) + boff + n * 2048 + k * 1024); } while (0)
#define PG8_MMA(ai, bj, At, Bt) do { __builtin_amdgcn_s_setprio(1); _Pragma("unroll") for (int m = 0; m < 4; ++m) _Pragma("unroll") for (int n = 0; n < 2; ++n) _Pragma("unroll") for (int k = 0; k < 2; ++k) \
        acc[ai][bj][m][n] = __builtin_amdgcn_mfma_f32_16x16x32_bf16(Bt[n][k], At[m][k], acc[ai][bj][m][n], 0, 0, 0); __builtin_amdgcn_s_setprio(0); } while (0)
#define PG8_WAIT_V(n) asm volatile("s_waitcnt vmcnt(" #n ")" ::: "memory")
#define PG8_WAIT_L(n) asm volatile("s_waitcnt lgkmcnt(" #n ")" ::: "memory")
#define PG8_BAR __builtin_amdgcn_s_barrier()
#define PG8_SCHED __builtin_amdgcn_sched_barrier(0)
    Unit cur, nxt; int ui = 0;
    if (!S.next(0, cur)) return;
    f32x4 acc[2][2][4][2];
#pragma unroll
    for (int a = 0; a < 2; ++a)
#pragma unroll
        for (int b = 0; b < 2; ++b)
#pragma unroll
            for (int m = 0; m < 4; ++m)
#pragma unroll
                for (int n = 0; n < 2; ++n) acc[a][b][m][n] = (f32x4){0.f, 0.f, 0.f, 0.f};
    bf16x8 At[4][2], B0[2][2], B1[2][2];
    const char* cA = (const char*)g.A + (size_t)cur.pm * tstep; const char* cB = (const char*)g.Bt + (size_t)cur.pn * tstep;
    S.a_ready(cur);
    if constexpr (SP2) {
        PG8_STAGE(PG8_SB(0, 0), cB, voffB); PG8_STAGE(PG8_SB(0, 1), cB + hstep, voffB); PG8_STAGE(PG8_SA(0, 0), cA, voffA); PG8_STAGE(PG8_SA(0, 1), cA + hstep, voffA);
        if (wr == 1) PG8_BAR;
        PG8_WAIT_V(2); PG8_BAR;
        PG8_STAGE(PG8_SB(1, 0), cB + kstep, voffB); PG8_STAGE(PG8_SA(1, 0), cA + kstep, voffA); PG8_STAGE(PG8_SB(1, 1), cB + hstep + kstep, voffB);
        PG8_WAIT_V(6); PG8_BAR;
    } else {
        PG8_STAGE(PG8_SB(0, 0), cB, voffB); PG8_STAGE(PG8_SA(0, 0), cA, voffA); PG8_STAGE(PG8_SB(0, 1), cB + hstep, voffB); PG8_STAGE(PG8_SA(0, 1), cA + hstep, voffA);
        if (wr == 1) PG8_BAR;
        PG8_WAIT_V(4); PG8_BAR;
        PG8_STAGE(PG8_SB(1, 0), cB + kstep, voffB); PG8_STAGE(PG8_SA(1, 0), cA + kstep, voffA); PG8_STAGE(PG8_SB(1, 1), cB + hstep + kstep, voffB);
        PG8_WAIT_V(6); PG8_BAR;
    }
    for (;;) {
        const bool has_next = S.next(ui + 1, nxt);
        const char* nA = has_next ? (const char*)g.A + (size_t)nxt.pm * tstep : cA; const char* nB = has_next ? (const char*)g.Bt + (size_t)nxt.pn * tstep : cB;
        for (int t = 0; t < nt; t += 2) {
            const bool last = (t == nt - 2);
            const char* a1 = cA + (size_t)(t + 1) * kstep;
            const char* a2 = last ? nA : cA + (size_t)(t + 2) * kstep; const char* b2 = last ? nB : cB + (size_t)(t + 2) * kstep;
            const char* a3 = a2 + kstep; const char* b3 = b2 + kstep;
            if (last && has_next) S.a_ready(nxt);
            if constexpr (SP2) {
            PG8_LDB(B0, 0, 0); PG8_LDB(B1, 0, 1); PG8_SCHED; PG8_LDA(At, 0, 0); PG8_STAGE(PG8_SA(1, 1), a1 + hstep, voffA);
            PG8_WAIT_V(8); PG8_WAIT_L(0); PG8_BAR; PG8_MMA(0, 0, At, B0); PG8_MMA(0, 1, At, B1); PG8_BAR; PG8_SCHED;
            PG8_LDA(At, 0, 1); PG8_STAGE(PG8_SB(0, 0), b2, voffB); PG8_STAGE(PG8_SB(0, 1), b2 + hstep, voffB); PG8_STAGE(PG8_SA(0, 0), a2, voffA);
            PG8_WAIT_V(8); PG8_WAIT_L(0); PG8_BAR; PG8_MMA(1, 0, At, B0); PG8_MMA(1, 1, At, B1); PG8_BAR; PG8_SCHED;
            PG8_LDB(B0, 1, 0); PG8_LDB(B1, 1, 1); PG8_SCHED; PG8_LDA(At, 1, 0); PG8_STAGE(PG8_SA(0, 1), a2 + hstep, voffA);
            PG8_WAIT_V(8); PG8_WAIT_L(0); PG8_BAR; PG8_MMA(0, 0, At, B0); PG8_MMA(0, 1, At, B1); PG8_BAR; PG8_SCHED;
            PG8_LDA(At, 1, 1); PG8_STAGE(PG8_SB(1, 0), b3, voffB); PG8_STAGE(PG8_SB(1, 1), b3 + hstep, voffB); PG8_STAGE(PG8_SA(1, 0), a3, voffA);
            PG8_WAIT_V(8); PG8_WAIT_L(0); PG8_BAR; PG8_MMA(1, 0, At, B0); PG8_MMA(1, 1, At, B1); PG8_BAR; PG8_SCHED;
            } else {
            PG8_LDB(B0, 0, 0); PG8_SCHED; PG8_LDA(At, 0, 0); PG8_STAGE(PG8_SA(1, 1), a1 + hstep, voffA);
            PG8_WAIT_L(8); PG8_BAR; PG8_WAIT_L(0); PG8_MMA(0, 0, At, B0); PG8_BAR; PG8_SCHED;
            PG8_LDB(B1, 0, 1); PG8_STAGE(PG8_SB(0, 0), b2, voffB);
            PG8_BAR; PG8_WAIT_L(0); PG8_MMA(0, 1, At, B1); PG8_BAR;
            PG8_LDA(At, 0, 1); PG8_STAGE(PG8_SA(0, 0), a2, voffA);
            PG8_BAR; PG8_WAIT_L(0); PG8_MMA(1, 0, At, B0); PG8_BAR; PG8_SCHED;
            PG8_STAGE(PG8_SB(0, 1), b2 + hstep, voffB);
            PG8_WAIT_V(6); PG8_BAR; PG8_MMA(1, 1, At, B1); PG8_BAR;
            PG8_LDB(B0, 1, 0); PG8_SCHED; PG8_LDA(At, 1, 0); PG8_STAGE(PG8_SA(0, 1), a2 + hstep, voffA);
            PG8_WAIT_L(8); PG8_BAR; PG8_WAIT_L(0); PG8_MMA(0, 0, At, B0); PG8_BAR; PG8_SCHED;
            PG8_LDB(B1, 1, 1); PG8_STAGE(PG8_SB(1, 0), b3, voffB);
            PG8_BAR; PG8_WAIT_L(0); PG8_MMA(0, 1, At, B1); PG8_BAR;
            PG8_LDA(At, 1, 1); PG8_STAGE(PG8_SA(1, 0), a3, voffA);
            PG8_BAR; PG8_WAIT_L(0); PG8_MMA(1, 0, At, B0); PG8_BAR; PG8_SCHED;
            PG8_STAGE(PG8_SB(1, 1), b3 + hstep, voffB);
            PG8_WAIT_V(6); PG8_BAR; PG8_MMA(1, 1, At, B1); PG8_BAR;
            }
        }
        if constexpr (ALIGN_EPI) { if (wr == 0) PG8_BAR; }
        if constexpr (!Epi::AFTER_DRAIN) { E(acc, cur, wr, wc, fr, fq); S.done(cur); }
        if (!has_next) break;
#pragma unroll
        for (int a = 0; a < 2; ++a)
#pragma unroll
            for (int b = 0; b < 2; ++b)
#pragma unroll
                for (int m = 0; m < 4; ++m)
#pragma unroll
                    for (int n = 0; n < 2; ++n) acc[a][b][m][n] = (f32x4){0.f, 0.f, 0.f, 0.f};
        cur = nxt; cA = nA; cB = nB; ++ui;
        if constexpr (ALIGN_EPI) { if (wr == 1) PG8_BAR; }
    }
    PG8_WAIT_V(0);
    if constexpr (!ALIGN_EPI) { if (wr == 0) PG8_BAR; }
    PG8_BAR;
    if constexpr (Epi::AFTER_DRAIN) { E.fused(acc, cur, wr, wc, fr, fq, lds, wid, lane); S.done(cur); }
#undef PG8_SA
#undef PG8_SB
#undef PG8_STAGE
#undef PG8_LDA
#undef PG8_LDB
#undef PG8_MMA
#undef PG8_WAIT_V
#undef PG8_WAIT_L
#undef PG8_BAR
#undef PG8_SCHED
}
}

constexpr int NWAVES = 8;
constexpr int BATCH = 8, SEQ = 2048, DM = 1024, M = BATCH * SEQ, DIN = 3072, DH = 64, NH = 8, DA = 512;
constexpr size_t MiB = 1u << 20;
constexpr size_t WS_CTL = 0, CTL_ZERO_BYTES = 64 * 1024;
constexpr size_t WS_MOD = 1 * MiB;
constexpr size_t WS_WIN = 2 * MiB;
constexpr size_t WS_WOUT = 8 * MiB;
constexpr size_t WS_WPOOL = 10 * MiB;
constexpr size_t WS_XN = 16 * MiB;
constexpr size_t WS_PROJ = 48 * MiB;
constexpr size_t PROJ_STRIDE = (size_t)M * 512;
constexpr size_t WS_CAT = 144 * MiB;
constexpr size_t WS_END = 176 * MiB;
constexpr int RING_BYTES = 131072, LDS_BYTES = 147456, MISC_OFF = LDS_BYTES - 128;
constexpr int CW_BAR = 1024;

#define GAS __attribute__((address_space(1)))
#define LAS __attribute__((address_space(3)))
typedef unsigned short bf16;
typedef unsigned v4u __attribute__((ext_vector_type(4)));
typedef unsigned v2u __attribute__((ext_vector_type(2)));
typedef float f32x4 __attribute__((ext_vector_type(4)));
typedef float f32x16 __attribute__((ext_vector_type(16)));
typedef short bf16x8 __attribute__((ext_vector_type(8)));
typedef short s16x4 __attribute__((ext_vector_type(4)));
#define LDS_WAIT() asm volatile("s_waitcnt lgkmcnt(0)" ::: "memory")
#define VM_WAIT() asm volatile("s_waitcnt vmcnt(0)" ::: "memory")
__device__ __forceinline__ unsigned pk2(float lo, float hi) { return pg8::cvt_pk_bf16(lo, hi); }
__device__ __forceinline__ float bf_lo(unsigned u) { return __builtin_bit_cast(float, u << 16); }
__device__ __forceinline__ float bf_hi(unsigned u) { return __builtin_bit_cast(float, u & 0xffff0000u); }
#define XB_TMO      128
#define XB_XCNT(j)  (256  + 64 * (j))
#define XB_XSUB(j)  (1280 + 64 * (j))
#define XB_XGEN(j)  (2304 + 64 * (j))
#define XB_TOP      3328
#define XB_TOPGEN   3392
#define XCD_BAR_WORDS 3456
#define XB_SPIN_CAP (1u << 18)

__device__ __forceinline__ unsigned xb_ld(unsigned* p)              { return __hip_atomic_load(p, __ATOMIC_RELAXED, __HIP_MEMORY_SCOPE_AGENT); }
__device__ __forceinline__ unsigned xb_add(unsigned* p, unsigned v) { return __hip_atomic_fetch_add(p, v, __ATOMIC_RELAXED, __HIP_MEMORY_SCOPE_AGENT); }
__device__ __forceinline__ unsigned xb_xcc_id() { return (unsigned)__builtin_amdgcn_s_getreg((3 << 11) | 20) & 0xFu; }
#define XB_SPIN(cond, bar) do { unsigned _sp = 0; while (cond) { __builtin_amdgcn_s_sleep(1); \
    if ((++_sp & 255u) == 0u) { if (xb_ld(&(bar)[XB_TMO])) break; if (_sp > XB_SPIN_CAP) { atomicAdd(&(bar)[XB_TMO], 1u); break; } } } } while (0)

struct XcdBarrier {
    unsigned* bar; unsigned x;
    volatile LAS unsigned* st;
};

__device__ __forceinline__ XcdBarrier xcd_barrier_post(unsigned* bar, volatile LAS unsigned* st) {
    XcdBarrier b; b.bar = bar; b.x = xb_xcc_id(); b.st = st;
    if (threadIdx.x == 0) (void)xb_add(&bar[XB_XCNT(b.x)], 1u);
    return b;
}
__device__ __forceinline__ void xcd_barrier_complete(unsigned* bar, unsigned x, unsigned& nloc, unsigned& nx) {
    const unsigned G = gridDim.x * gridDim.y * gridDim.z;
    unsigned sum, cnt, mine, sp = 0u;
    for (;;) {
        sum = 0u; cnt = 0u; mine = 0u;
#pragma unroll
        for (unsigned j = 0; j < 16; ++j) { const unsigned c = xb_ld(&bar[XB_XCNT(j)]); sum += c; cnt += (c > 0u) ? 1u : 0u; mine = (j == x) ? c : mine; }
        if (sum == G) break;
        __builtin_amdgcn_s_sleep(1);
        if ((++sp & 255u) == 0u) { if (xb_ld(&bar[XB_TMO])) break; if (sp > XB_SPIN_CAP) { atomicAdd(&bar[XB_TMO], 1u); break; } }
    }
    nloc = mine > 0u ? mine : 1u; nx = cnt > 0u ? cnt : 1u;
}

__device__ __forceinline__ void xcd_barrier(const XcdBarrier& b) {
    asm volatile("s_waitcnt vmcnt(0)" ::: "memory");
    __syncthreads();
    if (threadIdx.x == 0) {
        unsigned* bar = b.bar;
        __builtin_amdgcn_s_waitcnt(0);
        unsigned nloc = b.st[0], nx = b.st[1];
        if (nloc == 0u) { xcd_barrier_complete(bar, b.x, nloc, nx); b.st[0] = nloc; b.st[1] = nx; }
        const unsigned old = xb_add(&bar[XB_XSUB(b.x)], 1u);
        const unsigned gen = old / nloc;
        if (old + 1u == (gen + 1u) * nloc) {
            __builtin_amdgcn_fence(__ATOMIC_RELEASE, "agent");
            asm volatile("s_waitcnt vmcnt(0)" ::: "memory");
            const unsigned og = xb_add(&bar[XB_TOP], 1u);
            const unsigned tg = og / nx;
            if (og + 1u == (tg + 1u) * nx) xb_add(&bar[XB_TOPGEN], 1u);
            else XB_SPIN(xb_ld(&bar[XB_TOPGEN]) == tg, bar);
            __builtin_amdgcn_fence(__ATOMIC_ACQUIRE, "agent");
            xb_add(&bar[XB_XGEN(b.x)], 1u);
            asm volatile("s_waitcnt vmcnt(0)" ::: "memory");
        } else {
            XB_SPIN(xb_ld(&bar[XB_XGEN(b.x)]) == gen, bar);
            __builtin_amdgcn_fence(__ATOMIC_ACQUIRE, "agent");
            asm volatile("s_waitcnt vmcnt(0)" ::: "memory");
        }
    }
    __syncthreads();
}

namespace att {
__device__ __forceinline__ void glds16(const void* gsrc, unsigned lds_dst) { unsigned keep;
    asm volatile("s_mov_b32 %0, m0\n\ts_mov_b32 m0, %2\n\ts_nop 0\n\tglobal_load_lds_dwordx4 %1, off\n\ts_mov_b32 m0, %0" : "=&s"(keep) : "v"(gsrc), "s"(lds_dst) : "memory"); }
typedef short v4i16_t __attribute__((ext_vector_type(4)));
__device__ __forceinline__ s16x4 vtr(LAS const char* p) { return __builtin_bit_cast(s16x4, __builtin_amdgcn_ds_read_tr16_b64_v4i16((LAS v4i16_t*)p)); }
constexpr int TILEB = 8192, VOFF = 4096, STAGE_OFF = 12 * TILEB, STAGE_B = 4608;
#ifndef ATT_HIST
#define ATT_HIST 4
#endif

__device__ __forceinline__ void tile_weights(f32x16& p0, float& carry, unsigned (&pw)[2][4], bool diag, int kv0, int qabs, int hi) {
    float G[4];
#pragma unroll
    for (int i = 0; i < 4; ++i) {
        float rr[4], be[4];
#pragma unroll
        for (int j = 0; j < 4; ++j) {
            const float e = __builtin_amdgcn_exp2f(p0[4 * i + j]);
            float rv = __builtin_amdgcn_rcpf(1.0f + e); float bv = e * rv;
            if (diag) { const int kv = kv0 + 8 * i + 4 * hi + j; if (kv >= qabs) { rv = 1.0f; bv = 0.0f; } }
            rr[j] = rv; be[j] = bv;
        }
        const float s2 = rr[3], s1 = s2 * rr[2], s0 = s1 * rr[1];
        G[i] = s0 * rr[0];
        p0[4 * i + 3] = be[3]; p0[4 * i + 2] = be[2] * s2; p0[4 * i + 1] = be[1] * s1; p0[4 * i] = be[0] * s0;
    }
    float F[4]; float run = carry;
#pragma unroll
    for (int p = 3; p >= 0; --p) {
        auto sw = __builtin_amdgcn_permlane32_swap(__float_as_uint(G[p]), __float_as_uint(G[p]), false, false);
        const float g0 = __uint_as_float(sw[0]), g1 = __uint_as_float(sw[1]);
        F[p] = run * (hi ? 1.0f : g1);
        run = run * (g0 * g1);
    }
    carry = run;
#pragma unroll
    for (int i = 0; i < 4; ++i) { const float f = F[i];
        pw[i >> 1][2 * (i & 1)] = pk2(p0[4 * i] * f, p0[4 * i + 1] * f); pw[i >> 1][2 * (i & 1) + 1] = pk2(p0[4 * i + 2] * f, p0[4 * i + 3] * f); }
}

template <bool EARLY>
__device__ __forceinline__ void attn_pass(int b, int h, int qb0, const bf16* Q, const bf16* K, const bf16* V, const bf16* GA, bf16* CAT, LAS char* shm) {
    const int tid = threadIdx.x, lane = tid & 63, r32 = lane & 31, hi = lane >> 5; const int wid = __builtin_amdgcn_readfirstlane(tid >> 6);
    const size_t hb = ((size_t)(b * NH + h) * SEQ) * DH;
    const bf16* Qh = Q + hb; const bf16* Kh = K + hb; const bf16* Vh = V + hb;
    const unsigned lds0 = (unsigned)__builtin_amdgcn_readfirstlane((int)(unsigned)(uintptr_t)shm);
    const int wb = qb0 - ATT_HIST > 0 ? qb0 - ATT_HIST : 0, nw = qb0 + 8 - wb;
    const bf16* ksrc = Kh + (size_t)(lane >> 3) * DH + (((lane & 7) ^ ((lane >> 3) & 7)) * 8);
    const bf16* vsrc = Vh + (size_t)(lane >> 2) * DH + (lane & 3) * 8;
    for (int p = wid; p < nw * 8; p += NWAVES) {
        const int w = p >> 3, pc = p & 7; const size_t trow = (size_t)(wb + w) * 32;
        const unsigned dst = lds0 + w * TILEB + pc * 1024;
        if (pc < 4) glds16(ksrc + (trow + 8 * pc) * DH, dst);
        else glds16(vsrc + (trow + 16 * ((pc - 4) & 1)) * DH + 32 * ((pc - 4) >> 1), dst);
    }
    const int qblk = qb0 + wid, q0 = qblk * 32, qabs = q0 + r32;
    bf16x8 qr[4];
#pragma unroll
    for (int d0 = 0; d0 < 4; ++d0) qr[d0] = *reinterpret_cast<const bf16x8*>(&Qh[(size_t)qabs * DH + d0 * 16 + hi * 8]);
    const size_t tok0 = (size_t)b * SEQ + q0;
    v4u gpre[2][2];
#pragma unroll
    for (int dh = 0; dh < 2; ++dh)
#pragma unroll
        for (int k = 0; k < 2; ++k) gpre[dh][k] = *(const v4u*)(GA + (tok0 + 16 * k + (lane >> 2)) * 512 + h * DH + 32 * dh + (lane & 3) * 8);
    asm volatile("s_waitcnt vmcnt(0)" ::: "memory");
    __syncthreads();
    f32x16 o[2]; o[0] = f32x16{}; o[1] = f32x16{};
    float carry = 1.0f; bool dead = false;
    LAS const char* kp0 = shm + r32 * 128;
    LAS const char* vp0 = shm + VOFF + ((lane >> 4) & 1) * 32 + (lane & 3) * 8 + (4 * hi + ((lane & 15) >> 2)) * 64;
    int t = qblk;
    for (; t >= wb; --t) {
        const int w = t - wb;
        LAS const char* kp = kp0 + w * TILEB;
        f32x16 p0 = f32x16{};
#pragma unroll
        for (int d0 = 0; d0 < 4; ++d0) {
            const bf16x8 kf = *(LAS const bf16x8*)(kp + (((2 * d0 + hi) ^ (r32 & 7)) * 16));
            p0 = __builtin_amdgcn_mfma_f32_32x32x16_bf16(kf, qr[d0], p0, 0, 0, 0);
        }
        unsigned pw[2][4];
        tile_weights(p0, carry, pw, t == qblk, t * 32, qabs, hi);
        LAS const char* vp = vp0 + w * TILEB;
#pragma unroll
        for (int dh = 0; dh < 2; ++dh)
#pragma unroll
            for (int ks = 0; ks < 2; ++ks) {
                const s16x4 lo = vtr(vp + dh * 2048 + ks * 1024), hh = vtr(vp + dh * 2048 + ks * 1024 + 512);
                const bf16x8 vf = (bf16x8){lo[0], lo[1], lo[2], lo[3], hh[0], hh[1], hh[2], hh[3]};
                const v4u pwv = (v4u){pw[ks][0], pw[ks][1], pw[ks][2], pw[ks][3]};
                o[dh] = __builtin_amdgcn_mfma_f32_32x32x16_bf16(vf, __builtin_bit_cast(bf16x8, pwv), o[dh], 0, 0, 0);
            }
        if (EARLY) { if (__all(carry < 1e-30f)) { dead = true; break; } }
    }
    if (!dead) {
        for (t = wb - 1; t >= 0; --t) {
            f32x16 p0 = f32x16{};
#pragma unroll
            for (int d0 = 0; d0 < 4; ++d0) {
                const bf16x8 kf = *reinterpret_cast<const bf16x8*>(&Kh[((size_t)t * 32 + r32) * DH + (2 * d0 + hi) * 8]);
                p0 = __builtin_amdgcn_mfma_f32_32x32x16_bf16(kf, qr[d0], p0, 0, 0, 0);
            }
            unsigned pw[2][4];
            tile_weights(p0, carry, pw, false, t * 32, qabs, hi);
#pragma unroll
            for (int dh = 0; dh < 2; ++dh)
#pragma unroll
                for (int ks = 0; ks < 2; ++ks) {
                    bf16x8 vf;
#pragma unroll
                    for (int j = 0; j < 8; ++j) vf[j] = (short)Vh[((size_t)t * 32 + 16 * ks + 8 * (j >> 2) + 4 * hi + (j & 3)) * DH + 32 * dh + r32];
                    const v4u pwv = (v4u){pw[ks][0], pw[ks][1], pw[ks][2], pw[ks][3]};
                    o[dh] = __builtin_amdgcn_mfma_f32_32x32x16_bf16(vf, __builtin_bit_cast(bf16x8, pwv), o[dh], 0, 0, 0);
                }
            if (EARLY) { if (__all(carry < 1e-30f)) break; }
        }
    }
    {
        LAS char* st = shm + STAGE_OFF + wid * STAGE_B;
        const int rr = lane >> 2, ch = lane & 3;
#pragma unroll
        for (int dh = 0; dh < 2; ++dh) {
#pragma unroll
            for (int i = 0; i < 4; ++i) *(LAS f32x4*)(st + r32 * 144 + (8 * i + 4 * hi) * 4) = (f32x4){o[dh][4 * i], o[dh][4 * i + 1], o[dh][4 * i + 2], o[dh][4 * i + 3]};
            asm volatile("s_waitcnt lgkmcnt(0)" ::: "memory");
#pragma unroll
            for (int k = 0; k < 2; ++k) { const int row = 16 * k + rr;
                const f32x4 a0 = *(LAS const f32x4*)(st + row * 144 + ch * 32), a1 = *(LAS const f32x4*)(st + row * 144 + ch * 32 + 16);
                const v4u g = gpre[dh][k];
                v4u w; w.x = pk2(a0[0] * bf_lo(g.x), a0[1] * bf_hi(g.x)); w.y = pk2(a0[2] * bf_lo(g.y), a0[3] * bf_hi(g.y));
                w.z = pk2(a1[0] * bf_lo(g.z), a1[1] * bf_hi(g.z)); w.w = pk2(a1[2] * bf_lo(g.w), a1[3] * bf_hi(g.w));
                *(v4u*)(CAT + (tok0 + row) * DM + h * DH + 32 * dh + ch * 8) = w; }
            asm volatile("s_waitcnt lgkmcnt(0)" ::: "memory");
        }
    }
    __syncthreads();
}
}

namespace pool {
constexpr int UP = 272;
constexpr int WOFF = 73728;
template <int WIN>
__device__ __forceinline__ void pool_unit_w(int pm, int g, const bf16* U, const bf16* GP, const bf16* WpT, const float* bp, const float* ps, bf16* CAT, LAS char* shm) {
    const int tid = threadIdx.x, lane = tid & 63, r32 = lane & 31, hi = lane >> 5; const int wid = __builtin_amdgcn_readfirstlane(tid >> 6);
    const int t0 = pm * 256, tpos0 = t0 & (SEQ - 1);
    v4u tu[9], tw[4];
#pragma unroll
    for (int k = 0; k < 9; ++k) { const int c = tid + k * 512, row = c >> 4, ch = c & 15; tu[k] = (v4u){0u, 0u, 0u, 0u};
        if (c < 271 * 16 && tpos0 - 15 + row >= 0) tu[k] = *(const v4u*)(U + (size_t)(t0 - 15 + row) * 512 + g * 128 + ch * 8); }
#pragma unroll
    for (int k = 0; k < 4; ++k) { const int c = tid + k * 512; tw[k] = *(const v4u*)(WpT + (size_t)g * 16384 + (size_t)c * 8); }
#pragma unroll
    for (int k = 0; k < 9; ++k) { const int c = tid + k * 512, row = c >> 4, ch = c & 15; if (c < 271 * 16) *(LAS v4u*)(shm + row * UP + ch * 16) = tu[k]; }
#pragma unroll
    for (int k = 0; k < 4; ++k) { const int c = tid + k * 512, row = c >> 4, ch = c & 15; *(LAS v4u*)(shm + WOFF + row * UP + ch * 16) = tw[k]; }
    __syncthreads();
    v4u gpre[2][4];
#pragma unroll
    for (int half = 0; half < 2; ++half)
#pragma unroll
        for (int k = 0; k < 4; ++k) gpre[half][k] = *(const v4u*)(GP + ((size_t)t0 + wid * 32 + 8 * k + (lane >> 3)) * 512 + g * 128 + 64 * half + (lane & 7) * 8);
    const int r = wid * 32 + r32, tpos = tpos0 + r;
    const float inv = 1.0f / (float)(tpos + 1 < WIN ? tpos + 1 : WIN);
    f32x16 acc[4]; acc[0] = f32x16{}; acc[1] = f32x16{}; acc[2] = f32x16{}; acc[3] = f32x16{};
    LAS const char* wl = shm + WOFF + r32 * UP + 16 * hi;
#pragma unroll 2
    for (int s = 0; s < 8; ++s) {
        LAS const char* up = shm + (r + 15) * UP + (16 * s + 8 * hi) * 2;
        const v4u ut = *(LAS const v4u*)up;
        float sum[8] = {bf_lo(ut.x), bf_hi(ut.x), bf_lo(ut.y), bf_hi(ut.y), bf_lo(ut.z), bf_hi(ut.z), bf_lo(ut.w), bf_hi(ut.w)};
        float tk[8];
#pragma unroll
        for (int j = 0; j < 8; ++j) tk[j] = sum[j];
#pragma unroll
        for (int i = 1; i < WIN; ++i) { const v4u v = *(LAS const v4u*)(up - i * UP);
            sum[0] += bf_lo(v.x); sum[1] += bf_hi(v.x); sum[2] += bf_lo(v.y); sum[3] += bf_hi(v.y); sum[4] += bf_lo(v.z); sum[5] += bf_hi(v.z); sum[6] += bf_lo(v.w); sum[7] += bf_hi(v.w); }
        v4u pf; pf.x = pk2(sum[0] * inv - tk[0], sum[1] * inv - tk[1]); pf.y = pk2(sum[2] * inv - tk[2], sum[3] * inv - tk[3]);
        pf.z = pk2(sum[4] * inv - tk[4], sum[5] * inv - tk[5]); pf.w = pk2(sum[6] * inv - tk[6], sum[7] * inv - tk[7]);
        const bf16x8 pfr = __builtin_bit_cast(bf16x8, pf);
#pragma unroll
        for (int n = 0; n < 4; ++n) { const bf16x8 wf = *(LAS const bf16x8*)(wl + n * 32 * UP + 32 * s);
            acc[n] = __builtin_amdgcn_mfma_f32_32x32x16_bf16(wf, pfr, acc[n], 0, 0, 0); }
    }
    __syncthreads();
    {
        LAS char* st = shm + wid * 16384;
        const size_t tokw = (size_t)t0 + wid * 32;
        const int rr = lane >> 3, ch = lane & 7;
#pragma unroll
        for (int half = 0; half < 2; ++half) {
#pragma unroll
            for (int nn = 0; nn < 2; ++nn)
#pragma unroll
                for (int i = 0; i < 4; ++i) { const int n = 2 * half + nn;
                    *(LAS f32x4*)(st + r32 * 272 + (32 * nn + 8 * i + 4 * hi) * 4) = (f32x4){acc[n][4 * i], acc[n][4 * i + 1], acc[n][4 * i + 2], acc[n][4 * i + 3]}; }
            asm volatile("s_waitcnt lgkmcnt(0)" ::: "memory");
            const int col = g * 128 + 64 * half + ch * 8;
            const f32x4 b0 = *(const f32x4*)(bp + col), b1 = *(const f32x4*)(bp + col + 4), s0 = *(const f32x4*)(ps + col), s1 = *(const f32x4*)(ps + col + 4);
#pragma unroll
            for (int k = 0; k < 4; ++k) { const int row = 8 * k + rr;
                const f32x4 a0 = (*(LAS const f32x4*)(st + row * 272 + ch * 32) + b0) * s0, a1 = (*(LAS const f32x4*)(st + row * 272 + ch * 32 + 16) + b1) * s1;
                const v4u gv = gpre[half][k];
                v4u w; w.x = pk2(a0[0] * bf_lo(gv.x), a0[1] * bf_hi(gv.x)); w.y = pk2(a0[2] * bf_lo(gv.y), a0[3] * bf_hi(gv.y));
                w.z = pk2(a1[0] * bf_lo(gv.z), a1[1] * bf_hi(gv.z)); w.w = pk2(a1[2] * bf_lo(gv.w), a1[3] * bf_hi(gv.w));
                *(v4u*)(CAT + (tokw + row) * DM + 512 + col) = w; }
            asm volatile("s_waitcnt lgkmcnt(0)" ::: "memory");
        }
    }
    __syncthreads();
}
__device__ __forceinline__ void pool_unit(int pm, int g, const bf16* U, const bf16* GP, const bf16* WpT, const float* bp, const float* ps, bf16* CAT, LAS char* shm) {
    if (g == 0) pool_unit_w<2>(pm, g, U, GP, WpT, bp, ps, CAT, shm);
    else if (g == 1) pool_unit_w<4>(pm, g, U, GP, WpT, bp, ps, CAT, shm);
    else if (g == 2) pool_unit_w<8>(pm, g, U, GP, WpT, bp, ps, CAT, shm);
    else pool_unit_w<16>(pm, g, U, GP, WpT, bp, ps, CAT, shm);
}
}

__device__ __forceinline__ float wave_sum(float v) {
#pragma unroll
    for (int o = 1; o < 64; o <<= 1) v += __shfl_xor(v, o);
    return v;
}
struct TrItem { const float* W; bf16* WT; int K, N, item; bool permn; };
__device__ __forceinline__ void tr_load(const TrItem& t, float (&v)[32], int lane) {
    const int nblk = t.N / 32, kb = t.item / nblk, nb = t.item % nblk, k0 = 64 * kb, n0 = 32 * nb;
#pragma unroll
    for (int i = 0; i < 32; ++i) { const int kk = 2 * i + (lane >> 5); v[i] = t.W[(size_t)(k0 + kk) * t.N + n0 + (lane & 31)]; }
}
__device__ __forceinline__ void tr_finish(const TrItem& t, const float (&v)[32], LAS float* scr, int lane) {
    const int nblk = t.N / 32, kb = t.item / nblk, nb = t.item % nblk, k0 = 64 * kb, n0 = 32 * nb;
#pragma unroll
    for (int i = 0; i < 32; ++i) { const int kk = 2 * i + (lane >> 5); scr[kk * 33 + (lane & 31)] = v[i]; }
    LDS_WAIT(); asm volatile("" ::: "memory");
    const int c = lane & 7;
#pragma unroll
    for (int j = 0; j < 4; ++j) { const int n = (lane >> 3) + 8 * j; const LAS float* s = scr + (8 * c) * 33 + n;
        v4u o; o.x = pk2(s[0 * 33], s[1 * 33]); o.y = pk2(s[2 * 33], s[3 * 33]); o.z = pk2(s[4 * 33], s[5 * 33]); o.w = pk2(s[6 * 33], s[7 * 33]);
        int na = n0 + n;
        if (t.permn) na = (na & ~255) + 128 * ((na >> 5) & 1) + 32 * ((na >> 6) & 3) + (na & 31);
        *(GAS v4u*)(t.WT + (size_t)na * t.K + k0 + 8 * c) = o; }
    LDS_WAIT(); asm volatile("" ::: "memory");
}

struct Args { const float* in[12]; float* out; unsigned char* ws; int ph_lo, ph_hi; int coop, pad; };
constexpr int N_PHASES = 5;

__global__ void __launch_bounds__(NWAVES * 64, 2) hybrid_fwd(Args args) {
    extern __shared__ __attribute__((aligned(16))) unsigned char lds[];
    LAS unsigned char* L = (LAS unsigned char*)lds;
    const int tid = threadIdx.x, lane = tid & 63, wave = __builtin_amdgcn_readfirstlane(tid >> 6);
    const int G = gridDim.x, bx = blockIdx.x;
    const int vcu = (G % 8 == 0) ? (bx % 8) * (G / 8) + bx / 8 : bx;
    const float* x = args.in[0]; const float* c = args.in[1]; const float* w_ada = args.in[2]; const float* b_ada = args.in[3]; const float* norm_g = args.in[4];
    const float* w_in = args.in[5]; const float* qg = args.in[6]; const float* kg = args.in[7]; const float* w_pool = args.in[8]; const float* b_pool = args.in[9];
    const float* pool_scale = args.in[10]; const float* w_out = args.in[11];
    unsigned char* ws = args.ws;
    float* mod = (float*)(ws + WS_MOD);
    bf16* Win_t = (bf16*)(ws + WS_WIN); bf16* Wout_t = (bf16*)(ws + WS_WOUT); bf16* WpT = (bf16*)(ws + WS_WPOOL);
    bf16* XN = (bf16*)(ws + WS_XN); bf16* PROJ = (bf16*)(ws + WS_PROJ); bf16* CAT = (bf16*)(ws + WS_CAT);
    const int lo = args.ph_lo, hi = args.ph_hi;
#define IN(k) (lo <= (k) && (k) < hi)
#define BOTH(k) (IN(k) && IN((k) + 1))
#if MK_COOP
    if (tid < 32) ((LAS unsigned*)(L + MISC_OFF))[tid] = 0u;
    __syncthreads();
    XcdBarrier bar = xcd_barrier_post((unsigned*)(ws + WS_CTL) + CW_BAR, (volatile LAS unsigned*)(L + MISC_OFF) + 8);
#define GRID_BAR() do { if (args.coop == 2) cg::this_grid().sync(); else xcd_barrier(bar); } while (0)
#else
#define GRID_BAR() do { } while (0)
#endif
    const int gw = vcu * NWAVES + wave, NGW = G * NWAVES;

    const bool fuse01 = BOTH(0) && (NGW * 8 == M);
    f32x4 xr_[8][4]; float xs_[8];
    if (fuse01) {
#pragma unroll
        for (int q = 0; q < 8; ++q) { const GAS f32x4* xp = (const GAS f32x4*)(x + (size_t)(gw + q * NGW) * DM) + lane;
#pragma unroll
            for (int j = 0; j < 4; ++j) xr_[q][j] = xp[64 * j]; }
    }
    if (IN(0)) { for (int rep_ = 0; rep_ < MK_REP0; ++rep_) {
        LAS float* cact = (LAS float*)L;
        LAS float* red = (LAS float*)(L + 32768);
        LAS float* scr = (LAS float*)(L + 40960 + wave * 8448);
        constexpr int I_IN = (DM / 64) * (DIN / 32), I_OUT = (DM / 64) * (DM / 32), I_P = 4 * (128 / 64) * (128 / 32), I_ALL = I_IN + I_OUT + I_P;
        auto mk_item = [&](int it) { TrItem t; int r = it;
            if (r < I_IN) { t.W = w_in; t.WT = Win_t; t.K = DM; t.N = DIN; t.item = r; t.permn = true; return t; } r -= I_IN;
            if (r < I_OUT) { t.W = w_out; t.WT = Wout_t; t.K = DM; t.N = DM; t.item = r; t.permn = false; return t; } r -= I_OUT;
            const int g = r >> 3; t.W = w_pool + (size_t)g * 16384; t.WT = WpT + (size_t)g * 16384; t.K = 128; t.N = 128; t.item = r & 7; t.permn = false; return t; };
        for (int i = tid; i < BATCH * DM; i += NWAVES * 64) { const float v = c[i]; cact[i] = v / (1.0f + __expf(-v)); }
        __syncthreads();
        for (int cgp = bx; cgp < 256; cgp += G) {
            const int kq = tid >> 2, cq = tid & 3;
            float a[8][3];
#pragma unroll
            for (int b = 0; b < 8; ++b) { a[b][0] = 0.f; a[b][1] = 0.f; a[b][2] = 0.f; }
            float wv[8][3];
#pragma unroll
            for (int kk = 0; kk < 8; ++kk) { const float* wr = w_ada + (size_t)(kq * 8 + kk) * DIN + cgp * 12 + cq * 3; wv[kk][0] = wr[0]; wv[kk][1] = wr[1]; wv[kk][2] = wr[2]; }
#pragma unroll
            for (int kk = 0; kk < 8; ++kk) { const int k = kq * 8 + kk;
#pragma unroll
                for (int b = 0; b < 8; ++b) { const float ca = cact[b * DM + k]; a[b][0] += ca * wv[kk][0]; a[b][1] += ca * wv[kk][1]; a[b][2] += ca * wv[kk][2]; } }
#pragma unroll
            for (int b = 0; b < 8; ++b)
#pragma unroll
                for (int j = 0; j < 3; ++j) { float v = a[b][j]; v += __shfl_xor(v, 4); v += __shfl_xor(v, 8); v += __shfl_xor(v, 16); v += __shfl_xor(v, 32);
                    if (lane < 4) red[wave * 96 + b * 12 + cq * 3 + j] = v; }
            __syncthreads();
            if (tid < 96) { float s = 0.f;
#pragma unroll
                for (int w = 0; w < 8; ++w) s += red[w * 96 + tid];
                const int b = tid / 12, n = cgp * 12 + tid % 12; mod[b * DIN + n] = s + b_ada[n]; }
            __syncthreads();
        }
        for (int it = gw; it < I_ALL; it += NGW) { float tv[32]; const TrItem ti = mk_item(it); tr_load(ti, tv, lane); tr_finish(ti, tv, scr, lane); }
        __syncthreads(); }
        if (BOTH(0)) GRID_BAR();
    }
    if (IN(1) && fuse01) {
#pragma unroll
        for (int q = 0; q < 8; ++q) { float t = 0.f;
#pragma unroll
            for (int j = 0; j < 4; ++j) t += (xr_[q][j].x * xr_[q][j].x + xr_[q][j].y * xr_[q][j].y) + (xr_[q][j].z * xr_[q][j].z + xr_[q][j].w * xr_[q][j].w);
            xs_[q] = t; }
#pragma unroll
        for (int q = 0; q < 8; ++q) { const int m = gw + q * NGW;
            const float* mb = mod + (size_t)(m >> 11) * DIN;
            const float inv = 1.0f / sqrtf(wave_sum(xs_[q]) * (1.0f / DM) + 1e-6f);
            GAS unsigned long long* o8 = (GAS unsigned long long*)(XN + (size_t)m * DM) + lane;
#pragma unroll
            for (int j = 0; j < 4; ++j) { const int k = 4 * lane + 256 * j;
                const f32x4 gg = *(const f32x4*)(norm_g + k), sh = *(const f32x4*)(mb + k), sc = *(const f32x4*)(mb + DM + k);
                const f32x4 y = xr_[q][j] * inv * gg * (sc + 1.0f) + sh;
                o8[64 * j] = (unsigned long long)pk2(y.x, y.y) | ((unsigned long long)pk2(y.z, y.w) << 32); } }
        if (BOTH(1)) GRID_BAR();
    } else
    if (IN(1)) { for (int rep_ = 0; rep_ < MK_REP1; ++rep_) {
        for (int m0 = gw; m0 < M; m0 += 4 * NGW) {
            f32x4 v[4][4]; float s[4];
#pragma unroll
            for (int q = 0; q < 4; ++q) { const int m = m0 + q * NGW; const GAS f32x4* xr = (const GAS f32x4*)(x + (size_t)(m < M ? m : m0) * DM) + lane;
#pragma unroll
                for (int j = 0; j < 4; ++j) v[q][j] = xr[64 * j]; }
#pragma unroll
            for (int q = 0; q < 4; ++q) { float t = 0.f;
#pragma unroll
                for (int j = 0; j < 4; ++j) t += (v[q][j].x * v[q][j].x + v[q][j].y * v[q][j].y) + (v[q][j].z * v[q][j].z + v[q][j].w * v[q][j].w);
                s[q] = t; }
#pragma unroll
            for (int q = 0; q < 4; ++q) { const int m = m0 + q * NGW; if (m >= M) break;
                const float* mb = mod + (size_t)(m >> 11) * DIN;
                const float inv = 1.0f / sqrtf(wave_sum(s[q]) * (1.0f / DM) + 1e-6f);
                GAS unsigned long long* o8 = (GAS unsigned long long*)(XN + (size_t)m * DM) + lane;
#pragma unroll
                for (int j = 0; j < 4; ++j) { const int k = 4 * lane + 256 * j;
                    const f32x4 gg = *(const f32x4*)(norm_g + k), sh = *(const f32x4*)(mb + k), sc = *(const f32x4*)(mb + DM + k);
                    const f32x4 y = v[q][j] * inv * gg * (sc + 1.0f) + sh;
                    o8[64 * j] = (unsigned long long)pk2(y.x, y.y) | ((unsigned long long)pk2(y.z, y.w) << 32); } }
        }
        }
        if (BOTH(1)) GRID_BAR();
    }
    if (IN(2)) { for (int rep_ = 0; rep_ < MK_REP2; ++rep_) {
        pg8::Gemm g{XN, Win_t, M, DIN, DM}; pg8::StaticOrder S; S.init(M, DIN, G, bx);
        pg8::EpiInProj E{PROJ, PROJ_STRIDE, qg, kg};
        pg8::gemm_phase<pg8::EpiInProj, pg8::StaticOrder, true, true>(L, g, S, E);
        }
        if (BOTH(2)) GRID_BAR();
    }
    if (IN(3)) { for (int rep_ = 0; rep_ < MK_REP3; ++rep_) {
        const bf16* Qb = PROJ; const bf16* Kb = PROJ + PROJ_STRIDE; const bf16* Vb = PROJ + 2 * PROJ_STRIDE; const bf16* GAb = PROJ + 3 * PROJ_STRIDE;
        const bf16* Ub = PROJ + 4 * PROJ_STRIDE; const bf16* GPb = PROJ + 5 * PROJ_STRIDE;
        for (int i = vcu; i < 256; i += G) {
            const int bh = i >> 2, qq = i & 3;
            if (i & 1) pool::pool_unit(i >> 2, i & 3, Ub, GPb, WpT, b_pool, pool_scale, CAT, (LAS char*)L);
            att::attn_pass<MK_EARLY>(bh >> 3, bh & 7, 16 * qq + 8, Qb, Kb, Vb, GAb, CAT, (LAS char*)L);
            att::attn_pass<MK_EARLY>(bh >> 3, bh & 7, 16 * qq, Qb, Kb, Vb, GAb, CAT, (LAS char*)L);
            VM_WAIT(); __syncthreads();
            if (!(i & 1)) pool::pool_unit(i >> 2, i & 3, Ub, GPb, WpT, b_pool, pool_scale, CAT, (LAS char*)L);
        }
        }
        if (BOTH(3)) GRID_BAR();
    }
    if (IN(4)) { for (int rep_ = 0; rep_ < MK_REP4; ++rep_) {
        pg8::Gemm g{CAT, Wout_t, M, DM, DM}; pg8::StaticOrder S; S.init(M, DM, G, bx);
        pg8::EpiOutRes E{x, args.out, mod + 2 * DM};
        pg8::gemm_phase<pg8::EpiOutRes, pg8::StaticOrder, true, true>(L, g, S, E);
    } }
#undef IN
#undef BOTH
}

extern "C" void kernel_launch(void* const* d_in, const int* in_sizes, int n_in, void* d_out, int out_size, void* d_ws, size_t ws_size, hipStream_t stream) {
    static int grid = 0;
    if (grid == 0) {
        if (n_in != 12 || out_size != M * DM || ws_size < WS_END) { fprintf(stderr, "kernel_launch: unexpected shapes (n_in %d out %d ws %zu)\n", n_in, out_size, ws_size); grid = -1; return; }
        int dev = 0, cus = 0, per_cu = 0;
        if (hipGetDevice(&dev) != hipSuccess || hipDeviceGetAttribute(&cus, hipDeviceAttributeMultiprocessorCount, dev) != hipSuccess) { grid = -1; return; }
        if (hipFuncSetAttribute((const void*)hybrid_fwd, hipFuncAttributeMaxDynamicSharedMemorySize, LDS_BYTES) != hipSuccess) { fprintf(stderr, "kernel_launch: hipFuncSetAttribute failed\n"); grid = -1; return; }
        if (hipOccupancyMaxActiveBlocksPerMultiprocessor(&per_cu, (const void*)hybrid_fwd, NWAVES * 64, LDS_BYTES) != hipSuccess || per_cu < 1) { fprintf(stderr, "kernel_launch: occupancy query says %d\n", per_cu); per_cu = 1; }
        (void)hipGetLastError();
        grid = cus;
    }
    if (grid < 0) return;
#if MK_COOP
    if (hipMemsetAsync((char*)d_ws + WS_CTL, 0, CTL_ZERO_BYTES, stream) != hipSuccess) { fprintf(stderr, "kernel_launch: hipMemsetAsync failed\n"); return; }
#endif
    Args a{};
    for (int i = 0; i < 12; ++i) a.in[i] = (const float*)d_in[i];
    a.out = (float*)d_out; a.ws = (unsigned char*)d_ws;
#if MK_COOP
    a.ph_lo = 0; a.ph_hi = N_PHASES; a.coop = 1;
    void* kargs[] = {&a};
    hipError_t e = hipLaunchCooperativeKernel((const void*)hybrid_fwd, dim3(grid), dim3(NWAVES * 64), kargs, LDS_BYTES, stream);
    if (e != hipSuccess) fprintf(stderr, "kernel_launch: cooperative launch failed: %s (grid %d)\n", hipGetErrorString(e), grid);
#else
    for (int p = 0; p < N_PHASES; ++p) { a.ph_lo = p; a.ph_hi = p + 1; a.coop = 0;
        hipLaunchKernelGGL(hybrid_fwd, dim3(grid), dim3(NWAVES * 64), LDS_BYTES, stream, a); }
#endif
}
```

```cpp
#include <hip/hip_runtime.h>
#include <hip/hip_cooperative_groups.h>
#include <cstdio>
#include <cstdint>
namespace cg = cooperative_groups;
#ifndef MK_COOP
#define MK_COOP 1
#endif
#ifndef MK_EARLY
#define MK_EARLY true
#endif
#define PG8_SP2 true
#define PG8_ALIGN true
#ifndef MK_REP0
#define MK_REP0 1
#endif
#ifndef MK_REP1
#define MK_REP1 1
#endif
#ifndef MK_REP2
#define MK_REP2 1
#endif
#ifndef MK_REP3
#define MK_REP3 1
#endif
#ifndef MK_REP4
#define MK_REP4 1
#endif
#ifndef MK_REP3A
#define MK_REP3A 1
#endif
#ifndef MK_REP3P
#define MK_REP3P 1
#endif
namespace pg8 {
#define PG8_LAS __attribute__((address_space(3)))
typedef unsigned short bf16_t;
typedef short bf16x8 __attribute__((ext_vector_type(8)));
typedef float f32x4 __attribute__((ext_vector_type(4)));
typedef unsigned u32x4 __attribute__((ext_vector_type(4)));
constexpr int BM = 256, BK = 64, HALF = 128, HTB = HALF * BK * 2  , STAGE_BYTES = 8 * HTB, NXCD = 8, WGM = 8;

__host__ __device__ __forceinline__ int lds_byte(int r, int c) { const int st = (r >> 4) * 2 + (c >> 5), rr = r & 15, cc = c & 31, ob = rr * 64 + cc * 2; return st * 1024 + (ob ^ (((ob >> 9) & 1) << 5)); }
__host__ __device__ __forceinline__ void stage_rc(int b, int& R, int& C) { const int st = b / 1024, sb = b % 1024, swz = sb ^ (((sb >> 9) & 1) << 5); R = (st >> 1) * 16 + swz / 64; C = (st & 1) * 32 + (swz % 64) / 2; }
__host__ __device__ __forceinline__ int perm32(int rho) { const int n = rho >> 4, i = rho & 15; return 8 * (i >> 2) + 4 * n + (i & 3); }

struct Unit { int pm, pn; };
struct Gemm { const bf16_t* A; const bf16_t* Bt; int M, N, K; };

struct StaticOrder {
    int nM, nN, nwg, G, c;
    __host__ __device__ void init(int M, int N, int G_, int c_) { nM = M / BM; nN = N / BM; nwg = nM * nN; G = G_; c = c_; }
    __host__ __device__ bool next(int i, Unit& u) const {
        const long L = (long)i * G + c; if (L >= nwg) return false;
        int wgid = (int)L; { const int q = nwg / NXCD, r = nwg % NXCD, xcd = wgid % NXCD, off = wgid / NXCD; wgid = (xcd < r ? xcd * (q + 1) : r * (q + 1) + (xcd - r) * q) + off; }
        const int nig = WGM * nN, gid = wgid / nig, fm = gid * WGM, gsz = (nM - fm) < WGM ? (nM - fm) : WGM;
        u.pm = fm + ((wgid % nig) % gsz); u.pn = (wgid % nig) / gsz; return true;
    }
    __device__ __forceinline__ void a_ready(const Unit&) const {}
    __device__ __forceinline__ void done(const Unit&) const {}
};
__device__ __forceinline__ unsigned cvt_pk_bf16(float lo, float hi) { unsigned r; asm volatile("v_cvt_pk_bf16_f32 %0, %1, %2" : "=v"(r) : "v"(lo), "v"(hi)); return r; }
typedef float f32x2 __attribute__((ext_vector_type(2)));
__device__ __forceinline__ float silu_f(float v) { return v * __builtin_amdgcn_rcpf(1.0f + __builtin_amdgcn_exp2f(-1.4426950408889634f * v)); }
constexpr float QSCALE = 0.125f * 1.4426950408889634f;
__device__ __forceinline__ size_t hm_off(int row, int head) { return ((size_t)((row >> 11) * 8 + head) * 2048 + (row & 2047)) * 64; }
struct EpiInProj {
    static constexpr bool PERM = true, AFTER_DRAIN = false;
    bf16_t* base; size_t stride; const float* gq; const float* gk;
    __device__ __forceinline__ void operator()(const f32x4 (&acc)[2][2][4][2], const Unit& u, int wr, int wc, int fr, int fq) const {
        const int type = u.pn >> 1;
        bf16_t* O = base + (size_t)type * stride;
        const int row0 = u.pm * BM + wr * 64 + fr;
        const int col0 = (u.pn & 1) * 256 + wc * 64 + 8 * fq;
        if (type < 2) {
            const float* g = type == 0 ? gq : gk; const float s = type == 0 ? QSCALE : 1.0f;
            f32x4 gs[2][2];
#pragma unroll
            for (int bj = 0; bj < 2; ++bj)
#pragma unroll
                for (int n = 0; n < 2; ++n) gs[bj][n] = *(const f32x4*)(g + 32 * bj + 8 * fq + 4 * n) * s;
#pragma unroll
            for (int ai = 0; ai < 2; ++ai)
#pragma unroll
                for (int m = 0; m < 4; ++m) {
                    float ss = 0.f;
#pragma unroll
                    for (int bj = 0; bj < 2; ++bj)
#pragma unroll
                        for (int n = 0; n < 2; ++n) { const f32x4 x = acc[ai][bj][m][n]; ss += (x[0] * x[0] + x[1] * x[1]) + (x[2] * x[2] + x[3] * x[3]); }
                    ss += __shfl_xor(ss, 16); ss += __shfl_xor(ss, 32);
                    const float inv = 1.0f / sqrtf(ss * (1.0f / 64.0f) + 1e-6f);
                    bf16_t* rowp = O + hm_off(row0 + ai * HALF + m * 16, (u.pn & 1) * 4 + wc) + 8 * fq;
#pragma unroll
                    for (int bj = 0; bj < 2; ++bj) { const f32x4 v0 = acc[ai][bj][m][0] * inv * gs[bj][0], v1 = acc[ai][bj][m][1] * inv * gs[bj][1];
                        u32x4 w; w.x = cvt_pk_bf16(v0[0], v0[1]); w.y = cvt_pk_bf16(v0[2], v0[3]); w.z = cvt_pk_bf16(v1[0], v1[1]); w.w = cvt_pk_bf16(v1[2], v1[3]);
                        *(u32x4*)(rowp + bj * 32) = w; }
                }
        } else {
            const bool act = (type == 3) || (type == 5);
#pragma unroll
            for (int ai = 0; ai < 2; ++ai)
#pragma unroll
                for (int m = 0; m < 4; ++m) {
                    const int row = row0 + ai * HALF + m * 16;
                    bf16_t* rowp = (type <= 3) ? O + hm_off(row, (u.pn & 1) * 4 + wc) + 8 * fq : O + ((size_t)((u.pn & 1) * 2 + (wc >> 1)) * 16384 + row) * 128 + (wc & 1) * 64 + 8 * fq;
#pragma unroll
                    for (int bj = 0; bj < 2; ++bj) { f32x4 v0 = acc[ai][bj][m][0], v1 = acc[ai][bj][m][1];
                        if (act) { v0 = (f32x4){silu_f(v0[0]), silu_f(v0[1]), silu_f(v0[2]), silu_f(v0[3])}; v1 = (f32x4){silu_f(v1[0]), silu_f(v1[1]), silu_f(v1[2]), silu_f(v1[3])}; }
                        u32x4 w; w.x = cvt_pk_bf16(v0[0], v0[1]); w.y = cvt_pk_bf16(v0[2], v0[3]); w.z = cvt_pk_bf16(v1[0], v1[1]); w.w = cvt_pk_bf16(v1[2], v1[3]);
                        *(u32x4*)(rowp + bj * 32) = w; }
                }
        }
    }
};
struct EpiOutRes {
    static constexpr bool PERM = false, AFTER_DRAIN = false;
    const float* x; float* out; const float* gate;
    __device__ __forceinline__ void operator()(const f32x4 (&acc)[2][2][4][2], const Unit& u, int wr, int wc, int fr, int fq) const {
        const int col0 = u.pn * BM + wc * 32 + 4 * fq;
        const float* gp = gate + (size_t)((u.pm * BM) >> 11) * 3072 + col0;
        f32x4 gv[2][2];
#pragma unroll
        for (int bj = 0; bj < 2; ++bj)
#pragma unroll
            for (int n = 0; n < 2; ++n) gv[bj][n] = *(const f32x4*)(gp + bj * HALF + n * 16);
#pragma unroll
        for (int ai = 0; ai < 2; ++ai)
#pragma unroll
            for (int m = 0; m < 4; ++m) { const size_t off = (size_t)(u.pm * BM + ai * HALF + wr * 64 + m * 16 + fr) * 1024 + col0;
#pragma unroll
                for (int bj = 0; bj < 2; ++bj)
#pragma unroll
                    for (int n = 0; n < 2; ++n) { const f32x4 xv = *(const f32x4*)(x + off + bj * HALF + n * 16);
                        *(f32x4*)(out + off + bj * HALF + n * 16) = xv + gv[bj][n] * acc[ai][bj][m][n]; } }
    }
};
template <class Epi, class Sched, bool ALIGN_EPI = false, bool SP2 = false>
__device__ __forceinline__ void gemm_phase(PG8_LAS unsigned char* lds, const Gemm g, const Sched& S, const Epi& E) {
    const int tid = threadIdx.x, wid = __builtin_amdgcn_readfirstlane(tid >> 6), lane = tid & 63, wr = wid >> 2, wc = wid & 3, fr = lane & 15, fq = lane >> 4;
    const int K = g.K, nt = K / BK;
    unsigned voffA[2], voffB[2];
#pragma unroll
    for (int i = 0; i < 2; ++i) { int R, C; stage_rc(tid * 16 + i * 8192, R, C); const int Rb = Epi::PERM ? ((R & ~31) + perm32(R & 31)) : R;
        voffA[i] = (unsigned)(R * K + C) * 2u; voffB[i] = (unsigned)(Rb * K + C) * 2u; }
    const size_t kstep = (size_t)(BK * 2);
    const size_t hstep = (size_t)HALF * K * 2;
    const size_t tstep = 2 * hstep;
    const unsigned ldsw = (unsigned)wid * 1024u;
    const int aoff = lds_byte(wr * 64 + fr, fq * 8), boff = lds_byte(wc * 32 + fr, fq * 8);
#define PG8_SA(b, h) (((b) * 2 + (h)) * HTB)
#define PG8_SB(b, h) ((4 + (b) * 2 + (h)) * HTB)
#define PG8_STAGE(bufoff, gbase, voff) do { _Pragma("unroll") for (int _i = 0; _i < 2; ++_i) \
        __builtin_amdgcn_global_load_lds((const unsigned*)((const char*)(gbase) + (voff)[_i]), (PG8_LAS unsigned*)(lds + (bufoff) + ldsw + _i * 8192), 16, 0, 0); } while (0)
#define PG8_LDA(dst, b, h) do { _Pragma("unroll") for (int m = 0; m < 4; ++m) _Pragma("unroll") for (int k = 0; k < 2; ++k) dst[m][k] = *(const PG8_LAS bf16x8*)(lds + PG8_SA(b, h) + aoff + m * 2048 + k * 1024); } while (0)
#define PG8_LDB(dst, b, h) do { _Pragma("unroll") for (int n = 0; n < 2; ++n) _Pragma("unroll") for (int k = 0; k < 2; ++k) dst[n][k] = *(const PG8_LAS bf16x8*)(lds + PG8_SB(b, h) + boff + n * 2048 + k * 1024); } while (0)
#define PG8_MMA(ai, bj, At, Bt) do { __builtin_amdgcn_s_setprio(1); _Pragma("unroll") for (int m = 0; m < 4; ++m) _Pragma("unroll") for (int n = 0; n < 2; ++n) _Pragma("unroll") for (int k = 0; k < 2; ++k) \
        acc[ai][bj][m][n] = __builtin_amdgcn_mfma_f32_16x16x32_bf16(Bt[n][k], At[m][k], acc[ai][bj][m][n], 0, 0, 0); __builtin_amdgcn_s_setprio(0); } while (0)
#define PG8_WAIT_V(n) asm volatile("s_waitcnt vmcnt(" #n ")" ::: "memory")
#define PG8_WAIT_L(n) asm volatile("s_waitcnt lgkmcnt(" #n ")" ::: "memory")
#define PG8_BAR __builtin_amdgcn_s_barrier()
#define PG8_SCHED __builtin_amdgcn_sched_barrier(0)
    Unit cur, nxt; int ui = 0;
    if (!S.next(0, cur)) return;
    f32x4 acc[2][2][4][2];
#pragma unroll
    for (int a = 0; a < 2; ++a)
#pragma unroll
        for (int b = 0; b < 2; ++b)
#pragma unroll
            for (int m = 0; m < 4; ++m)
#pragma unroll
                for (int n = 0; n < 2; ++n) acc[a][b][m][n] = (f32x4){0.f, 0.f, 0.f, 0.f};
    bf16x8 At[4][2], B0[2][2], B1[2][2];
    const char* cA = (const char*)g.A + (size_t)cur.pm * tstep; const char* cB = (const char*)g.Bt + (size_t)cur.pn * tstep;
    S.a_ready(cur);
    if constexpr (SP2) {
        PG8_STAGE(PG8_SB(0, 0), cB, voffB); PG8_STAGE(PG8_SB(0, 1), cB + hstep, voffB); PG8_STAGE(PG8_SA(0, 0), cA, voffA); PG8_STAGE(PG8_SA(0, 1), cA + hstep, voffA);
        if (wr == 1) PG8_BAR;
        PG8_WAIT_V(2); PG8_BAR;
        PG8_STAGE(PG8_SB(1, 0), cB + kstep, voffB); PG8_STAGE(PG8_SA(1, 0), cA + kstep, voffA); PG8_STAGE(PG8_SB(1, 1), cB + hstep + kstep, voffB);
        PG8_WAIT_V(6); PG8_BAR;
    } else {
        PG8_STAGE(PG8_SB(0, 0), cB, voffB); PG8_STAGE(PG8_SA(0, 0), cA, voffA); PG8_STAGE(PG8_SB(0, 1), cB + hstep, voffB); PG8_STAGE(PG8_SA(0, 1), cA + hstep, voffA);
        if (wr == 1) PG8_BAR;
        PG8_WAIT_V(4); PG8_BAR;
        PG8_STAGE(PG8_SB(1, 0), cB + kstep, voffB); PG8_STAGE(PG8_SA(1, 0), cA + kstep, voffA); PG8_STAGE(PG8_SB(1, 1), cB + hstep + kstep, voffB);
        PG8_WAIT_V(6); PG8_BAR;
    }
    for (;;) {
        const bool has_next = S.next(ui + 1, nxt);
        const char* nA = has_next ? (const char*)g.A + (size_t)nxt.pm * tstep : cA; const char* nB = has_next ? (const char*)g.Bt + (size_t)nxt.pn * tstep : cB;
        for (int t = 0; t < nt; t += 2) {
            const bool last = (t == nt - 2);
            const char* a1 = cA + (size_t)(t + 1) * kstep;
            const char* a2 = last ? nA : cA + (size_t)(t + 2) * kstep; const char* b2 = last ? nB : cB + (size_t)(t + 2) * kstep;
            const char* a3 = a2 + kstep; const char* b3 = b2 + kstep;
            if (last && has_next) S.a_ready(nxt);
            if constexpr (SP2) {
            PG8_LDB(B0, 0, 0); PG8_LDB(B1, 0, 1); PG8_SCHED; PG8_LDA(At, 0, 0); PG8_STAGE(PG8_SA(1, 1), a1 + hstep, voffA);
            PG8_WAIT_V(8); PG8_WAIT_L(0); PG8_BAR; PG8_MMA(0, 0, At, B0); PG8_MMA(0, 1, At, B1); PG8_BAR; PG8_SCHED;
            PG8_LDA(At, 0, 1); PG8_STAGE(PG8_SB(0, 0), b2, voffB); PG8_STAGE(PG8_SB(0, 1), b2 + hstep, voffB); PG8_STAGE(PG8_SA(0, 0), a2, voffA);
            PG8_WAIT_V(8); PG8_WAIT_L(0); PG8_BAR; PG8_MMA(1, 0, At, B0); PG8_MMA(1, 1, At, B1); PG8_BAR; PG8_SCHED;
            PG8_LDB(B0, 1, 0); PG8_LDB(B1, 1, 1); PG8_SCHED; PG8_LDA(At, 1, 0); PG8_STAGE(PG8_SA(0, 1), a2 + hstep, voffA);
            PG8_WAIT_V(8); PG8_WAIT_L(0); PG8_BAR; PG8_MMA(0, 0, At, B0); PG8_MMA(0, 1, At, B1); PG8_BAR; PG8_SCHED;
            PG8_LDA(At, 1, 1); PG8_STAGE(PG8_SB(1, 0), b3, voffB); PG8_STAGE(PG8_SB(1, 1), b3 + hstep, voffB); PG8_STAGE(PG8_SA(1, 0), a3, voffA);
            PG8_WAIT_V(8); PG8_WAIT_L(0); PG8_BAR; PG8_MMA(1, 0, At, B0); PG8_MMA(1, 1, At, B1); PG8_BAR; PG8_SCHED;
            } else {
            PG8_LDB(B0, 0, 0); PG8_SCHED; PG8_LDA(At, 0, 0); PG8_STAGE(PG8_SA(1, 1), a1 + hstep, voffA);
            PG8_WAIT_L(8); PG8_BAR; PG8_WAIT_L(0); PG8_MMA(0, 0, At, B0); PG8_BAR; PG8_SCHED;
            PG8_LDB(B1, 0, 1); PG8_STAGE(PG8_SB(0, 0), b2, voffB);
            PG8_BAR; PG8_WAIT_L(0); PG8_MMA(0, 1, At, B1); PG8_BAR;
            PG8_LDA(At, 0, 1); PG8_STAGE(PG8_SA(0, 0), a2, voffA);
            PG8_BAR; PG8_WAIT_L(0); PG8_MMA(1, 0, At, B0); PG8_BAR; PG8_SCHED;
            PG8_STAGE(PG8_SB(0, 1), b2 + hstep, voffB);
            PG8_WAIT_V(6); PG8_BAR; PG8_MMA(1, 1, At, B1); PG8_BAR;
            PG8_LDB(B0, 1, 0); PG8_SCHED; PG8_LDA(At, 1, 0); PG8_STAGE(PG8_SA(0, 1), a2 + hstep, voffA);
            PG8_WAIT_L(8); PG8_BAR; PG8_WAIT_L(0); PG8_MMA(0, 0, At, B0); PG8_BAR; PG8_SCHED;
            PG8_LDB(B1, 1, 1); PG8_STAGE(PG8_SB(1, 0), b3, voffB);
            PG8_BAR; PG8_WAIT_L(0); PG8_MMA(0, 1, At, B1); PG8_BAR;
            PG8_LDA(At, 1, 1); PG8_STAGE(PG8_SA(1, 0), a3, voffA);
            PG8_BAR; PG8_WAIT_L(0); PG8_MMA(1, 0, At, B0); PG8_BAR; PG8_SCHED;
            PG8_STAGE(PG8_SB(1, 1), b3 + hstep, voffB);
            PG8_WAIT_V(6); PG8_BAR; PG8_MMA(1, 1, At, B1); PG8_BAR;
            }
        }
        if constexpr (ALIGN_EPI) { if (wr == 0) PG8_BAR; }
        if constexpr (!Epi::AFTER_DRAIN) { E(acc, cur, wr, wc, fr, fq); S.done(cur); }
        if (!has_next) break;
#pragma unroll
        for (int a = 0; a < 2; ++a)
#pragma unroll
            for (int b = 0; b < 2; ++b)
#pragma unroll
                for (int m = 0; m < 4; ++m)
#pragma unroll
                    for (int n = 0; n < 2; ++n) acc[a][b][m][n] = (f32x4){0.f, 0.f, 0.f, 0.f};
        cur = nxt; cA = nA; cB = nB; ++ui;
        if constexpr (ALIGN_EPI) { if (wr == 1) PG8_BAR; }
    }
    PG8_WAIT_V(0);
    if constexpr (!ALIGN_EPI) { if (wr == 0) PG8_BAR; }
    PG8_BAR;
    if constexpr (Epi::AFTER_DRAIN) { E.fused(acc, cur, wr, wc, fr, fq, lds, wid, lane); S.done(cur); }
#undef PG8_SA
#undef PG8_SB
#undef PG8_STAGE
#undef PG8_LDA
#undef PG8_LDB
#undef PG8_MMA
#undef PG8_WAIT_V
#undef PG8_WAIT_L
#undef PG8_BAR
#undef PG8_SCHED
}
}

constexpr int NWAVES = 8;
constexpr int BATCH = 8, SEQ = 2048, DM = 1024, M = BATCH * SEQ, DIN = 3072, DH = 64, NH = 8, DA = 512;
constexpr size_t MiB = 1u << 20;
constexpr size_t WS_CTL = 0, CTL_ZERO_BYTES = 64 * 1024;
constexpr size_t WS_MOD = 1 * MiB;
constexpr size_t WS_WIN = 2 * MiB;
constexpr size_t WS_WOUT = 8 * MiB;
constexpr size_t WS_WPOOL = 10 * MiB;
constexpr size_t WS_XN = 16 * MiB;
constexpr size_t WS_PROJ = 48 * MiB;
constexpr size_t PROJ_STRIDE = (size_t)M * 512;
constexpr size_t WS_CAT = 144 * MiB;
constexpr size_t WS_END = 176 * MiB;
constexpr int RING_BYTES = 131072, LDS_BYTES = 147456, MISC_OFF = LDS_BYTES - 128;
constexpr int CW_BAR = 1024;

#define GAS __attribute__((address_space(1)))
#define LAS __attribute__((address_space(3)))
typedef unsigned short bf16;
typedef unsigned v4u __attribute__((ext_vector_type(4)));
typedef unsigned v2u __attribute__((ext_vector_type(2)));
typedef float f32x4 __attribute__((ext_vector_type(4)));
typedef float f32x16 __attribute__((ext_vector_type(16)));
typedef short bf16x8 __attribute__((ext_vector_type(8)));
typedef short s16x4 __attribute__((ext_vector_type(4)));
#define LDS_WAIT() asm volatile("s_waitcnt lgkmcnt(0)" ::: "memory")
#define VM_WAIT() asm volatile("s_waitcnt vmcnt(0)" ::: "memory")
__device__ __forceinline__ unsigned pk2(float lo, float hi) { return pg8::cvt_pk_bf16(lo, hi); }
__device__ __forceinline__ float bf_lo(unsigned u) { return __builtin_bit_cast(float, u << 16); }
__device__ __forceinline__ float bf_hi(unsigned u) { return __builtin_bit_cast(float, u & 0xffff0000u); }
#define XB_TMO      128
#define XB_XCNT(j)  (256  + 64 * (j))
#define XB_XSUB(j)  (1280 + 64 * (j))
#define XB_XGEN(j)  (2304 + 64 * (j))
#define XB_TOP      3328
#define XB_TOPGEN   3392
#define XCD_BAR_WORDS 3456
#define XB_SPIN_CAP (1u << 18)

__device__ __forceinline__ unsigned xb_ld(unsigned* p)              { return __hip_atomic_load(p, __ATOMIC_RELAXED, __HIP_MEMORY_SCOPE_AGENT); }
__device__ __forceinline__ unsigned xb_add(unsigned* p, unsigned v) { return __hip_atomic_fetch_add(p, v, __ATOMIC_RELAXED, __HIP_MEMORY_SCOPE_AGENT); }
__device__ __forceinline__ unsigned xb_xcc_id() { return (unsigned)__builtin_amdgcn_s_getreg((3 << 11) | 20) & 0xFu; }
#define XB_SPIN(cond, bar) do { unsigned _sp = 0; while (cond) { __builtin_amdgcn_s_sleep(1); \
    if ((++_sp & 255u) == 0u) { if (xb_ld(&(bar)[XB_TMO])) break; if (_sp > XB_SPIN_CAP) { atomicAdd(&(bar)[XB_TMO], 1u); break; } } } } while (0)

struct XcdBarrier {
    unsigned* bar; unsigned x;
    volatile LAS unsigned* st;
};

__device__ __forceinline__ XcdBarrier xcd_barrier_post(unsigned* bar, volatile LAS unsigned* st) {
    XcdBarrier b; b.bar = bar; b.x = xb_xcc_id(); b.st = st;
    if (threadIdx.x == 0) (void)xb_add(&bar[XB_XCNT(b.x)], 1u);
    return b;
}
__device__ __forceinline__ void xcd_barrier_complete(unsigned* bar, unsigned x, unsigned& nloc, unsigned& nx) {
    const unsigned G = gridDim.x * gridDim.y * gridDim.z;
    unsigned sum, cnt, mine, sp = 0u;
    for (;;) {
        sum = 0u; cnt = 0u; mine = 0u;
#pragma unroll
        for (unsigned j = 0; j < 16; ++j) { const unsigned c = xb_ld(&bar[XB_XCNT(j)]); sum += c; cnt += (c > 0u) ? 1u : 0u; mine = (j == x) ? c : mine; }
        if (sum == G) break;
        __builtin_amdgcn_s_sleep(1);
        if ((++sp & 255u) == 0u) { if (xb_ld(&bar[XB_TMO])) break; if (sp > XB_SPIN_CAP) { atomicAdd(&bar[XB_TMO], 1u); break; } }
    }
    nloc = mine > 0u ? mine : 1u; nx = cnt > 0u ? cnt : 1u;
}

__device__ __forceinline__ void xcd_barrier(const XcdBarrier& b) {
    asm volatile("s_waitcnt vmcnt(0)" ::: "memory");
    __syncthreads();
    if (threadIdx.x == 0) {
        unsigned* bar = b.bar;
        __builtin_amdgcn_s_waitcnt(0);
        unsigned nloc = b.st[0], nx = b.st[1];
        if (nloc == 0u) { xcd_barrier_complete(bar, b.x, nloc, nx); b.st[0] = nloc; b.st[1] = nx; }
        const unsigned old = xb_add(&bar[XB_XSUB(b.x)], 1u);
        const unsigned gen = old / nloc;
        if (old + 1u == (gen + 1u) * nloc) {
            __builtin_amdgcn_fence(__ATOMIC_RELEASE, "agent");
            asm volatile("s_waitcnt vmcnt(0)" ::: "memory");
            const unsigned og = xb_add(&bar[XB_TOP], 1u);
            const unsigned tg = og / nx;
            if (og + 1u == (tg + 1u) * nx) xb_add(&bar[XB_TOPGEN], 1u);
            else XB_SPIN(xb_ld(&bar[XB_TOPGEN]) == tg, bar);
            __builtin_amdgcn_fence(__ATOMIC_ACQUIRE, "agent");
            xb_add(&bar[XB_XGEN(b.x)], 1u);
            asm volatile("s_waitcnt vmcnt(0)" ::: "memory");
        } else {
            XB_SPIN(xb_ld(&bar[XB_XGEN(b.x)]) == gen, bar);
            __builtin_amdgcn_fence(__ATOMIC_ACQUIRE, "agent");
            asm volatile("s_waitcnt vmcnt(0)" ::: "memory");
        }
    }
    __syncthreads();
}

namespace att {
__device__ __forceinline__ void glds16(const void* gsrc, unsigned lds_dst) { unsigned keep;
    asm volatile("s_mov_b32 %0, m0\n\ts_mov_b32 m0, %2\n\ts_nop 0\n\tglobal_load_lds_dwordx4 %1, off\n\ts_mov_b32 m0, %0" : "=&s"(keep) : "v"(gsrc), "s"(lds_dst) : "memory"); }
typedef short v4i16_t __attribute__((ext_vector_type(4)));
__device__ __forceinline__ s16x4 vtr(LAS const char* p) { return __builtin_bit_cast(s16x4, __builtin_amdgcn_ds_read_tr16_b64_v4i16((LAS v4i16_t*)p)); }
constexpr int TILEB = 8192, VOFF = 4096, STAGE_OFF = 12 * TILEB, STAGE_B = 4608;
#ifndef ATT_HIST
#define ATT_HIST 4
#endif

__device__ __forceinline__ void tile_weights(f32x16& p0, float& carry, unsigned (&pw)[2][4], bool diag, int kv0, int qabs, int hi) {
    float G[4];
#pragma unroll
    for (int i = 0; i < 4; ++i) {
        float rr[4], be[4];
#pragma unroll
        for (int j = 0; j < 4; ++j) {
            const float e = __builtin_amdgcn_exp2f(p0[4 * i + j]);
            float rv = __builtin_amdgcn_rcpf(1.0f + e); float bv = e * rv;
            if (diag) { const int kv = kv0 + 8 * i + 4 * hi + j; if (kv >= qabs) { rv = 1.0f; bv = 0.0f; } }
            rr[j] = rv; be[j] = bv;
        }
        const float s2 = rr[3], s1 = s2 * rr[2], s0 = s1 * rr[1];
        G[i] = s0 * rr[0];
        p0[4 * i + 3] = be[3]; p0[4 * i + 2] = be[2] * s2; p0[4 * i + 1] = be[1] * s1; p0[4 * i] = be[0] * s0;
    }
    float F[4]; float run = carry;
#pragma unroll
    for (int p = 3; p >= 0; --p) {
        auto sw = __builtin_amdgcn_permlane32_swap(__float_as_uint(G[p]), __float_as_uint(G[p]), false, false);
        const float g0 = __uint_as_float(sw[0]), g1 = __uint_as_float(sw[1]);
        F[p] = run * (hi ? 1.0f : g1);
        run = run * (g0 * g1);
    }
    carry = run;
#pragma unroll
    for (int i = 0; i < 4; ++i) { const float f = F[i];
        pw[i >> 1][2 * (i & 1)] = pk2(p0[4 * i] * f, p0[4 * i + 1] * f); pw[i >> 1][2 * (i & 1) + 1] = pk2(p0[4 * i + 2] * f, p0[4 * i + 3] * f); }
}

template <bool EARLY>
__device__ __forceinline__ void attn_pass(int b, int h, int qb0, const bf16* Q, const bf16* K, const bf16* V, const bf16* GA, bf16* CAT, LAS char* shm) {
    const int tid = threadIdx.x, lane = tid & 63, r32 = lane & 31, hi = lane >> 5; const int wid = __builtin_amdgcn_readfirstlane(tid >> 6);
    const size_t hb = ((size_t)(b * NH + h) * SEQ) * DH;
    const bf16* Qh = Q + hb; const bf16* Kh = K + hb; const bf16* Vh = V + hb;
    const unsigned lds0 = (unsigned)__builtin_amdgcn_readfirstlane((int)(unsigned)(uintptr_t)shm);
    const int wb = qb0 - ATT_HIST > 0 ? qb0 - ATT_HIST : 0, nw = qb0 + 8 - wb;
    const bf16* ksrc = Kh + (size_t)(lane >> 3) * DH + (((lane & 7) ^ ((lane >> 3) & 7)) * 8);
    const bf16* vsrc = Vh + (size_t)(lane >> 2) * DH + (lane & 3) * 8;
    for (int p = wid; p < nw * 8; p += NWAVES) {
        const int w = p >> 3, pc = p & 7; const size_t trow = (size_t)(wb + w) * 32;
        const unsigned dst = lds0 + w * TILEB + pc * 1024;
        if (pc < 4) glds16(ksrc + (trow + 8 * pc) * DH, dst);
        else glds16(vsrc + (trow + 16 * ((pc - 4) & 1)) * DH + 32 * ((pc - 4) >> 1), dst);
    }
    const int qblk = qb0 + wid, q0 = qblk * 32, qabs = q0 + r32;
    bf16x8 qr[4];
#pragma unroll
    for (int d0 = 0; d0 < 4; ++d0) qr[d0] = *reinterpret_cast<const bf16x8*>(&Qh[(size_t)qabs * DH + d0 * 16 + hi * 8]);
    const size_t tok0 = (size_t)b * SEQ + q0;
    v4u gpre[2][2];
#pragma unroll
    for (int dh = 0; dh < 2; ++dh)
#pragma unroll
        for (int k = 0; k < 2; ++k) gpre[dh][k] = *(const v4u*)(GA + hb + (size_t)(q0 + 16 * k + (lane >> 2)) * DH + 32 * dh + (lane & 3) * 8);
    asm volatile("s_waitcnt vmcnt(0)" ::: "memory");
    __syncthreads();
    f32x16 o[2]; o[0] = f32x16{}; o[1] = f32x16{};
    float carry = 1.0f; bool dead = false;
    LAS const char* kp0 = shm + r32 * 128;
    LAS const char* vp0 = shm + VOFF + ((lane >> 4) & 1) * 32 + (lane & 3) * 8 + (4 * hi + ((lane & 15) >> 2)) * 64;
    int t = qblk;
    for (; t >= wb; --t) {
        const int w = t - wb;
        LAS const char* kp = kp0 + w * TILEB;
        f32x16 p0 = f32x16{};
#pragma unroll
        for (int d0 = 0; d0 < 4; ++d0) {
            const bf16x8 kf = *(LAS const bf16x8*)(kp + (((2 * d0 + hi) ^ (r32 & 7)) * 16));
            p0 = __builtin_amdgcn_mfma_f32_32x32x16_bf16(kf, qr[d0], p0, 0, 0, 0);
        }
        unsigned pw[2][4];
        tile_weights(p0, carry, pw, t == qblk, t * 32, qabs, hi);
        LAS const char* vp = vp0 + w * TILEB;
#pragma unroll
        for (int dh = 0; dh < 2; ++dh)
#pragma unroll
            for (int ks = 0; ks < 2; ++ks) {
                const s16x4 lo = vtr(vp + dh * 2048 + ks * 1024), hh = vtr(vp + dh * 2048 + ks * 1024 + 512);
                const bf16x8 vf = (bf16x8){lo[0], lo[1], lo[2], lo[3], hh[0], hh[1], hh[2], hh[3]};
                const v4u pwv = (v4u){pw[ks][0], pw[ks][1], pw[ks][2], pw[ks][3]};
                o[dh] = __builtin_amdgcn_mfma_f32_32x32x16_bf16(vf, __builtin_bit_cast(bf16x8, pwv), o[dh], 0, 0, 0);
            }
        if (EARLY) { if (__all(carry < 1e-30f)) { dead = true; break; } }
    }
    if (!dead) {
        for (t = wb - 1; t >= 0; --t) {
            f32x16 p0 = f32x16{};
#pragma unroll
            for (int d0 = 0; d0 < 4; ++d0) {
                const bf16x8 kf = *reinterpret_cast<const bf16x8*>(&Kh[((size_t)t * 32 + r32) * DH + (2 * d0 + hi) * 8]);
                p0 = __builtin_amdgcn_mfma_f32_32x32x16_bf16(kf, qr[d0], p0, 0, 0, 0);
            }
            unsigned pw[2][4];
            tile_weights(p0, carry, pw, false, t * 32, qabs, hi);
#pragma unroll
            for (int dh = 0; dh < 2; ++dh)
#pragma unroll
                for (int ks = 0; ks < 2; ++ks) {
                    bf16x8 vf;
#pragma unroll
                    for (int j = 0; j < 8; ++j) vf[j] = (short)Vh[((size_t)t * 32 + 16 * ks + 8 * (j >> 2) + 4 * hi + (j & 3)) * DH + 32 * dh + r32];
                    const v4u pwv = (v4u){pw[ks][0], pw[ks][1], pw[ks][2], pw[ks][3]};
                    o[dh] = __builtin_amdgcn_mfma_f32_32x32x16_bf16(vf, __builtin_bit_cast(bf16x8, pwv), o[dh], 0, 0, 0);
                }
            if (EARLY) { if (__all(carry < 1e-30f)) break; }
        }
    }
    {
        LAS char* st = shm + STAGE_OFF + wid * STAGE_B;
        const int rr = lane >> 2, ch = lane & 3;
#pragma unroll
        for (int dh = 0; dh < 2; ++dh) {
#pragma unroll
            for (int i = 0; i < 4; ++i) *(LAS f32x4*)(st + r32 * 144 + (8 * i + 4 * hi) * 4) = (f32x4){o[dh][4 * i], o[dh][4 * i + 1], o[dh][4 * i + 2], o[dh][4 * i + 3]};
            asm volatile("s_waitcnt lgkmcnt(0)" ::: "memory");
#pragma unroll
            for (int k = 0; k < 2; ++k) { const int row = 16 * k + rr;
                const f32x4 a0 = *(LAS const f32x4*)(st + row * 144 + ch * 32), a1 = *(LAS const f32x4*)(st + row * 144 + ch * 32 + 16);
                const v4u g = gpre[dh][k];
                v4u w; w.x = pk2(a0[0] * bf_lo(g.x), a0[1] * bf_hi(g.x)); w.y = pk2(a0[2] * bf_lo(g.y), a0[3] * bf_hi(g.y));
                w.z = pk2(a1[0] * bf_lo(g.z), a1[1] * bf_hi(g.z)); w.w = pk2(a1[2] * bf_lo(g.w), a1[3] * bf_hi(g.w));
                *(v4u*)(CAT + (tok0 + row) * DM + h * DH + 32 * dh + ch * 8) = w; }
            asm volatile("s_waitcnt lgkmcnt(0)" ::: "memory");
        }
    }
    __syncthreads();
}
}

namespace pool {
constexpr int UP = 272;
constexpr int WOFF = 73728;
template <int WIN>
__device__ __forceinline__ void pool_unit_w(int pm, int g, const bf16* U, const bf16* GP, const bf16* WpT, const float* bp, const float* ps, bf16* CAT, LAS char* shm) {
    const int tid = threadIdx.x, lane = tid & 63, r32 = lane & 31, hi = lane >> 5; const int wid = __builtin_amdgcn_readfirstlane(tid >> 6);
    const int t0 = pm * 256, tpos0 = t0 & (SEQ - 1);
    v4u tu[9], tw[4];
#pragma unroll
    for (int k = 0; k < 9; ++k) { const int c = tid + k * 512, row = c >> 4, ch = c & 15; tu[k] = (v4u){0u, 0u, 0u, 0u};
        if (c < 271 * 16 && tpos0 - 15 + row >= 0) tu[k] = *(const v4u*)(U + ((size_t)g * M + (t0 - 15 + row)) * 128 + ch * 8); }
#pragma unroll
    for (int k = 0; k < 4; ++k) { const int c = tid + k * 512; tw[k] = *(const v4u*)(WpT + (size_t)g * 16384 + (size_t)c * 8); }
#pragma unroll
    for (int k = 0; k < 9; ++k) { const int c = tid + k * 512, row = c >> 4, ch = c & 15; if (c < 271 * 16) *(LAS v4u*)(shm + row * UP + ch * 16) = tu[k]; }
#pragma unroll
    for (int k = 0; k < 4; ++k) { const int c = tid + k * 512, row = c >> 4, ch = c & 15; *(LAS v4u*)(shm + WOFF + row * UP + ch * 16) = tw[k]; }
    __syncthreads();
    v4u gpre[2][4];
#pragma unroll
    for (int half = 0; half < 2; ++half)
#pragma unroll
        for (int k = 0; k < 4; ++k) gpre[half][k] = *(const v4u*)(GP + ((size_t)g * M + t0 + wid * 32 + 8 * k + (lane >> 3)) * 128 + 64 * half + (lane & 7) * 8);
    const int r = wid * 32 + r32, tpos = tpos0 + r;
    const float inv = 1.0f / (float)(tpos + 1 < WIN ? tpos + 1 : WIN);
    f32x16 acc[4]; acc[0] = f32x16{}; acc[1] = f32x16{}; acc[2] = f32x16{}; acc[3] = f32x16{};
    LAS const char* wl = shm + WOFF + r32 * UP + 16 * hi;
#pragma unroll 2
    for (int s = 0; s < 8; ++s) {
        LAS const char* up = shm + (r + 15) * UP + (16 * s + 8 * hi) * 2;
        const v4u ut = *(LAS const v4u*)up;
        float sum[8] = {bf_lo(ut.x), bf_hi(ut.x), bf_lo(ut.y), bf_hi(ut.y), bf_lo(ut.z), bf_hi(ut.z), bf_lo(ut.w), bf_hi(ut.w)};
        float tk[8];
#pragma unroll
        for (int j = 0; j < 8; ++j) tk[j] = sum[j];
#pragma unroll
        for (int i = 1; i < WIN; ++i) { const v4u v = *(LAS const v4u*)(up - i * UP);
            sum[0] += bf_lo(v.x); sum[1] += bf_hi(v.x); sum[2] += bf_lo(v.y); sum[3] += bf_hi(v.y); sum[4] += bf_lo(v.z); sum[5] += bf_hi(v.z); sum[6] += bf_lo(v.w); sum[7] += bf_hi(v.w); }
        v4u pf; pf.x = pk2(sum[0] * inv - tk[0], sum[1] * inv - tk[1]); pf.y = pk2(sum[2] * inv - tk[2], sum[3] * inv - tk[3]);
        pf.z = pk2(sum[4] * inv - tk[4], sum[5] * inv - tk[5]); pf.w = pk2(sum[6] * inv - tk[6], sum[7] * inv - tk[7]);
        const bf16x8 pfr = __builtin_bit_cast(bf16x8, pf);
#pragma unroll
        for (int n = 0; n < 4; ++n) { const bf16x8 wf = *(LAS const bf16x8*)(wl + n * 32 * UP + 32 * s);
            acc[n] = __builtin_amdgcn_mfma_f32_32x32x16_bf16(wf, pfr, acc[n], 0, 0, 0); }
    }
    __syncthreads();
    {
        LAS char* st = shm + wid * 16384;
        const size_t tokw = (size_t)t0 + wid * 32;
        const int rr = lane >> 3, ch = lane & 7;
#pragma unroll
        for (int half = 0; half < 2; ++half) {
#pragma unroll
            for (int nn = 0; nn < 2; ++nn)
#pragma unroll
                for (int i = 0; i < 4; ++i) { const int n = 2 * half + nn;
                    *(LAS f32x4*)(st + r32 * 272 + (32 * nn + 8 * i + 4 * hi) * 4) = (f32x4){acc[n][4 * i], acc[n][4 * i + 1], acc[n][4 * i + 2], acc[n][4 * i + 3]}; }
            asm volatile("s_waitcnt lgkmcnt(0)" ::: "memory");
            const int col = g * 128 + 64 * half + ch * 8;
            const f32x4 b0 = *(const f32x4*)(bp + col), b1 = *(const f32x4*)(bp + col + 4), s0 = *(const f32x4*)(ps + col), s1 = *(const f32x4*)(ps + col + 4);
#pragma unroll
            for (int k = 0; k < 4; ++k) { const int row = 8 * k + rr;
                const f32x4 a0 = (*(LAS const f32x4*)(st + row * 272 + ch * 32) + b0) * s0, a1 = (*(LAS const f32x4*)(st + row * 272 + ch * 32 + 16) + b1) * s1;
                const v4u gv = gpre[half][k];
                v4u w; w.x = pk2(a0[0] * bf_lo(gv.x), a0[1] * bf_hi(gv.x)); w.y = pk2(a0[2] * bf_lo(gv.y), a0[3] * bf_hi(gv.y));
                w.z = pk2(a1[0] * bf_lo(gv.z), a1[1] * bf_hi(gv.z)); w.w = pk2(a1[2] * bf_lo(gv.w), a1[3] * bf_hi(gv.w));
                *(v4u*)(CAT + (tokw + row) * DM + 512 + col) = w; }
            asm volatile("s_waitcnt lgkmcnt(0)" ::: "memory");
        }
    }
    __syncthreads();
}
__device__ __forceinline__ void pool_unit(int pm, int g, const bf16* U, const bf16* GP, const bf16* WpT, const float* bp, const float* ps, bf16* CAT, LAS char* shm) {
    if (g == 0) pool_unit_w<2>(pm, g, U, GP, WpT, bp, ps, CAT, shm);
    else if (g == 1) pool_unit_w<4>(pm, g, U, GP, WpT, bp, ps, CAT, shm);
    else if (g == 2) pool_unit_w<8>(pm, g, U, GP, WpT, bp, ps, CAT, shm);
    else pool_unit_w<16>(pm, g, U, GP, WpT, bp, ps, CAT, shm);
}
}

__device__ __forceinline__ float wave_sum(float v) {
#pragma unroll
    for (int o = 1; o < 64; o <<= 1) v += __shfl_xor(v, o);
    return v;
}
struct TrItem { const float* W; bf16* WT; int K, N, item; bool permn; };
__device__ __forceinline__ void tr_load(const TrItem& t, float (&v)[32], int lane) {
    const int nblk = t.N / 32, kb = t.item / nblk, nb = t.item % nblk, k0 = 64 * kb, n0 = 32 * nb;
#pragma unroll
    for (int i = 0; i < 32; ++i) { const int kk = 2 * i + (lane >> 5); v[i] = t.W[(size_t)(k0 + kk) * t.N + n0 + (lane & 31)]; }
}
__device__ __forceinline__ void tr_finish(const TrItem& t, const float (&v)[32], LAS float* scr, int lane) {
    const int nblk = t.N / 32, kb = t.item / nblk, nb = t.item % nblk, k0 = 64 * kb, n0 = 32 * nb;
#pragma unroll
    for (int i = 0; i < 32; ++i) { const int kk = 2 * i + (lane >> 5); scr[kk * 33 + (lane & 31)] = v[i]; }
    LDS_WAIT(); asm volatile("" ::: "memory");
    const int c = lane & 7;
#pragma unroll
    for (int j = 0; j < 4; ++j) { const int n = (lane >> 3) + 8 * j; const LAS float* s = scr + (8 * c) * 33 + n;
        v4u o; o.x = pk2(s[0 * 33], s[1 * 33]); o.y = pk2(s[2 * 33], s[3 * 33]); o.z = pk2(s[4 * 33], s[5 * 33]); o.w = pk2(s[6 * 33], s[7 * 33]);
        int na = n0 + n;
        if (t.permn) na = (na & ~255) + 128 * ((na >> 5) & 1) + 32 * ((na >> 6) & 3) + (na & 31);
        *(GAS v4u*)(t.WT + (size_t)na * t.K + k0 + 8 * c) = o; }
    LDS_WAIT(); asm volatile("" ::: "memory");
}

struct Args { const float* in[12]; float* out; unsigned char* ws; int ph_lo, ph_hi; int coop, pad; };
constexpr int N_PHASES = 5;

__global__ void __launch_bounds__(NWAVES * 64, 2) hybrid_fwd(Args args) {
    extern __shared__ __attribute__((aligned(16))) unsigned char lds[];
    LAS unsigned char* L = (LAS unsigned char*)lds;
    const int tid = threadIdx.x, lane = tid & 63, wave = __builtin_amdgcn_readfirstlane(tid >> 6);
    const int G = gridDim.x, bx = blockIdx.x;
    const int vcu = (G % 8 == 0) ? (bx % 8) * (G / 8) + bx / 8 : bx;
    const float* x = args.in[0]; const float* c = args.in[1]; const float* w_ada = args.in[2]; const float* b_ada = args.in[3]; const float* norm_g = args.in[4];
    const float* w_in = args.in[5]; const float* qg = args.in[6]; const float* kg = args.in[7]; const float* w_pool = args.in[8]; const float* b_pool = args.in[9];
    const float* pool_scale = args.in[10]; const float* w_out = args.in[11];
    unsigned char* ws = args.ws;
    float* mod = (float*)(ws + WS_MOD);
    bf16* Win_t = (bf16*)(ws + WS_WIN); bf16* Wout_t = (bf16*)(ws + WS_WOUT); bf16* WpT = (bf16*)(ws + WS_WPOOL);
    bf16* XN = (bf16*)(ws + WS_XN); bf16* PROJ = (bf16*)(ws + WS_PROJ); bf16* CAT = (bf16*)(ws + WS_CAT);
    const int lo = args.ph_lo, hi = args.ph_hi;
#define IN(k) (lo <= (k) && (k) < hi)
#define BOTH(k) (IN(k) && IN((k) + 1))
#if MK_COOP
    if (tid < 32) ((LAS unsigned*)(L + MISC_OFF))[tid] = 0u;
    __syncthreads();
    XcdBarrier bar = xcd_barrier_post((unsigned*)(ws + WS_CTL) + CW_BAR, (volatile LAS unsigned*)(L + MISC_OFF) + 8);
#define GRID_BAR() do { if (args.coop == 2) cg::this_grid().sync(); else xcd_barrier(bar); } while (0)
#else
#define GRID_BAR() do { } while (0)
#endif
    const int gw = vcu * NWAVES + wave, NGW = G * NWAVES;

    const bool fuse01 = BOTH(0) && (NGW * 8 == M);
    f32x4 xr_[8][4]; float xs_[8];
    if (fuse01) {
#pragma unroll
        for (int q = 0; q < 8; ++q) { const GAS f32x4* xp = (const GAS f32x4*)(x + (size_t)(gw + q * NGW) * DM) + lane;
#pragma unroll
            for (int j = 0; j < 4; ++j) xr_[q][j] = xp[64 * j]; }
    }
    if (IN(0)) { for (int rep_ = 0; rep_ < MK_REP0; ++rep_) {
        LAS float* cact = (LAS float*)L;
        LAS float* red = (LAS float*)(L + 32768);
        LAS float* scr = (LAS float*)(L + 40960 + wave * 8448);
        constexpr int I_IN = (DM / 64) * (DIN / 32), I_OUT = (DM / 64) * (DM / 32), I_P = 4 * (128 / 64) * (128 / 32), I_ALL = I_IN + I_OUT + I_P;
        auto mk_item = [&](int it) { TrItem t; int r = it;
            if (r < I_IN) { t.W = w_in; t.WT = Win_t; t.K = DM; t.N = DIN; t.item = r; t.permn = true; return t; } r -= I_IN;
            if (r < I_OUT) { t.W = w_out; t.WT = Wout_t; t.K = DM; t.N = DM; t.item = r; t.permn = false; return t; } r -= I_OUT;
            const int g = r >> 3; t.W = w_pool + (size_t)g * 16384; t.WT = WpT + (size_t)g * 16384; t.K = 128; t.N = 128; t.item = r & 7; t.permn = false; return t; };
        for (int i = tid; i < BATCH * DM; i += NWAVES * 64) { const float v = c[i]; cact[i] = v / (1.0f + __expf(-v)); }
        __syncthreads();
        for (int cgp = bx; cgp < 256; cgp += G) {
            const int kq = tid >> 2, cq = tid & 3;
            float a[8][3];
#pragma unroll
            for (int b = 0; b < 8; ++b) { a[b][0] = 0.f; a[b][1] = 0.f; a[b][2] = 0.f; }
            float wv[8][3];
#pragma unroll
            for (int kk = 0; kk < 8; ++kk) { const float* wr = w_ada + (size_t)(kq * 8 + kk) * DIN + cgp * 12 + cq * 3; wv[kk][0] = wr[0]; wv[kk][1] = wr[1]; wv[kk][2] = wr[2]; }
#pragma unroll
            for (int kk = 0; kk < 8; ++kk) { const int k = kq * 8 + kk;
#pragma unroll
                for (int b = 0; b < 8; ++b) { const float ca = cact[b * DM + k]; a[b][0] += ca * wv[kk][0]; a[b][1] += ca * wv[kk][1]; a[b][2] += ca * wv[kk][2]; } }
#pragma unroll
            for (int b = 0; b < 8; ++b)
#pragma unroll
                for (int j = 0; j < 3; ++j) { float v = a[b][j]; v += __shfl_xor(v, 4); v += __shfl_xor(v, 8); v += __shfl_xor(v, 16); v += __shfl_xor(v, 32);
                    if (lane < 4) red[wave * 96 + b * 12 + cq * 3 + j] = v; }
            __syncthreads();
            if (tid < 96) { float s = 0.f;
#pragma unroll
                for (int w = 0; w < 8; ++w) s += red[w * 96 + tid];
                const int b = tid / 12, n = cgp * 12 + tid % 12; mod[b * DIN + n] = s + b_ada[n]; }
            __syncthreads();
        }
        for (int it = gw; it < I_ALL; it += NGW) { float tv[32]; const TrItem ti = mk_item(it); tr_load(ti, tv, lane); tr_finish(ti, tv, scr, lane); }
        __syncthreads(); }
        if (BOTH(0)) GRID_BAR();
    }
    if (IN(1) && fuse01) {
#pragma unroll
        for (int q = 0; q < 8; ++q) { float t = 0.f;
#pragma unroll
            for (int j = 0; j < 4; ++j) t += (xr_[q][j].x * xr_[q][j].x + xr_[q][j].y * xr_[q][j].y) + (xr_[q][j].z * xr_[q][j].z + xr_[q][j].w * xr_[q][j].w);
            xs_[q] = t; }
#pragma unroll
        for (int q = 0; q < 8; ++q) { const int m = gw + q * NGW;
            const float* mb = mod + (size_t)(m >> 11) * DIN;
            const float inv = 1.0f / sqrtf(wave_sum(xs_[q]) * (1.0f / DM) + 1e-6f);
            GAS unsigned long long* o8 = (GAS unsigned long long*)(XN + (size_t)m * DM) + lane;
#pragma unroll
            for (int j = 0; j < 4; ++j) { const int k = 4 * lane + 256 * j;
                const f32x4 gg = *(const f32x4*)(norm_g + k), sh = *(const f32x4*)(mb + k), sc = *(const f32x4*)(mb + DM + k);
                const f32x4 y = xr_[q][j] * inv * gg * (sc + 1.0f) + sh;
                o8[64 * j] = (unsigned long long)pk2(y.x, y.y) | ((unsigned long long)pk2(y.z, y.w) << 32); } }
        if (BOTH(1)) GRID_BAR();
    } else
    if (IN(1)) { for (int rep_ = 0; rep_ < MK_REP1; ++rep_) {
        for (int m0 = gw; m0 < M; m0 += 4 * NGW) {
            f32x4 v[4][4]; float s[4];
#pragma unroll
            for (int q = 0; q < 4; ++q) { const int m = m0 + q * NGW; const GAS f32x4* xr = (const GAS f32x4*)(x + (size_t)(m < M ? m : m0) * DM) + lane;
#pragma unroll
                for (int j = 0; j < 4; ++j) v[q][j] = xr[64 * j]; }
#pragma unroll
            for (int q = 0; q < 4; ++q) { float t = 0.f;
#pragma unroll
                for (int j = 0; j < 4; ++j) t += (v[q][j].x * v[q][j].x + v[q][j].y * v[q][j].y) + (v[q][j].z * v[q][j].z + v[q][j].w * v[q][j].w);
                s[q] = t; }
#pragma unroll
            for (int q = 0; q < 4; ++q) { const int m = m0 + q * NGW; if (m >= M) break;
                const float* mb = mod + (size_t)(m >> 11) * DIN;
                const float inv = 1.0f / sqrtf(wave_sum(s[q]) * (1.0f / DM) + 1e-6f);
                GAS unsigned long long* o8 = (GAS unsigned long long*)(XN + (size_t)m * DM) + lane;
#pragma unroll
                for (int j = 0; j < 4; ++j) { const int k = 4 * lane + 256 * j;
                    const f32x4 gg = *(const f32x4*)(norm_g + k), sh = *(const f32x4*)(mb + k), sc = *(const f32x4*)(mb + DM + k);
                    const f32x4 y = v[q][j] * inv * gg * (sc + 1.0f) + sh;
                    o8[64 * j] = (unsigned long long)pk2(y.x, y.y) | ((unsigned long long)pk2(y.z, y.w) << 32); } }
        }
        }
        if (BOTH(1)) GRID_BAR();
    }
    if (IN(2)) { for (int rep_ = 0; rep_ < MK_REP2; ++rep_) {
        pg8::Gemm g{XN, Win_t, M, DIN, DM}; pg8::StaticOrder S; S.init(M, DIN, G, bx);
        pg8::EpiInProj E{PROJ, PROJ_STRIDE, qg, kg};
        pg8::gemm_phase<pg8::EpiInProj, pg8::StaticOrder, true, true>(L, g, S, E);
        }
        if (BOTH(2)) GRID_BAR();
    }
    if (IN(3)) { for (int rep_ = 0; rep_ < MK_REP3; ++rep_) {
        const bf16* Qb = PROJ; const bf16* Kb = PROJ + PROJ_STRIDE; const bf16* Vb = PROJ + 2 * PROJ_STRIDE; const bf16* GAb = PROJ + 3 * PROJ_STRIDE;
        const bf16* Ub = PROJ + 4 * PROJ_STRIDE; const bf16* GPb = PROJ + 5 * PROJ_STRIDE;
        for (int i = vcu; i < 256; i += G) {
            const int bh = i >> 2, qq = i & 3;
            if (i & 1) pool::pool_unit(i >> 2, i & 3, Ub, GPb, WpT, b_pool, pool_scale, CAT, (LAS char*)L);
            att::attn_pass<MK_EARLY>(bh >> 3, bh & 7, 16 * qq + 8, Qb, Kb, Vb, GAb, CAT, (LAS char*)L);
            att::attn_pass<MK_EARLY>(bh >> 3, bh & 7, 16 * qq, Qb, Kb, Vb, GAb, CAT, (LAS char*)L);
            VM_WAIT(); __syncthreads();
            if (!(i & 1)) pool::pool_unit(i >> 2, i & 3, Ub, GPb, WpT, b_pool, pool_scale, CAT, (LAS char*)L);
        }
        }
        if (BOTH(3)) GRID_BAR();
    }
    if (IN(4)) { for (int rep_ = 0; rep_ < MK_REP4; ++rep_) {
        pg8::Gemm g{CAT, Wout_t, M, DM, DM}; pg8::StaticOrder S; S.init(M, DM, G, bx);
        pg8::EpiOutRes E{x, args.out, mod + 2 * DM};
        pg8::gemm_phase<pg8::EpiOutRes, pg8::StaticOrder, true, true>(L, g, S, E);
    } }
#undef IN
#undef BOTH
}

extern "C" void kernel_launch(void* const* d_in, const int* in_sizes, int n_in, void* d_out, int out_size, void* d_ws, size_t ws_size, hipStream_t stream) {
    static int grid = 0;
    if (grid == 0) {
        if (n_in != 12 || out_size != M * DM || ws_size < WS_END) { fprintf(stderr, "kernel_launch: unexpected shapes (n_in %d out %d ws %zu)\n", n_in, out_size, ws_size); grid = -1; return; }
        int dev = 0, cus = 0, per_cu = 0;
        if (hipGetDevice(&dev) != hipSuccess || hipDeviceGetAttribute(&cus, hipDeviceAttributeMultiprocessorCount, dev) != hipSuccess) { grid = -1; return; }
        if (hipFuncSetAttribute((const void*)hybrid_fwd, hipFuncAttributeMaxDynamicSharedMemorySize, LDS_BYTES) != hipSuccess) { fprintf(stderr, "kernel_launch: hipFuncSetAttribute failed\n"); grid = -1; return; }
        if (hipOccupancyMaxActiveBlocksPerMultiprocessor(&per_cu, (const void*)hybrid_fwd, NWAVES * 64, LDS_BYTES) != hipSuccess || per_cu < 1) { fprintf(stderr, "kernel_launch: occupancy query says %d\n", per_cu); per_cu = 1; }
        (void)hipGetLastError();
        grid = cus;
    }
    if (grid < 0) return;
#if MK_COOP
    if (hipMemsetAsync((char*)d_ws + WS_CTL, 0, CTL_ZERO_BYTES, stream) != hipSuccess) { fprintf(stderr, "kernel_launch: hipMemsetAsync failed\n"); return; }
#endif
    Args a{};
    for (int i = 0; i < 12; ++i) a.in[i] = (const float*)d_in[i];
    a.out = (float*)d_out; a.ws = (unsigned char*)d_ws;
#if MK_COOP
    a.ph_lo = 0; a.ph_hi = N_PHASES; a.coop = 1;
    void* kargs[] = {&a};
    hipError_t e = hipLaunchCooperativeKernel((const void*)hybrid_fwd, dim3(grid), dim3(NWAVES * 64), kargs, LDS_BYTES, stream);
    if (e != hipSuccess) fprintf(stderr, "kernel_launch: cooperative launch failed: %s (grid %d)\n", hipGetErrorString(e), grid);
#else
    for (int p = 0; p < N_PHASES; ++p) { a.ph_lo = p; a.ph_hi = p + 1; a.coop = 0;
        hipLaunchKernelGGL(hybrid_fwd, dim3(grid), dim3(NWAVES * 64), LDS_BYTES, stream, a); }
#endif
}
```

```cpp
#include <hip/hip_runtime.h>
#include <hip/hip_cooperative_groups.h>
#include <cstdio>
#include <cstdint>
namespace cg = cooperative_groups;
#ifndef MK_COOP
#define MK_COOP 1
#endif
#ifndef MK_EARLY
#define MK_EARLY true
#endif
#define PG8_SP2 true
#define PG8_ALIGN true
#ifndef MK_REP0
#define MK_REP0 1
#endif
#ifndef MK_REP1
#define MK_REP1 1
#endif
#ifndef MK_REP2
#define MK_REP2 1
#endif
#ifndef MK_REP3
#define MK_REP3 1
#endif
#ifndef MK_REP4
#define MK_REP4 1
#endif
#ifndef MK_REP3A
#define MK_REP3A 1
#endif
#ifndef MK_REP3P
#define MK_REP3P 1
#endif
namespace pg8 {
#define PG8_LAS __attribute__((address_space(3)))
typedef unsigned short bf16_t;
typedef short bf16x8 __attribute__((ext_vector_type(8)));
typedef float f32x4 __attribute__((ext_vector_type(4)));
typedef unsigned u32x4 __attribute__((ext_vector_type(4)));
constexpr int BM = 256, BK = 64, HALF = 128, HTB = HALF * BK * 2  , STAGE_BYTES = 8 * HTB, NXCD = 8, WGM = 8;

__host__ __device__ __forceinline__ int lds_byte(int r, int c) { const int st = (r >> 4) * 2 + (c >> 5), rr = r & 15, cc = c & 31, ob = rr * 64 + cc * 2; return st * 1024 + (ob ^ (((ob >> 9) & 1) << 5)); }
__host__ __device__ __forceinline__ void stage_rc(int b, int& R, int& C) { const int st = b / 1024, sb = b % 1024, swz = sb ^ (((sb >> 9) & 1) << 5); R = (st >> 1) * 16 + swz / 64; C = (st & 1) * 32 + (swz % 64) / 2; }
__host__ __device__ __forceinline__ int perm32(int rho) { const int n = rho >> 4, i = rho & 15; return 8 * (i >> 2) + 4 * n + (i & 3); }

struct Unit { int pm, pn; };
struct Gemm { const bf16_t* A; const bf16_t* Bt; int M, N, K; };

struct StaticOrder {
    int nM, nN, nwg, G, c;
    __host__ __device__ void init(int M, int N, int G_, int c_) { nM = M / BM; nN = N / BM; nwg = nM * nN; G = G_; c = c_; }
    __host__ __device__ bool next(int i, Unit& u) const {
        const long L = (long)i * G + c; if (L >= nwg) return false;
        int wgid = (int)L; { const int q = nwg / NXCD, r = nwg % NXCD, xcd = wgid % NXCD, off = wgid / NXCD; wgid = (xcd < r ? xcd * (q + 1) : r * (q + 1) + (xcd - r) * q) + off; }
        const int nig = WGM * nN, gid = wgid / nig, fm = gid * WGM, gsz = (nM - fm) < WGM ? (nM - fm) : WGM;
        u.pm = fm + ((wgid % nig) % gsz); u.pn = (wgid % nig) / gsz; return true;
    }
    __device__ __forceinline__ void a_ready(const Unit&) const {}
    __device__ __forceinline__ void done(const Unit&) const {}
};
__device__ __forceinline__ unsigned cvt_pk_bf16(float lo, float hi) { unsigned r; asm volatile("v_cvt_pk_bf16_f32 %0, %1, %2" : "=v"(r) : "v"(lo), "v"(hi)); return r; }
typedef float f32x2 __attribute__((ext_vector_type(2)));
__device__ __forceinline__ float silu_f(float v) { return v * __builtin_amdgcn_rcpf(1.0f + __builtin_amdgcn_exp2f(-1.4426950408889634f * v)); }
constexpr float QSCALE = 0.125f * 1.4426950408889634f;
__device__ __forceinline__ size_t hm_off(int row, int head) { return ((size_t)((row >> 11) * 8 + head) * 2048 + (row & 2047)) * 64; }
struct EpiInProj {
    static constexpr bool PERM = true, AFTER_DRAIN = false;
    bf16_t* base; size_t stride; const float* gq; const float* gk;
    __device__ __forceinline__ void operator()(const f32x4 (&acc)[2][2][4][2], const Unit& u, int wr, int wc, int fr, int fq) const {
        const int type = u.pn >> 1;
        bf16_t* O = base + (size_t)type * stride;
        const int row0 = u.pm * BM + wr * 64 + fr;
        const int col0 = (u.pn & 1) * 256 + wc * 64 + 8 * fq;
        if (type < 2) {
            const float* g = type == 0 ? gq : gk; const float s = type == 0 ? QSCALE : 1.0f;
            f32x4 gs[2][2];
#pragma unroll
            for (int bj = 0; bj < 2; ++bj)
#pragma unroll
                for (int n = 0; n < 2; ++n) gs[bj][n] = *(const f32x4*)(g + 32 * bj + 8 * fq + 4 * n) * s;
#pragma unroll
            for (int ai = 0; ai < 2; ++ai)
#pragma unroll
                for (int m = 0; m < 4; ++m) {
                    float ss = 0.f;
#pragma unroll
                    for (int bj = 0; bj < 2; ++bj)
#pragma unroll
                        for (int n = 0; n < 2; ++n) { const f32x4 x = acc[ai][bj][m][n]; ss += (x[0] * x[0] + x[1] * x[1]) + (x[2] * x[2] + x[3] * x[3]); }
                    ss += __shfl_xor(ss, 16); ss += __shfl_xor(ss, 32);
                    const float inv = 1.0f / sqrtf(ss * (1.0f / 64.0f) + 1e-6f);
                    bf16_t* rowp = O + hm_off(row0 + ai * HALF + m * 16, (u.pn & 1) * 4 + wc) + 8 * fq;
#pragma unroll
                    for (int bj = 0; bj < 2; ++bj) { const f32x4 v0 = acc[ai][bj][m][0] * inv * gs[bj][0], v1 = acc[ai][bj][m][1] * inv * gs[bj][1];
                        u32x4 w; w.x = cvt_pk_bf16(v0[0], v0[1]); w.y = cvt_pk_bf16(v0[2], v0[3]); w.z = cvt_pk_bf16(v1[0], v1[1]); w.w = cvt_pk_bf16(v1[2], v1[3]);
                        *(u32x4*)(rowp + bj * 32) = w; }
                }
        } else {
            const bool act = (type == 3) || (type == 5);
#pragma unroll
            for (int ai = 0; ai < 2; ++ai)
#pragma unroll
                for (int m = 0; m < 4; ++m) {
                    const int row = row0 + ai * HALF + m * 16;
                    bf16_t* rowp = (type <= 3) ? O + hm_off(row, (u.pn & 1) * 4 + wc) + 8 * fq : O + ((size_t)((u.pn & 1) * 2 + (wc >> 1)) * 16384 + row) * 128 + (wc & 1) * 64 + 8 * fq;
#pragma unroll
                    for (int bj = 0; bj < 2; ++bj) { f32x4 v0 = acc[ai][bj][m][0], v1 = acc[ai][bj][m][1];
                        if (act) { v0 = (f32x4){silu_f(v0[0]), silu_f(v0[1]), silu_f(v0[2]), silu_f(v0[3])}; v1 = (f32x4){silu_f(v1[0]), silu_f(v1[1]), silu_f(v1[2]), silu_f(v1[3])}; }
                        u32x4 w; w.x = cvt_pk_bf16(v0[0], v0[1]); w.y = cvt_pk_bf16(v0[2], v0[3]); w.z = cvt_pk_bf16(v1[0], v1[1]); w.w = cvt_pk_bf16(v1[2], v1[3]);
                        *(u32x4*)(rowp + bj * 32) = w; }
                }
        }
    }
};
struct EpiOutRes {
    static constexpr bool PERM = false, AFTER_DRAIN = false;
    const float* x; float* out; const float* gate;
    __device__ __forceinline__ void operator()(const f32x4 (&acc)[2][2][4][2], const Unit& u, int wr, int wc, int fr, int fq) const {
        const int col0 = u.pn * BM + wc * 32 + 4 * fq;
        const float* gp = gate + (size_t)((u.pm * BM) >> 11) * 3072 + col0;
        f32x4 gv[2][2];
#pragma unroll
        for (int bj = 0; bj < 2; ++bj)
#pragma unroll
            for (int n = 0; n < 2; ++n) gv[bj][n] = *(const f32x4*)(gp + bj * HALF + n * 16);
#pragma unroll
        for (int ai = 0; ai < 2; ++ai)
#pragma unroll
            for (int m = 0; m < 4; ++m) { const size_t off = (size_t)(u.pm * BM + ai * HALF + wr * 64 + m * 16 + fr) * 1024 + col0;
#pragma unroll
                for (int bj = 0; bj < 2; ++bj)
#pragma unroll
                    for (int n = 0; n < 2; ++n) { const f32x4 xv = *(const f32x4*)(x + off + bj * HALF + n * 16);
                        *(f32x4*)(out + off + bj * HALF + n * 16) = xv + gv[bj][n] * acc[ai][bj][m][n]; } }
    }
};
template <class Epi, class Sched, bool ALIGN_EPI = false, bool SP2 = false>
__device__ __forceinline__ void gemm_phase(PG8_LAS unsigned char* lds, const Gemm g, const Sched& S, const Epi& E) {
    const int tid = threadIdx.x, wid = __builtin_amdgcn_readfirstlane(tid >> 6), lane = tid & 63, wr = wid >> 2, wc = wid & 3, fr = lane & 15, fq = lane >> 4;
    const int K = g.K, nt = K / BK;
    unsigned voffA[2], voffB[2];
#pragma unroll
    for (int i = 0; i < 2; ++i) { int R, C; stage_rc(tid * 16 + i * 8192, R, C); const int Rb = Epi::PERM ? ((R & ~31) + perm32(R & 31)) : R;
        voffA[i] = (unsigned)(R * K + C) * 2u; voffB[i] = (unsigned)(Rb * K + C) * 2u; }
    const size_t kstep = (size_t)(BK * 2);
    const size_t hstep = (size_t)HALF * K * 2;
    const size_t tstep = 2 * hstep;
    const unsigned ldsw = (unsigned)wid * 1024u;
    const int aoff = lds_byte(wr * 64 + fr, fq * 8), boff = lds_byte(wc * 32 + fr, fq * 8);
#define PG8_SA(b, h) (((b) * 2 + (h)) * HTB)
#define PG8_SB(b, h) ((4 + (b) * 2 + (h)) * HTB)
#define PG8_STAGE(bufoff, gbase, voff) do { _Pragma("unroll") for (int _i = 0; _i < 2; ++_i) \
        __builtin_amdgcn_global_load_lds((const unsigned*)((const char*)(gbase) + (voff)[_i]), (PG8_LAS unsigned*)(lds + (bufoff) + ldsw + _i * 8192), 16, 0, 0); } while (0)
#define PG8_LDA(dst, b, h) do { _Pragma("unroll") for (int m = 0; m < 4; ++m) _Pragma("unroll") for (int k = 0; k < 2; ++k) dst[m][k] = *(const PG8_LAS bf16x8*)(lds + PG8_SA(b, h) + aoff + m * 2048 + k * 1024); } while (0)
#define PG8_LDB(dst, b, h) do { _Pragma("unroll") for (int n = 0; n < 2; ++n) _Pragma("unroll") for (int k = 0; k < 2; ++k) dst[n][k] = *(const PG8_LAS bf16x8*)(lds + PG8_SB(b, h) + boff + n * 2048 + k * 1024); } while (0)
#define PG8_MMA(ai, bj, At, Bt) do { __builtin_amdgcn_s_setprio(1); _Pragma("unroll") for (int m = 0; m < 4; ++m) _Pragma("unroll") for (int n = 0; n < 2; ++n) _Pragma("unroll") for (int k = 0; k < 2; ++k) \
        acc[ai][bj][m][n] = __builtin_amdgcn_mfma_f32_16x16x32_bf16(Bt[n][k], At[m][k], acc[ai][bj][m][n], 0, 0, 0); __builtin_amdgcn_s_setprio(0); } while (0)
#define PG8_WAIT_V(n) asm volatile("s_waitcnt vmcnt(" #n ")" ::: "memory")
#define PG8_WAIT_L(n) asm volatile("s_waitcnt lgkmcnt(" #n ")" ::: "memory")
#define PG8_BAR __builtin_amdgcn_s_barrier()
#define PG8_SCHED __builtin_amdgcn_sched_barrier(0)
    Unit cur, nxt; int ui = 0;
    if (!S.next(0, cur)) return;
    f32x4 acc[2][2][4][2];
#pragma unroll
    for (int a = 0; a < 2; ++a)
#pragma unroll
        for (int b = 0; b < 2; ++b)
#pragma unroll
            for (int m = 0; m < 4; ++m)
#pragma unroll
                for (int n = 0; n < 2; ++n) acc[a][b][m][n] = (f32x4){0.f, 0.f, 0.f, 0.f};
    bf16x8 At[4][2], B0[2][2], B1[2][2];
    const char* cA = (const char*)g.A + (size_t)cur.pm * tstep; const char* cB = (const char*)g.Bt + (size_t)cur.pn * tstep;
    S.a_ready(cur);
    if constexpr (SP2) {
        PG8_STAGE(PG8_SB(0, 0), cB, voffB); PG8_STAGE(PG8_SB(0, 1), cB + hstep, voffB); PG8_STAGE(PG8_SA(0, 0), cA, voffA); PG8_STAGE(PG8_SA(0, 1), cA + hstep, voffA);
        if (wr == 1) PG8_BAR;
        PG8_WAIT_V(2); PG8_BAR;
        PG8_STAGE(PG8_SB(1, 0), cB + kstep, voffB); PG8_STAGE(PG8_SA(1, 0), cA + kstep, voffA); PG8_STAGE(PG8_SB(1, 1), cB + hstep + kstep, voffB);
        PG8_WAIT_V(6); PG8_BAR;
    } else {
        PG8_STAGE(PG8_SB(0, 0), cB, voffB); PG8_STAGE(PG8_SA(0, 0), cA, voffA); PG8_STAGE(PG8_SB(0, 1), cB + hstep, voffB); PG8_STAGE(PG8_SA(0, 1), cA + hstep, voffA);
        if (wr == 1) PG8_BAR;
        PG8_WAIT_V(4); PG8_BAR;
        PG8_STAGE(PG8_SB(1, 0), cB + kstep, voffB); PG8_STAGE(PG8_SA(1, 0), cA + kstep, voffA); PG8_STAGE(PG8_SB(1, 1), cB + hstep + kstep, voffB);
        PG8_WAIT_V(6); PG8_BAR;
    }
    for (;;) {
        const bool has_next = S.next(ui + 1, nxt);
        const char* nA = has_next ? (const char*)g.A + (size_t)nxt.pm * tstep : cA; const char* nB = has_next ? (const char*)g.Bt + (size_t)nxt.pn * tstep : cB;
        for (int t = 0; t < nt; t += 2) {
            const bool last = (t == nt - 2);
            const char* a1 = cA + (size_t)(t + 1) * kstep;
            const char* a2 = last ? nA : cA + (size_t)(t + 2) * kstep; const char* b2 = last ? nB : cB + (size_t)(t + 2) * kstep;
            const char* a3 = a2 + kstep; const char* b3 = b2 + kstep;
            if (last && has_next) S.a_ready(nxt);
            if constexpr (SP2) {
            PG8_LDB(B0, 0, 0); PG8_LDB(B1, 0, 1); PG8_SCHED; PG8_LDA(At, 0, 0); PG8_STAGE(PG8_SA(1, 1), a1 + hstep, voffA);
            PG8_WAIT_V(8); PG8_WAIT_L(0); PG8_BAR; PG8_MMA(0, 0, At, B0); PG8_MMA(0, 1, At, B1); PG8_BAR; PG8_SCHED;
            PG8_LDA(At, 0, 1); PG8_STAGE(PG8_SB(0, 0), b2, voffB); PG8_STAGE(PG8_SB(0, 1), b2 + hstep, voffB); PG8_STAGE(PG8_SA(0, 0), a2, voffA);
            PG8_WAIT_V(8); PG8_WAIT_L(0); PG8_BAR; PG8_MMA(1, 0, At, B0); PG8_MMA(1, 1, At, B1); PG8_BAR; PG8_SCHED;
            PG8_LDB(B0, 1, 0); PG8_LDB(B1, 1, 1); PG8_SCHED; PG8_LDA(At, 1, 0); PG8_STAGE(PG8_SA(0, 1), a2 + hstep, voffA);
            PG8_WAIT_V(8); PG8_WAIT_L(0); PG8_BAR; PG8_MMA(0, 0, At, B0); PG8_MMA(0, 1, At, B1); PG8_BAR; PG8_SCHED;
            PG8_LDA(At, 1, 1); PG8_STAGE(PG8_SB(1, 0), b3, voffB); PG8_STAGE(PG8_SB(1, 1), b3 + hstep, voffB); PG8_STAGE(PG8_SA(1, 0), a3, voffA);
            PG8_WAIT_V(8); PG8_WAIT_L(0); PG8_BAR; PG8_MMA(1, 0, At, B0); PG8_MMA(1, 1, At, B1); PG8_BAR; PG8_SCHED;
            } else {
            PG8_LDB(B0, 0, 0); PG8_SCHED; PG8_LDA(At, 0, 0); PG8_STAGE(PG8_SA(1, 1), a1 + hstep, voffA);
            PG8_WAIT_L(8); PG8_BAR; PG8_WAIT_L(0); PG8_MMA(0, 0, At, B0); PG8_BAR; PG8_SCHED;
            PG8_LDB(B1, 0, 1); PG8_STAGE(PG8_SB(0, 0), b2, voffB);
            PG8_BAR; PG8_WAIT_L(0); PG8_MMA(0, 1, At, B1); PG8_BAR;
            PG8_LDA(At, 0, 1); PG8_STAGE(PG8_SA(0, 0), a2, voffA);
            PG8_BAR; PG8_WAIT_L(0); PG8_MMA(1, 0, At, B0); PG8_BAR; PG8_SCHED;
            PG8_STAGE(PG8_SB(0, 1), b2 + hstep, voffB);
            PG8_WAIT_V(6); PG8_BAR; PG8_MMA(1, 1, At, B1); PG8_BAR;
            PG8_LDB(B0, 1, 0); PG8_SCHED; PG8_LDA(At, 1, 0); PG8_STAGE(PG8_SA(0, 1), a2 + hstep, voffA);
            PG8_WAIT_L(8); PG8_BAR; PG8_WAIT_L(0); PG8_MMA(0, 0, At, B0); PG8_BAR; PG8_SCHED;
            PG8_LDB(B1, 1, 1); PG8_STAGE(PG8_SB(1, 0), b3, voffB);
            PG8_BAR; PG8_WAIT_L(0); PG8_MMA(0, 1, At, B1); PG8_BAR;
            PG8_LDA(At, 1, 1); PG8_STAGE(PG8_SA(1, 0), a3, voffA);
            PG8_BAR; PG8_WAIT_L(0); PG8_MMA(1, 0, At, B0); PG8_BAR; PG8_SCHED;
            PG8_STAGE(PG8_SB(1, 1), b3 + hstep, voffB);
            PG8_WAIT_V(6); PG8_BAR; PG8_MMA(1, 1, At, B1); PG8_BAR;
            }
        }
        if constexpr (ALIGN_EPI) { if (wr == 0) PG8_BAR; }
        if constexpr (!Epi::AFTER_DRAIN) { E(acc, cur, wr, wc, fr, fq); S.done(cur); }
        if (!has_next) break;
#pragma unroll
        for (int a = 0; a < 2; ++a)
#pragma unroll
            for (int b = 0; b < 2; ++b)
#pragma unroll
                for (int m = 0; m < 4; ++m)
#pragma unroll
                    for (int n = 0; n < 2; ++n) acc[a][b][m][n] = (f32x4){0.f, 0.f, 0.f, 0.f};
        cur = nxt; cA = nA; cB = nB; ++ui;
        if constexpr (ALIGN_EPI) { if (wr == 1) PG8_BAR; }
    }
    PG8_WAIT_V(0);
    if constexpr (!ALIGN_EPI) { if (wr == 0) PG8_BAR; }
    PG8_BAR;
    if constexpr (Epi::AFTER_DRAIN) { E.fused(acc, cur, wr, wc, fr, fq, lds, wid, lane); S.done(cur); }
#undef PG8_SA
#undef PG8_SB
#undef PG8_STAGE
#undef PG8_LDA
#undef PG8_LDB
#undef PG8_MMA
#undef PG8_WAIT_V
#undef PG8_WAIT_L
#undef PG8_BAR
#undef PG8_SCHED
}
}

constexpr int NWAVES = 8;
constexpr int BATCH = 8, SEQ = 2048, DM = 1024, M = BATCH * SEQ, DIN = 3072, DH = 64, NH = 8, DA = 512;
constexpr size_t MiB = 1u << 20;
constexpr size_t WS_CTL = 0, CTL_ZERO_BYTES = 64 * 1024;
constexpr size_t WS_MOD = 1 * MiB;
constexpr size_t WS_WIN = 2 * MiB;
constexpr size_t WS_WOUT = 8 * MiB;
constexpr size_t WS_WPOOL = 10 * MiB;
constexpr size_t WS_XN = 16 * MiB;
constexpr size_t WS_PROJ = 48 * MiB;
constexpr size_t PROJ_STRIDE = (size_t)M * 512;
constexpr size_t WS_CAT = 144 * MiB;
constexpr size_t WS_END = 176 * MiB;
constexpr int RING_BYTES = 131072, LDS_BYTES = 147456, MISC_OFF = LDS_BYTES - 128;
constexpr int CW_BAR = 1024;

#define GAS __attribute__((address_space(1)))
#define LAS __attribute__((address_space(3)))
typedef unsigned short bf16;
typedef unsigned v4u __attribute__((ext_vector_type(4)));
typedef unsigned v2u __attribute__((ext_vector_type(2)));
typedef float f32x4 __attribute__((ext_vector_type(4)));
typedef float f32x16 __attribute__((ext_vector_type(16)));
typedef short bf16x8 __attribute__((ext_vector_type(8)));
typedef short s16x4 __attribute__((ext_vector_type(4)));
#define LDS_WAIT() asm volatile("s_waitcnt lgkmcnt(0)" ::: "memory")
#define VM_WAIT() asm volatile("s_waitcnt vmcnt(0)" ::: "memory")
__device__ __forceinline__ unsigned pk2(float lo, float hi) { return pg8::cvt_pk_bf16(lo, hi); }
__device__ __forceinline__ float bf_lo(unsigned u) { return __builtin_bit_cast(float, u << 16); }
__device__ __forceinline__ float bf_hi(unsigned u) { return __builtin_bit_cast(float, u & 0xffff0000u); }
#define XB_TMO      128
#define XB_XCNT(j)  (256  + 64 * (j))
#define XB_XSUB(j)  (1280 + 64 * (j))
#define XB_XGEN(j)  (2304 + 64 * (j))
#define XB_TOP      3328
#define XB_TOPGEN   3392
#define XCD_BAR_WORDS 3456
#define XB_SPIN_CAP (1u << 18)

__device__ __forceinline__ unsigned xb_ld(unsigned* p)              { return __hip_atomic_load(p, __ATOMIC_RELAXED, __HIP_MEMORY_SCOPE_AGENT); }
__device__ __forceinline__ unsigned xb_add(unsigned* p, unsigned v) { return __hip_atomic_fetch_add(p, v, __ATOMIC_RELAXED, __HIP_MEMORY_SCOPE_AGENT); }
__device__ __forceinline__ unsigned xb_xcc_id() { return (unsigned)__builtin_amdgcn_s_getreg((3 << 11) | 20) & 0xFu; }
#define XB_SPIN(cond, bar) do { unsigned _sp = 0; while (cond) { __builtin_amdgcn_s_sleep(1); \
    if ((++_sp & 255u) == 0u) { if (xb_ld(&(bar)[XB_TMO])) break; if (_sp > XB_SPIN_CAP) { atomicAdd(&(bar)[XB_TMO], 1u); break; } } } } while (0)

struct XcdBarrier {
    unsigned* bar; unsigned x;
    volatile LAS unsigned* st;
};

__device__ __forceinline__ XcdBarrier xcd_barrier_post(unsigned* bar, volatile LAS unsigned* st) {
    XcdBarrier b; b.bar = bar; b.x = xb_xcc_id(); b.st = st;
    if (threadIdx.x == 0) (void)xb_add(&bar[XB_XCNT(b.x)], 1u);
    return b;
}
__device__ __forceinline__ void xcd_barrier_complete(unsigned* bar, unsigned x, unsigned& nloc, unsigned& nx) {
    const unsigned G = gridDim.x * gridDim.y * gridDim.z;
    unsigned sum, cnt, mine, sp = 0u;
    for (;;) {
        sum = 0u; cnt = 0u; mine = 0u;
#pragma unroll
        for (unsigned j = 0; j < 16; ++j) { const unsigned c = xb_ld(&bar[XB_XCNT(j)]); sum += c; cnt += (c > 0u) ? 1u : 0u; mine = (j == x) ? c : mine; }
        if (sum == G) break;
        __builtin_amdgcn_s_sleep(1);
        if ((++sp & 255u) == 0u) { if (xb_ld(&bar[XB_TMO])) break; if (sp > XB_SPIN_CAP) { atomicAdd(&bar[XB_TMO], 1u); break; } }
    }
    nloc = mine > 0u ? mine : 1u; nx = cnt > 0u ? cnt : 1u;
}

__device__ __forceinline__ void xcd_barrier(const XcdBarrier& b) {
    asm volatile("s_waitcnt vmcnt(0)" ::: "memory");
    __syncthreads();
    if (threadIdx.x == 0) {
        unsigned* bar = b.bar;
        __builtin_amdgcn_s_waitcnt(0);
        unsigned nloc = b.st[0], nx = b.st[1];
        if (nloc == 0u) { xcd_barrier_complete(bar, b.x, nloc, nx); b.st[0] = nloc; b.st[1] = nx; }
        const unsigned old = xb_add(&bar[XB_XSUB(b.x)], 1u);
        const unsigned gen = old / nloc;
        if (old + 1u == (gen + 1u) * nloc) {
            __builtin_amdgcn_fence(__ATOMIC_RELEASE, "agent");
            asm volatile("s_waitcnt vmcnt(0)" ::: "memory");
            const unsigned og = xb_add(&bar[XB_TOP], 1u);
            const unsigned tg = og / nx;
            if (og + 1u == (tg + 1u) * nx) xb_add(&bar[XB_TOPGEN], 1u);
            else XB_SPIN(xb_ld(&bar[XB_TOPGEN]) == tg, bar);
            __builtin_amdgcn_fence(__ATOMIC_ACQUIRE, "agent");
            xb_add(&bar[XB_XGEN(b.x)], 1u);
            asm volatile("s_waitcnt vmcnt(0)" ::: "memory");
        } else {
            XB_SPIN(xb_ld(&bar[XB_XGEN(b.x)]) == gen, bar);
            __builtin_amdgcn_fence(__ATOMIC_ACQUIRE, "agent");
            asm volatile("s_waitcnt vmcnt(0)" ::: "memory");
        }
    }
    __syncthreads();
}

namespace att {
__device__ __forceinline__ void glds16(const void* gsrc, unsigned lds_dst) { unsigned keep;
    asm volatile("s_mov_b32 %0, m0\n\ts_mov_b32 m0, %2\n\ts_nop 0\n\tglobal_load_lds_dwordx4 %1, off\n\ts_mov_b32 m0, %0" : "=&s"(keep) : "v"(gsrc), "s"(lds_dst) : "memory"); }
typedef short v4i16_t __attribute__((ext_vector_type(4)));
__device__ __forceinline__ s16x4 vtr(LAS const char* p) { return __builtin_bit_cast(s16x4, __builtin_amdgcn_ds_read_tr16_b64_v4i16((LAS v4i16_t*)p)); }
constexpr int TILEB = 8192, VOFF = 4096, STAGE_OFF = 12 * TILEB, STAGE_B = 4608;
#ifndef ATT_HIST
#define ATT_HIST 4
#endif

__device__ __forceinline__ void tile_weights(f32x16& p0, float& carry, unsigned (&pw)[2][4], bool diag, int kv0, int qabs, int hi) {
    float G[4];
#pragma unroll
    for (int i = 0; i < 4; ++i) {
        float rr[4], be[4];
#pragma unroll
        for (int j = 0; j < 4; ++j) {
            const float e = __builtin_amdgcn_exp2f(p0[4 * i + j]);
            float rv = __builtin_amdgcn_rcpf(1.0f + e); float bv = e * rv;
            if (diag) { const int kv = kv0 + 8 * i + 4 * hi + j; if (kv >= qabs) { rv = 1.0f; bv = 0.0f; } }
            rr[j] = rv; be[j] = bv;
        }
        const float s2 = rr[3], s1 = s2 * rr[2], s0 = s1 * rr[1];
        G[i] = s0 * rr[0];
        p0[4 * i + 3] = be[3]; p0[4 * i + 2] = be[2] * s2; p0[4 * i + 1] = be[1] * s1; p0[4 * i] = be[0] * s0;
    }
    float F[4]; float run = carry;
#pragma unroll
    for (int p = 3; p >= 0; --p) {
        auto sw = __builtin_amdgcn_permlane32_swap(__float_as_uint(G[p]), __float_as_uint(G[p]), false, false);
        const float g0 = __uint_as_float(sw[0]), g1 = __uint_as_float(sw[1]);
        F[p] = run * (hi ? 1.0f : g1);
        run = run * (g0 * g1);
    }
    carry = run;
#pragma unroll
    for (int i = 0; i < 4; ++i) { const float f = F[i];
        pw[i >> 1][2 * (i & 1)] = pk2(p0[4 * i] * f, p0[4 * i + 1] * f); pw[i >> 1][2 * (i & 1) + 1] = pk2(p0[4 * i + 2] * f, p0[4 * i + 3] * f); }
}

template <bool EARLY>
__device__ __forceinline__ void attn_pass(int b, int h, int qb0, const bf16* Q, const bf16* K, const bf16* V, const bf16* GA, bf16* CAT, LAS char* shm) {
    const int tid = threadIdx.x, lane = tid & 63, r32 = lane & 31, hi = lane >> 5; const int wid = __builtin_amdgcn_readfirstlane(tid >> 6);
    const size_t hb = ((size_t)(b * NH + h) * SEQ) * DH;
    const bf16* Qh = Q + hb; const bf16* Kh = K + hb; const bf16* Vh = V + hb;
    const unsigned lds0 = (unsigned)__builtin_amdgcn_readfirstlane((int)(unsigned)(uintptr_t)shm);
    const int wb = qb0 - ATT_HIST > 0 ? qb0 - ATT_HIST : 0, nw = qb0 + 8 - wb;
    const bf16* ksrc = Kh + (size_t)(lane >> 3) * DH + (((lane & 7) ^ ((lane >> 3) & 7)) * 8);
    const bf16* vsrc = Vh + (size_t)(lane >> 2) * DH + (lane & 3) * 8;
    for (int p = wid; p < nw * 8; p += NWAVES) {
        const int w = p >> 3, pc = p & 7; const size_t trow = (size_t)(wb + w) * 32;
        const unsigned dst = lds0 + w * TILEB + pc * 1024;
        if (pc < 4) glds16(ksrc + (trow + 8 * pc) * DH, dst);
        else glds16(vsrc + (trow + 16 * ((pc - 4) & 1)) * DH + 32 * ((pc - 4) >> 1), dst);
    }
    const int qblk = qb0 + wid, q0 = qblk * 32, qabs = q0 + r32;
    bf16x8 qr[4];
#pragma unroll
    for (int d0 = 0; d0 < 4; ++d0) qr[d0] = *reinterpret_cast<const bf16x8*>(&Qh[(size_t)qabs * DH + d0 * 16 + hi * 8]);
    const size_t tok0 = (size_t)b * SEQ + q0;
    v4u gpre[2][2];
#pragma unroll
    for (int dh = 0; dh < 2; ++dh)
#pragma unroll
        for (int k = 0; k < 2; ++k) gpre[dh][k] = *(const v4u*)(GA + hb + (size_t)(q0 + 16 * k + (lane >> 2)) * DH + 32 * dh + (lane & 3) * 8);
    asm volatile("s_waitcnt vmcnt(0)" ::: "memory");
    __syncthreads();
    f32x16 o[2]; o[0] = f32x16{}; o[1] = f32x16{};
    float carry = 1.0f; bool dead = false;
    LAS const char* kp0 = shm + r32 * 128;
    LAS const char* vp0 = shm + VOFF + ((lane >> 4) & 1) * 32 + (lane & 3) * 8 + (4 * hi + ((lane & 15) >> 2)) * 64;
    int t = qblk;
    for (; t >= wb; --t) {
        const int w = t - wb;
        LAS const char* kp = kp0 + w * TILEB;
        f32x16 p0 = f32x16{};
#pragma unroll
        for (int d0 = 0; d0 < 4; ++d0) {
            const bf16x8 kf = *(LAS const bf16x8*)(kp + (((2 * d0 + hi) ^ (r32 & 7)) * 16));
            p0 = __builtin_amdgcn_mfma_f32_32x32x16_bf16(kf, qr[d0], p0, 0, 0, 0);
        }
        unsigned pw[2][4];
        tile_weights(p0, carry, pw, t == qblk, t * 32, qabs, hi);
        LAS const char* vp = vp0 + w * TILEB;
#pragma unroll
        for (int dh = 0; dh < 2; ++dh)
#pragma unroll
            for (int ks = 0; ks < 2; ++ks) {
                const s16x4 lo = vtr(vp + dh * 2048 + ks * 1024), hh = vtr(vp + dh * 2048 + ks * 1024 + 512);
                const bf16x8 vf = (bf16x8){lo[0], lo[1], lo[2], lo[3], hh[0], hh[1], hh[2], hh[3]};
                const v4u pwv = (v4u){pw[ks][0], pw[ks][1], pw[ks][2], pw[ks][3]};
                o[dh] = __builtin_amdgcn_mfma_f32_32x32x16_bf16(vf, __builtin_bit_cast(bf16x8, pwv), o[dh], 0, 0, 0);
            }
        if (EARLY) { if (__all(carry < 1e-30f)) { dead = true; break; } }
    }
    if (!dead) {
        for (t = wb - 1; t >= 0; --t) {
            f32x16 p0 = f32x16{};
#pragma unroll
            for (int d0 = 0; d0 < 4; ++d0) {
                const bf16x8 kf = *reinterpret_cast<const bf16x8*>(&Kh[((size_t)t * 32 + r32) * DH + (2 * d0 + hi) * 8]);
                p0 = __builtin_amdgcn_mfma_f32_32x32x16_bf16(kf, qr[d0], p0, 0, 0, 0);
            }
            unsigned pw[2][4];
            tile_weights(p0, carry, pw, false, t * 32, qabs, hi);
#pragma unroll
            for (int dh = 0; dh < 2; ++dh)
#pragma unroll
                for (int ks = 0; ks < 2; ++ks) {
                    bf16x8 vf;
#pragma unroll
                    for (int j = 0; j < 8; ++j) vf[j] = (short)Vh[((size_t)t * 32 + 16 * ks + 8 * (j >> 2) + 4 * hi + (j & 3)) * DH + 32 * dh + r32];
                    const v4u pwv = (v4u){pw[ks][0], pw[ks][1], pw[ks][2], pw[ks][3]};
                    o[dh] = __builtin_amdgcn_mfma_f32_32x32x16_bf16(vf, __builtin_bit_cast(bf16x8, pwv), o[dh], 0, 0, 0);
                }
            if (EARLY) { if (__all(carry < 1e-30f)) break; }
        }
    }
    {
        LAS char* st = shm + STAGE_OFF + wid * STAGE_B;
        const int rr = lane >> 2, ch = lane & 3;
#pragma unroll
        for (int dh = 0; dh < 2; ++dh) {
#pragma unroll
            for (int i = 0; i < 4; ++i) *(LAS f32x4*)(st + r32 * 144 + (8 * i + 4 * hi) * 4) = (f32x4){o[dh][4 * i], o[dh][4 * i + 1], o[dh][4 * i + 2], o[dh][4 * i + 3]};
            asm volatile("s_waitcnt lgkmcnt(0)" ::: "memory");
#pragma unroll
            for (int k = 0; k < 2; ++k) { const int row = 16 * k + rr;
                const f32x4 a0 = *(LAS const f32x4*)(st + row * 144 + ch * 32), a1 = *(LAS const f32x4*)(st + row * 144 + ch * 32 + 16);
                const v4u g = gpre[dh][k];
                v4u w; w.x = pk2(a0[0] * bf_lo(g.x), a0[1] * bf_hi(g.x)); w.y = pk2(a0[2] * bf_lo(g.y), a0[3] * bf_hi(g.y));
                w.z = pk2(a1[0] * bf_lo(g.z), a1[1] * bf_hi(g.z)); w.w = pk2(a1[2] * bf_lo(g.w), a1[3] * bf_hi(g.w));
                *(v4u*)(CAT + (tok0 + row) * DM + h * DH + 32 * dh + ch * 8) = w; }
            asm volatile("s_waitcnt lgkmcnt(0)" ::: "memory");
        }
    }
    __syncthreads();
}
}

namespace pool {
constexpr int UP = 272;
constexpr int UROWS = 272;
constexpr int WOFF = UROWS * UP;
typedef short v4i16_t __attribute__((ext_vector_type(4)));
__device__ __forceinline__ s16x4 vtr(LAS const char* p) { return __builtin_bit_cast(s16x4, __builtin_amdgcn_ds_read_tr16_b64_v4i16((LAS v4i16_t*)p)); }
template <int WIN>
__device__ __forceinline__ void pool_unit_w(int pm, int g, const bf16* U, const bf16* GP, const bf16* WpT, const float* bp, const float* ps, bf16* CAT, LAS char* shm) {
    const int tid = threadIdx.x, lane = tid & 63, r32 = lane & 31, hi = lane >> 5; const int wid = __builtin_amdgcn_readfirstlane(tid >> 6);
    asm volatile("" : "+s"(pm), "+s"(g));
    const int t0 = pm * 256, tpos0 = t0 & (SEQ - 1);
    v4u tu[9], tw[4];
#pragma unroll
    for (int k = 0; k < 9; ++k) { const int c = tid + k * 512, row = c >> 4, ch = c & 15; tu[k] = (v4u){0u, 0u, 0u, 0u};
        if (c < UROWS * 16 && tpos0 - 16 + row >= 0) tu[k] = *(const v4u*)(U + ((size_t)g * M + (t0 - 16 + row)) * 128 + ch * 8); }
#pragma unroll
    for (int k = 0; k < 4; ++k) { const int c = tid + k * 512; tw[k] = *(const v4u*)(WpT + (size_t)g * 16384 + (size_t)c * 8); }
#pragma unroll
    for (int k = 0; k < 9; ++k) { const int c = tid + k * 512, row = c >> 4, ch = c & 15; if (c < UROWS * 16) *(LAS v4u*)(shm + row * UP + ch * 16) = tu[k]; }
#pragma unroll
    for (int k = 0; k < 4; ++k) { const int c = tid + k * 512, row = c >> 4, ch = c & 15; *(LAS v4u*)(shm + WOFF + row * UP + ch * 16) = tw[k]; }
    v4u gpre[2][4];
#pragma unroll
    for (int half = 0; half < 2; ++half)
#pragma unroll
        for (int k = 0; k < 4; ++k) gpre[half][k] = *(const v4u*)(GP + ((size_t)g * M + t0 + wid * 32 + 8 * k + (lane >> 3)) * 128 + 64 * half + (lane & 7) * 8);
    __syncthreads();
    const int r = wid * 32 + r32, tpos = tpos0 + r;
    const float inv = 1.0f / (float)(tpos + 1 < WIN ? tpos + 1 : WIN);
    bf16x8 band[3];
#pragma unroll
    for (int ks = 0; ks < 3; ++ks)
#pragma unroll
        for (int j = 0; j < 8; ++j) { const int dlt = (r32 + 16) - (16 * ks + 8 * (j >> 2) + 4 * hi + (j & 3));
            band[ks][j] = (dlt >= 0 && dlt < WIN) ? (short)0x3F80 : (short)0; }
    LAS const char* ub = shm + (32 * wid + 4 * hi + ((lane & 15) >> 2)) * UP + (16 * ((lane >> 4) & 1) + 4 * (lane & 3)) * 2;
    LAS const char* urow = shm + (32 * wid + r32 + 16) * UP + 8 * hi;
    LAS const char* wl = shm + WOFF + r32 * UP + 8 * hi;
    f32x16 acc[4]; acc[0] = f32x16{}; acc[1] = f32x16{}; acc[2] = f32x16{}; acc[3] = f32x16{};
#pragma unroll 1
    for (int ct = 0; ct < 4; ++ct) {
        f32x16 X = f32x16{};
#pragma unroll
        for (int ks = 0; ks < 3; ++ks) {
            const s16x4 lo = vtr(ub + (16 * ks) * UP + ct * 64), hh = vtr(ub + (16 * ks + 8) * UP + ct * 64);
            const bf16x8 uf = (bf16x8){lo[0], lo[1], lo[2], lo[3], hh[0], hh[1], hh[2], hh[3]};
            X = __builtin_amdgcn_mfma_f32_32x32x16_bf16(uf, band[ks], X, 0, 0, 0);
        }
        unsigned pw[2][4];
#pragma unroll
        for (int i = 0; i < 4; ++i) { const v2u ut = *(LAS const v2u*)(urow + (32 * ct + 8 * i) * 2);
            pw[i >> 1][2 * (i & 1)] = pk2(X[4 * i] * inv - bf_lo(ut.x), X[4 * i + 1] * inv - bf_hi(ut.x));
            pw[i >> 1][2 * (i & 1) + 1] = pk2(X[4 * i + 2] * inv - bf_lo(ut.y), X[4 * i + 3] * inv - bf_hi(ut.y)); }
#pragma unroll
        for (int s2 = 0; s2 < 2; ++s2) { const int S = 2 * ct + s2;
            const v4u pv = (v4u){pw[s2][0], pw[s2][1], pw[s2][2], pw[s2][3]};
            const bf16x8 pfr = __builtin_bit_cast(bf16x8, pv);
#pragma unroll
            for (int n = 0; n < 4; ++n) { const v2u w0 = *(LAS const v2u*)(wl + n * 32 * UP + 32 * S), w1 = *(LAS const v2u*)(wl + n * 32 * UP + 32 * S + 16);
                const v4u wv = (v4u){w0.x, w0.y, w1.x, w1.y};
                acc[n] = __builtin_amdgcn_mfma_f32_32x32x16_bf16(__builtin_bit_cast(bf16x8, wv), pfr, acc[n], 0, 0, 0); }
        }
    }
    __syncthreads();
    {
        LAS char* st = shm + wid * 16384;
        const size_t tokw = (size_t)t0 + wid * 32;
        const int rr = lane >> 3, ch = lane & 7;
#pragma unroll
        for (int half = 0; half < 2; ++half) {
#pragma unroll
            for (int nn = 0; nn < 2; ++nn)
#pragma unroll
                for (int i = 0; i < 4; ++i) { const int n = 2 * half + nn;
                    *(LAS f32x4*)(st + r32 * 272 + (32 * nn + 8 * i + 4 * hi) * 4) = (f32x4){acc[n][4 * i], acc[n][4 * i + 1], acc[n][4 * i + 2], acc[n][4 * i + 3]}; }
            asm volatile("s_waitcnt lgkmcnt(0)" ::: "memory");
            const int col = g * 128 + 64 * half + ch * 8;
            const f32x4 b0 = *(const f32x4*)(bp + col), b1 = *(const f32x4*)(bp + col + 4), s0 = *(const f32x4*)(ps + col), s1 = *(const f32x4*)(ps + col + 4);
#pragma unroll
            for (int k = 0; k < 4; ++k) { const int row = 8 * k + rr;
                const f32x4 a0 = (*(LAS const f32x4*)(st + row * 272 + ch * 32) + b0) * s0, a1 = (*(LAS const f32x4*)(st + row * 272 + ch * 32 + 16) + b1) * s1;
                const v4u gv = gpre[half][k];
                v4u w; w.x = pk2(a0[0] * bf_lo(gv.x), a0[1] * bf_hi(gv.x)); w.y = pk2(a0[2] * bf_lo(gv.y), a0[3] * bf_hi(gv.y));
                w.z = pk2(a1[0] * bf_lo(gv.z), a1[1] * bf_hi(gv.z)); w.w = pk2(a1[2] * bf_lo(gv.w), a1[3] * bf_hi(gv.w));
                *(v4u*)(CAT + (tokw + row) * DM + 512 + col) = w; }
            asm volatile("s_waitcnt lgkmcnt(0)" ::: "memory");
        }
    }
    __syncthreads();
}
__device__ __forceinline__ void pool_unit(int pm, int g, const bf16* U, const bf16* GP, const bf16* WpT, const float* bp, const float* ps, bf16* CAT, LAS char* shm) {
    if (g == 0) pool_unit_w<2>(pm, g, U, GP, WpT, bp, ps, CAT, shm);
    else if (g == 1) pool_unit_w<4>(pm, g, U, GP, WpT, bp, ps, CAT, shm);
    else if (g == 2) pool_unit_w<8>(pm, g, U, GP, WpT, bp, ps, CAT, shm);
    else pool_unit_w<16>(pm, g, U, GP, WpT, bp, ps, CAT, shm);
}
}

__device__ __forceinline__ float wave_sum(float v) {
#pragma unroll
    for (int o = 1; o < 64; o <<= 1) v += __shfl_xor(v, o);
    return v;
}
struct TrItem { const float* W; bf16* WT; int K, N, item; bool permn; };
__device__ __forceinline__ void tr_load(const TrItem& t, float (&v)[32], int lane) {
    const int nblk = t.N / 32, kb = t.item / nblk, nb = t.item % nblk, k0 = 64 * kb, n0 = 32 * nb;
#pragma unroll
    for (int i = 0; i < 32; ++i) { const int kk = 2 * i + (lane >> 5); v[i] = t.W[(size_t)(k0 + kk) * t.N + n0 + (lane & 31)]; }
}
__device__ __forceinline__ void tr_finish(const TrItem& t, const float (&v)[32], LAS float* scr, int lane) {
    const int nblk = t.N / 32, kb = t.item / nblk, nb = t.item % nblk, k0 = 64 * kb, n0 = 32 * nb;
#pragma unroll
    for (int i = 0; i < 32; ++i) { const int kk = 2 * i + (lane >> 5); scr[kk * 33 + (lane & 31)] = v[i]; }
    LDS_WAIT(); asm volatile("" ::: "memory");
    const int c = lane & 7;
#pragma unroll
    for (int j = 0; j < 4; ++j) { const int n = (lane >> 3) + 8 * j; const LAS float* s = scr + (8 * c) * 33 + n;
        v4u o; o.x = pk2(s[0 * 33], s[1 * 33]); o.y = pk2(s[2 * 33], s[3 * 33]); o.z = pk2(s[4 * 33], s[5 * 33]); o.w = pk2(s[6 * 33], s[7 * 33]);
        int na = n0 + n;
        if (t.permn) na = (na & ~255) + 128 * ((na >> 5) & 1) + 32 * ((na >> 6) & 3) + (na & 31);
        *(GAS v4u*)(t.WT + (size_t)na * t.K + k0 + 8 * c) = o; }
    LDS_WAIT(); asm volatile("" ::: "memory");
}

struct Args { const float* in[12]; float* out; unsigned char* ws; int ph_lo, ph_hi; int coop, pad; };
constexpr int N_PHASES = 5;

__global__ void __launch_bounds__(NWAVES * 64, 2) hybrid_fwd(Args args) {
    extern __shared__ __attribute__((aligned(16))) unsigned char lds[];
    LAS unsigned char* L = (LAS unsigned char*)lds;
    const int tid = threadIdx.x, lane = tid & 63, wave = __builtin_amdgcn_readfirstlane(tid >> 6);
    const int G = gridDim.x, bx = blockIdx.x;
    const int vcu = (G % 8 == 0) ? (bx % 8) * (G / 8) + bx / 8 : bx;
    const float* x = args.in[0]; const float* c = args.in[1]; const float* w_ada = args.in[2]; const float* b_ada = args.in[3]; const float* norm_g = args.in[4];
    const float* w_in = args.in[5]; const float* qg = args.in[6]; const float* kg = args.in[7]; const float* w_pool = args.in[8]; const float* b_pool = args.in[9];
    const float* pool_scale = args.in[10]; const float* w_out = args.in[11];
    unsigned char* ws = args.ws;
    float* mod = (float*)(ws + WS_MOD);
    bf16* Win_t = (bf16*)(ws + WS_WIN); bf16* Wout_t = (bf16*)(ws + WS_WOUT); bf16* WpT = (bf16*)(ws + WS_WPOOL);
    bf16* XN = (bf16*)(ws + WS_XN); bf16* PROJ = (bf16*)(ws + WS_PROJ); bf16* CAT = (bf16*)(ws + WS_CAT);
    const int lo = args.ph_lo, hi = args.ph_hi;
#define IN(k) (lo <= (k) && (k) < hi)
#define BOTH(k) (IN(k) && IN((k) + 1))
#if MK_COOP
    if (tid < 32) ((LAS unsigned*)(L + MISC_OFF))[tid] = 0u;
    __syncthreads();
    XcdBarrier bar = xcd_barrier_post((unsigned*)(ws + WS_CTL) + CW_BAR, (volatile LAS unsigned*)(L + MISC_OFF) + 8);
#define GRID_BAR() do { if (args.coop == 2) cg::this_grid().sync(); else xcd_barrier(bar); } while (0)
#else
#define GRID_BAR() do { } while (0)
#endif
    const int gw = vcu * NWAVES + wave, NGW = G * NWAVES;

    const bool fuse01 = false;
    f32x4 xr_[8][4]; float xs_[8];
    if (fuse01) {
#pragma unroll
        for (int q = 0; q < 8; ++q) { const GAS f32x4* xp = (const GAS f32x4*)(x + (size_t)(gw + q * NGW) * DM) + lane;
#pragma unroll
            for (int j = 0; j < 4; ++j) xr_[q][j] = xp[64 * j]; }
    }
    if (IN(0)) { for (int rep_ = 0; rep_ < MK_REP0; ++rep_) {
        LAS float* cact = (LAS float*)L;
        LAS float* red = (LAS float*)(L + 32768);
        LAS float* scr = (LAS float*)(L + 40960 + wave * 8448);
        constexpr int I_IN = (DM / 64) * (DIN / 32), I_OUT = (DM / 64) * (DM / 32), I_P = 4 * (128 / 64) * (128 / 32), I_ALL = I_IN + I_OUT + I_P;
        auto mk_item = [&](int it) { TrItem t; int r = it;
            if (r < I_IN) { t.W = w_in; t.WT = Win_t; t.K = DM; t.N = DIN; t.item = r; t.permn = true; return t; } r -= I_IN;
            if (r < I_OUT) { t.W = w_out; t.WT = Wout_t; t.K = DM; t.N = DM; t.item = r; t.permn = false; return t; } r -= I_OUT;
            const int g = r >> 3; t.W = w_pool + (size_t)g * 16384; t.WT = WpT + (size_t)g * 16384; t.K = 128; t.N = 128; t.item = r & 7; t.permn = false; return t; };
        for (int i = tid; i < BATCH * DM; i += NWAVES * 64) { const float v = c[i]; cact[i] = v / (1.0f + __expf(-v)); }
        __syncthreads();
        for (int cgp = bx; cgp < 256; cgp += G) {
            const int kq = tid >> 2, cq = tid & 3;
            float a[8][3];
#pragma unroll
            for (int b = 0; b < 8; ++b) { a[b][0] = 0.f; a[b][1] = 0.f; a[b][2] = 0.f; }
            float wv[8][3];
#pragma unroll
            for (int kk = 0; kk < 8; ++kk) { const float* wr = w_ada + (size_t)(kq * 8 + kk) * DIN + cgp * 12 + cq * 3; wv[kk][0] = wr[0]; wv[kk][1] = wr[1]; wv[kk][2] = wr[2]; }
#pragma unroll
            for (int kk = 0; kk < 8; ++kk) { const int k = kq * 8 + kk;
#pragma unroll
                for (int b = 0; b < 8; ++b) { const float ca = cact[b * DM + k]; a[b][0] += ca * wv[kk][0]; a[b][1] += ca * wv[kk][1]; a[b][2] += ca * wv[kk][2]; } }
#pragma unroll
            for (int b = 0; b < 8; ++b)
#pragma unroll
                for (int j = 0; j < 3; ++j) { float v = a[b][j]; v += __shfl_xor(v, 4); v += __shfl_xor(v, 8); v += __shfl_xor(v, 16); v += __shfl_xor(v, 32);
                    if (lane < 4) red[wave * 96 + b * 12 + cq * 3 + j] = v; }
            __syncthreads();
            if (tid < 96) { float s = 0.f;
#pragma unroll
                for (int w = 0; w < 8; ++w) s += red[w * 96 + tid];
                const int b = tid / 12, n = cgp * 12 + tid % 12; mod[b * DIN + n] = s + b_ada[n]; }
            __syncthreads();
        }
        for (int it = gw; it < I_ALL; it += NGW) { float tv[32]; const TrItem ti = mk_item(it); tr_load(ti, tv, lane); tr_finish(ti, tv, scr, lane); }
        __syncthreads(); }
        if (BOTH(0)) GRID_BAR();
    }
    if (IN(1) && fuse01) {
#pragma unroll
        for (int q = 0; q < 8; ++q) { float t = 0.f;
#pragma unroll
            for (int j = 0; j < 4; ++j) t += (xr_[q][j].x * xr_[q][j].x + xr_[q][j].y * xr_[q][j].y) + (xr_[q][j].z * xr_[q][j].z + xr_[q][j].w * xr_[q][j].w);
            xs_[q] = t; }
#pragma unroll
        for (int q = 0; q < 8; ++q) { const int m = gw + q * NGW;
            const float* mb = mod + (size_t)(m >> 11) * DIN;
            const float inv = 1.0f / sqrtf(wave_sum(xs_[q]) * (1.0f / DM) + 1e-6f);
            GAS unsigned long long* o8 = (GAS unsigned long long*)(XN + (size_t)m * DM) + lane;
#pragma unroll
            for (int j = 0; j < 4; ++j) { const int k = 4 * lane + 256 * j;
                const f32x4 gg = *(const f32x4*)(norm_g + k), sh = *(const f32x4*)(mb + k), sc = *(const f32x4*)(mb + DM + k);
                const f32x4 y = xr_[q][j] * inv * gg * (sc + 1.0f) + sh;
                o8[64 * j] = (unsigned long long)pk2(y.x, y.y) | ((unsigned long long)pk2(y.z, y.w) << 32); } }
        if (BOTH(1)) GRID_BAR();
    } else
    if (IN(1)) { for (int rep_ = 0; rep_ < MK_REP1; ++rep_) {
        for (int m0 = gw; m0 < M; m0 += 4 * NGW) {
            f32x4 v[4][4]; float s[4];
#pragma unroll
            for (int q = 0; q < 4; ++q) { const int m = m0 + q * NGW; const GAS f32x4* xr = (const GAS f32x4*)(x + (size_t)(m < M ? m : m0) * DM) + lane;
#pragma unroll
                for (int j = 0; j < 4; ++j) v[q][j] = xr[64 * j]; }
#pragma unroll
            for (int q = 0; q < 4; ++q) { float t = 0.f;
#pragma unroll
                for (int j = 0; j < 4; ++j) t += (v[q][j].x * v[q][j].x + v[q][j].y * v[q][j].y) + (v[q][j].z * v[q][j].z + v[q][j].w * v[q][j].w);
                s[q] = t; }
#pragma unroll
            for (int q = 0; q < 4; ++q) { const int m = m0 + q * NGW; if (m >= M) break;
                const float* mb = mod + (size_t)(m >> 11) * DIN;
                const float inv = 1.0f / sqrtf(wave_sum(s[q]) * (1.0f / DM) + 1e-6f);
                GAS unsigned long long* o8 = (GAS unsigned long long*)(XN + (size_t)m * DM) + lane;
#pragma unroll
                for (int j = 0; j < 4; ++j) { const int k = 4 * lane + 256 * j;
                    const f32x4 gg = *(const f32x4*)(norm_g + k), sh = *(const f32x4*)(mb + k), sc = *(const f32x4*)(mb + DM + k);
                    const f32x4 y = v[q][j] * inv * gg * (sc + 1.0f) + sh;
                    o8[64 * j] = (unsigned long long)pk2(y.x, y.y) | ((unsigned long long)pk2(y.z, y.w) << 32); } }
        }
        }
        if (BOTH(1)) GRID_BAR();
    }
    if (IN(2)) { for (int rep_ = 0; rep_ < MK_REP2; ++rep_) {
        pg8::Gemm g{XN, Win_t, M, DIN, DM}; pg8::StaticOrder S; S.init(M, DIN, G, bx);
        pg8::EpiInProj E{PROJ, PROJ_STRIDE, qg, kg};
        pg8::gemm_phase<pg8::EpiInProj, pg8::StaticOrder, true, true>(L, g, S, E);
        }
        if (BOTH(2)) GRID_BAR();
    }
    if (IN(3)) { for (int rep_ = 0; rep_ < MK_REP3; ++rep_) {
        const bf16* Qb = PROJ; const bf16* Kb = PROJ + PROJ_STRIDE; const bf16* Vb = PROJ + 2 * PROJ_STRIDE; const bf16* GAb = PROJ + 3 * PROJ_STRIDE;
        const bf16* Ub = PROJ + 4 * PROJ_STRIDE; const bf16* GPb = PROJ + 5 * PROJ_STRIDE;
        for (int i = vcu; i < 256; i += G) {
            const int bh = i >> 2, qq = i & 3;
            if (i & 1) pool::pool_unit(i >> 2, i & 3, Ub, GPb, WpT, b_pool, pool_scale, CAT, (LAS char*)L);
            att::attn_pass<MK_EARLY>(bh >> 3, bh & 7, 16 * qq + 8, Qb, Kb, Vb, GAb, CAT, (LAS char*)L);
            att::attn_pass<MK_EARLY>(bh >> 3, bh & 7, 16 * qq, Qb, Kb, Vb, GAb, CAT, (LAS char*)L);
            VM_WAIT(); __syncthreads();
            if (!(i & 1)) pool::pool_unit(i >> 2, i & 3, Ub, GPb, WpT, b_pool, pool_scale, CAT, (LAS char*)L);
        }
        }
        if (BOTH(3)) GRID_BAR();
    }
    if (IN(4)) { for (int rep_ = 0; rep_ < MK_REP4; ++rep_) {
        pg8::Gemm g{CAT, Wout_t, M, DM, DM}; pg8::StaticOrder S; S.init(M, DM, G, bx);
        pg8::EpiOutRes E{x, args.out, mod + 2 * DM};
        pg8::gemm_phase<pg8::EpiOutRes, pg8::StaticOrder, true, true>(L, g, S, E);
    } }
#undef IN
#undef BOTH
}

extern "C" void kernel_launch(void* const* d_in, const int* in_sizes, int n_in, void* d_out, int out_size, void* d_ws, size_t ws_size, hipStream_t stream) {
    static int grid = 0;
    if (grid == 0) {
        if (n_in != 12 || out_size != M * DM || ws_size < WS_END) { fprintf(stderr, "kernel_launch: unexpected shapes (n_in %d out %d ws %zu)\n", n_in, out_size, ws_size); grid = -1; return; }
        int dev = 0, cus = 0, per_cu = 0;
        if (hipGetDevice(&dev) != hipSuccess || hipDeviceGetAttribute(&cus, hipDeviceAttributeMultiprocessorCount, dev) != hipSuccess) { grid = -1; return; }
        if (hipFuncSetAttribute((const void*)hybrid_fwd, hipFuncAttributeMaxDynamicSharedMemorySize, LDS_BYTES) != hipSuccess) { fprintf(stderr, "kernel_launch: hipFuncSetAttribute failed\n"); grid = -1; return; }
        if (hipOccupancyMaxActiveBlocksPerMultiprocessor(&per_cu, (const void*)hybrid_fwd, NWAVES * 64, LDS_BYTES) != hipSuccess || per_cu < 1) { fprintf(stderr, "kernel_launch: occupancy query says %d\n", per_cu); per_cu = 1; }
        (void)hipGetLastError();
        grid = cus;
    }
    if (grid < 0) return;
#if MK_COOP
    if (hipMemsetAsync((char*)d_ws + WS_CTL, 0, CTL_ZERO_BYTES, stream) != hipSuccess) { fprintf(stderr, "kernel_launch: hipMemsetAsync failed\n"); return; }
#endif
    Args a{};
    for (int i = 0; i < 12; ++i) a.in[i] = (const float*)d_in[i];
    a.out = (float*)d_out; a.ws = (unsigned char*)d_ws;
#if MK_COOP
    a.ph_lo = 0; a.ph_hi = N_PHASES; a.coop = 1;
    void* kargs[] = {&a};
    hipError_t e = hipLaunchCooperativeKernel((const void*)hybrid_fwd, dim3(grid), dim3(NWAVES * 64), kargs, LDS_BYTES, stream);
    if (e != hipSuccess) fprintf(stderr, "kernel_launch: cooperative launch failed: %s (grid %d)\n", hipGetErrorString(e), grid);
#else
    for (int p = 0; p < N_PHASES; ++p) { a.ph_lo = p; a.ph_hi = p + 1; a.coop = 0;
        hipLaunchKernelGGL(hybrid_fwd, dim3(grid), dim3(NWAVES * 64), LDS_BYTES, stream, a); }
#endif
}
```

```cpp
#include <hip/hip_runtime.h>
#include <hip/hip_cooperative_groups.h>
#include <cstdio>
#include <cstdint>
namespace cg = cooperative_groups;
#ifndef MK_COOP
#define MK_COOP 1
#endif
#ifndef MK_EARLY
#define MK_EARLY true
#endif
#define PG8_SP2 true
#define PG8_ALIGN true
#ifndef MK_REP0
#define MK_REP0 1
#endif
#ifndef MK_REP1
#define MK_REP1 1
#endif
#ifndef MK_REP2
#define MK_REP2 1
#endif
#ifndef MK_REP3
#define MK_REP3 1
#endif
#ifndef MK_REP4
#define MK_REP4 1
#endif
#ifndef MK_REP3A
#define MK_REP3A 1
#endif
#ifndef MK_REP3P
#define MK_REP3P 1
#endif
#ifndef MK_STAMP
#define MK_STAMP -1
#endif
namespace pg8 {
#define PG8_LAS __attribute__((address_space(3)))
typedef unsigned short bf16_t;
typedef short bf16x8 __attribute__((ext_vector_type(8)));
typedef float f32x4 __attribute__((ext_vector_type(4)));
typedef unsigned u32x4 __attribute__((ext_vector_type(4)));
constexpr int BM = 256, BK = 64, HALF = 128, HTB = HALF * BK * 2  , STAGE_BYTES = 8 * HTB, NXCD = 8, WGM = 8;

__host__ __device__ __forceinline__ int lds_byte(int r, int c) { const int st = (r >> 4) * 2 + (c >> 5), rr = r & 15, cc = c & 31, ob = rr * 64 + cc * 2; return st * 1024 + (ob ^ (((ob >> 9) & 1) << 5)); }
__host__ __device__ __forceinline__ void stage_rc(int b, int& R, int& C) { const int st = b / 1024, sb = b % 1024, swz = sb ^ (((sb >> 9) & 1) << 5); R = (st >> 1) * 16 + swz / 64; C = (st & 1) * 32 + (swz % 64) / 2; }
__host__ __device__ __forceinline__ int perm32(int rho) { const int n = rho >> 4, i = rho & 15; return 8 * (i >> 2) + 4 * n + (i & 3); }

struct Unit { int pm, pn; };
struct Gemm { const bf16_t* A; const bf16_t* Bt; int M, N, K; };

struct StaticOrder {
    int nM, nN, nwg, G, c;
    __host__ __device__ void init(int M, int N, int G_, int c_) { nM = M / BM; nN = N / BM; nwg = nM * nN; G = G_; c = c_; }
    __host__ __device__ bool next(int i, Unit& u) const {
        const long L = (long)i * G + c; if (L >= nwg) return false;
        int wgid = (int)L; { const int q = nwg / NXCD, r = nwg % NXCD, xcd = wgid % NXCD, off = wgid / NXCD; wgid = (xcd < r ? xcd * (q + 1) : r * (q + 1) + (xcd - r) * q) + off; }
        const int nig = WGM * nN, gid = wgid / nig, fm = gid * WGM, gsz = (nM - fm) < WGM ? (nM - fm) : WGM;
        u.pm = fm + ((wgid % nig) % gsz); u.pn = (wgid % nig) / gsz; return true;
    }
    __device__ __forceinline__ void a_ready(const Unit&) const {}
    __device__ __forceinline__ void done(const Unit&) const {}
};
__device__ __forceinline__ unsigned cvt_pk_bf16(float lo, float hi) { unsigned r; asm volatile("v_cvt_pk_bf16_f32 %0, %1, %2" : "=v"(r) : "v"(lo), "v"(hi)); return r; }
typedef float f32x2 __attribute__((ext_vector_type(2)));
__device__ __forceinline__ float silu_f(float v) { return v * __builtin_amdgcn_rcpf(1.0f + __builtin_amdgcn_exp2f(-1.4426950408889634f * v)); }
constexpr float QSCALE = 0.125f * 1.4426950408889634f;
__device__ __forceinline__ size_t hm_off(int row, int head) { return ((size_t)((row >> 11) * 8 + head) * 2048 + (row & 2047)) * 64; }
struct EpiInProj {
    static constexpr bool PERM = true, AFTER_DRAIN = false;
    bf16_t* base; size_t stride; const float* gq; const float* gk;
    __device__ __forceinline__ void operator()(const f32x4 (&acc)[2][2][4][2], const Unit& u, int wr, int wc, int fr, int fq) const {
        const int type = u.pn >> 1;
        bf16_t* O = base + (size_t)type * stride;
        const int row0 = u.pm * BM + wr * 64 + fr;
        const int col0 = (u.pn & 1) * 256 + wc * 64 + 8 * fq;
        if (type < 2) {
            const float* g = type == 0 ? gq : gk; const float s = type == 0 ? QSCALE : 1.0f;
            f32x4 gs[2][2];
#pragma unroll
            for (int bj = 0; bj < 2; ++bj)
#pragma unroll
                for (int n = 0; n < 2; ++n) gs[bj][n] = *(const f32x4*)(g + 32 * bj + 8 * fq + 4 * n) * s;
#pragma unroll
            for (int ai = 0; ai < 2; ++ai)
#pragma unroll
                for (int m = 0; m < 4; ++m) {
                    float ss = 0.f;
#pragma unroll
                    for (int bj = 0; bj < 2; ++bj)
#pragma unroll
                        for (int n = 0; n < 2; ++n) { const f32x4 x = acc[ai][bj][m][n]; ss += (x[0] * x[0] + x[1] * x[1]) + (x[2] * x[2] + x[3] * x[3]); }
                    ss += __shfl_xor(ss, 16); ss += __shfl_xor(ss, 32);
                    const float inv = 1.0f / sqrtf(ss * (1.0f / 64.0f) + 1e-6f);
                    bf16_t* rowp = O + hm_off(row0 + ai * HALF + m * 16, (u.pn & 1) * 4 + wc) + 8 * fq;
#pragma unroll
                    for (int bj = 0; bj < 2; ++bj) { const f32x4 v0 = acc[ai][bj][m][0] * inv * gs[bj][0], v1 = acc[ai][bj][m][1] * inv * gs[bj][1];
                        u32x4 w; w.x = cvt_pk_bf16(v0[0], v0[1]); w.y = cvt_pk_bf16(v0[2], v0[3]); w.z = cvt_pk_bf16(v1[0], v1[1]); w.w = cvt_pk_bf16(v1[2], v1[3]);
                        *(u32x4*)(rowp + bj * 32) = w; }
                }
        } else {
            const bool act = (type == 3) || (type == 5);
#pragma unroll
            for (int ai = 0; ai < 2; ++ai)
#pragma unroll
                for (int m = 0; m < 4; ++m) {
                    const int row = row0 + ai * HALF + m * 16;
                    bf16_t* rowp = (type <= 3) ? O + hm_off(row, (u.pn & 1) * 4 + wc) + 8 * fq : O + ((size_t)((u.pn & 1) * 2 + (wc >> 1)) * 16384 + row) * 128 + (wc & 1) * 64 + 8 * fq;
#pragma unroll
                    for (int bj = 0; bj < 2; ++bj) { f32x4 v0 = acc[ai][bj][m][0], v1 = acc[ai][bj][m][1];
                        if (act) { v0 = (f32x4){silu_f(v0[0]), silu_f(v0[1]), silu_f(v0[2]), silu_f(v0[3])}; v1 = (f32x4){silu_f(v1[0]), silu_f(v1[1]), silu_f(v1[2]), silu_f(v1[3])}; }
                        u32x4 w; w.x = cvt_pk_bf16(v0[0], v0[1]); w.y = cvt_pk_bf16(v0[2], v0[3]); w.z = cvt_pk_bf16(v1[0], v1[1]); w.w = cvt_pk_bf16(v1[2], v1[3]);
                        *(u32x4*)(rowp + bj * 32) = w; }
                }
        }
    }
};
struct EpiOutRes {
    static constexpr bool PERM = false, AFTER_DRAIN = false;
    const float* x; float* out; const float* gate;
    __device__ __forceinline__ void operator()(const f32x4 (&acc)[2][2][4][2], const Unit& u, int wr, int wc, int fr, int fq) const {
        const int col0 = u.pn * BM + wc * 32 + 4 * fq;
        const float* gp = gate + (size_t)((u.pm * BM) >> 11) * 3072 + col0;
        f32x4 gv[2][2];
#pragma unroll
        for (int bj = 0; bj < 2; ++bj)
#pragma unroll
            for (int n = 0; n < 2; ++n) gv[bj][n] = *(const f32x4*)(gp + bj * HALF + n * 16);
#pragma unroll
        for (int ai = 0; ai < 2; ++ai)
#pragma unroll
            for (int m = 0; m < 4; ++m) { const size_t off = (size_t)(u.pm * BM + ai * HALF + wr * 64 + m * 16 + fr) * 1024 + col0;
#pragma unroll
                for (int bj = 0; bj < 2; ++bj)
#pragma unroll
                    for (int n = 0; n < 2; ++n) { const f32x4 xv = *(const f32x4*)(x + off + bj * HALF + n * 16);
                        *(f32x4*)(out + off + bj * HALF + n * 16) = xv + gv[bj][n] * acc[ai][bj][m][n]; } }
    }
};
template <class Epi, class Sched, bool ALIGN_EPI = false, bool SP2 = false>
__device__ __forceinline__ void gemm_phase(PG8_LAS unsigned char* lds, const Gemm g, const Sched& S, const Epi& E) {
    const int tid = threadIdx.x, wid = __builtin_amdgcn_readfirstlane(tid >> 6), lane = tid & 63, wr = wid >> 2, wc = wid & 3, fr = lane & 15, fq = lane >> 4;
    const int K = g.K, nt = K / BK;
    unsigned voffA[2], voffB[2];
#pragma unroll
    for (int i = 0; i < 2; ++i) { int R, C; stage_rc(tid * 16 + i * 8192, R, C); const int Rb = Epi::PERM ? ((R & ~31) + perm32(R & 31)) : R;
        voffA[i] = (unsigned)(R * K + C) * 2u; voffB[i] = (unsigned)(Rb * K + C) * 2u; }
    const size_t kstep = (size_t)(BK * 2);
    const size_t hstep = (size_t)HALF * K * 2;
    const size_t tstep = 2 * hstep;
    const unsigned ldsw = (unsigned)wid * 1024u;
    const int aoff = lds_byte(wr * 64 + fr, fq * 8), boff = lds_byte(wc * 32 + fr, fq * 8);
#define PG8_SA(b, h) (((b) * 2 + (h)) * HTB)
#define PG8_SB(b, h) ((4 + (b) * 2 + (h)) * HTB)
#define PG8_STAGE(bufoff, gbase, voff) do { _Pragma("unroll") for (int _i = 0; _i < 2; ++_i) \
        __builtin_amdgcn_global_load_lds((const unsigned*)((const char*)(gbase) + (voff)[_i]), (PG8_LAS unsigned*)(lds + (bufoff) + ldsw + _i * 8192), 16, 0, 0); } while (0)
#define PG8_LDA(dst, b, h) do { _Pragma("unroll") for (int m = 0; m < 4; ++m) _Pragma("unroll") for (int k = 0; k < 2; ++k) dst[m][k] = *(const PG8_LAS bf16x8*)(lds + PG8_SA(b, h) + aoff + m * 2048 + k * 1024); } while (0)
#define PG8_LDB(dst, b, h) do { _Pragma("unroll") for (int n = 0; n < 2; ++n) _Pragma("unroll") for (int k = 0; k < 2; ++k) dst[n][k] = *(const PG8_LAS bf16x8*)(lds + PG8_SB(b, h) + boff + n * 2048 + k * 1024); } while (0)
#define PG8_MMA(ai, bj, At, Bt) do { __builtin_amdgcn_s_setprio(1); _Pragma("unroll") for (int m = 0; m < 4; ++m) _Pragma("unroll") for (int n = 0; n < 2; ++n) _Pragma("unroll") for (int k = 0; k < 2; ++k) \
        acc[ai][bj][m][n] = __builtin_amdgcn_mfma_f32_16x16x32_bf16(Bt[n][k], At[m][k], acc[ai][bj][m][n], 0, 0, 0); __builtin_amdgcn_s_setprio(0); } while (0)
#define PG8_WAIT_V(n) asm volatile("s_waitcnt vmcnt(" #n ")" ::: "memory")
#define PG8_WAIT_L(n) asm volatile("s_waitcnt lgkmcnt(" #n ")" ::: "memory")
#define PG8_BAR __builtin_amdgcn_s_barrier()
#define PG8_SCHED __builtin_amdgcn_sched_barrier(0)
    Unit cur, nxt; int ui = 0;
    if (!S.next(0, cur)) return;
    f32x4 acc[2][2][4][2];
#pragma unroll
    for (int a = 0; a < 2; ++a)
#pragma unroll
        for (int b = 0; b < 2; ++b)
#pragma unroll
            for (int m = 0; m < 4; ++m)
#pragma unroll
                for (int n = 0; n < 2; ++n) acc[a][b][m][n] = (f32x4){0.f, 0.f, 0.f, 0.f};
    bf16x8 At[4][2], B0[2][2], B1[2][2];
    const char* cA = (const char*)g.A + (size_t)cur.pm * tstep; const char* cB = (const char*)g.Bt + (size_t)cur.pn * tstep;
    S.a_ready(cur);
    if constexpr (SP2) {
        PG8_STAGE(PG8_SB(0, 0), cB, voffB); PG8_STAGE(PG8_SB(0, 1), cB + hstep, voffB); PG8_STAGE(PG8_SA(0, 0), cA, voffA); PG8_STAGE(PG8_SA(0, 1), cA + hstep, voffA);
        if (wr == 1) PG8_BAR;
        PG8_WAIT_V(2); PG8_BAR;
        PG8_STAGE(PG8_SB(1, 0), cB + kstep, voffB); PG8_STAGE(PG8_SA(1, 0), cA + kstep, voffA); PG8_STAGE(PG8_SB(1, 1), cB + hstep + kstep, voffB);
        PG8_WAIT_V(6); PG8_BAR;
    } else {
        PG8_STAGE(PG8_SB(0, 0), cB, voffB); PG8_STAGE(PG8_SA(0, 0), cA, voffA); PG8_STAGE(PG8_SB(0, 1), cB + hstep, voffB); PG8_STAGE(PG8_SA(0, 1), cA + hstep, voffA);
        if (wr == 1) PG8_BAR;
        PG8_WAIT_V(4); PG8_BAR;
        PG8_STAGE(PG8_SB(1, 0), cB + kstep, voffB); PG8_STAGE(PG8_SA(1, 0), cA + kstep, voffA); PG8_STAGE(PG8_SB(1, 1), cB + hstep + kstep, voffB);
        PG8_WAIT_V(6); PG8_BAR;
    }
    for (;;) {
        const bool has_next = S.next(ui + 1, nxt);
        const char* nA = has_next ? (const char*)g.A + (size_t)nxt.pm * tstep : cA; const char* nB = has_next ? (const char*)g.Bt + (size_t)nxt.pn * tstep : cB;
        for (int t = 0; t < nt; t += 2) {
            const bool last = (t == nt - 2);
            const char* a1 = cA + (size_t)(t + 1) * kstep;
            const char* a2 = last ? nA : cA + (size_t)(t + 2) * kstep; const char* b2 = last ? nB : cB + (size_t)(t + 2) * kstep;
            const char* a3 = a2 + kstep; const char* b3 = b2 + kstep;
            if (last && has_next) S.a_ready(nxt);
            if constexpr (SP2) {
            PG8_LDB(B0, 0, 0); PG8_LDB(B1, 0, 1); PG8_SCHED; PG8_LDA(At, 0, 0); PG8_STAGE(PG8_SA(1, 1), a1 + hstep, voffA);
            PG8_WAIT_V(8); PG8_WAIT_L(0); PG8_BAR; PG8_MMA(0, 0, At, B0); PG8_MMA(0, 1, At, B1); PG8_BAR; PG8_SCHED;
            PG8_LDA(At, 0, 1); PG8_STAGE(PG8_SB(0, 0), b2, voffB); PG8_STAGE(PG8_SB(0, 1), b2 + hstep, voffB); PG8_STAGE(PG8_SA(0, 0), a2, voffA);
            PG8_WAIT_V(8); PG8_WAIT_L(0); PG8_BAR; PG8_MMA(1, 0, At, B0); PG8_MMA(1, 1, At, B1); PG8_BAR; PG8_SCHED;
            PG8_LDB(B0, 1, 0); PG8_LDB(B1, 1, 1); PG8_SCHED; PG8_LDA(At, 1, 0); PG8_STAGE(PG8_SA(0, 1), a2 + hstep, voffA);
            PG8_WAIT_V(8); PG8_WAIT_L(0); PG8_BAR; PG8_MMA(0, 0, At, B0); PG8_MMA(0, 1, At, B1); PG8_BAR; PG8_SCHED;
            PG8_LDA(At, 1, 1); PG8_STAGE(PG8_SB(1, 0), b3, voffB); PG8_STAGE(PG8_SB(1, 1), b3 + hstep, voffB); PG8_STAGE(PG8_SA(1, 0), a3, voffA);
            PG8_WAIT_V(8); PG8_WAIT_L(0); PG8_BAR; PG8_MMA(1, 0, At, B0); PG8_MMA(1, 1, At, B1); PG8_BAR; PG8_SCHED;
            } else {
            PG8_LDB(B0, 0, 0); PG8_SCHED; PG8_LDA(At, 0, 0); PG8_STAGE(PG8_SA(1, 1), a1 + hstep, voffA);
            PG8_WAIT_L(8); PG8_BAR; PG8_WAIT_L(0); PG8_MMA(0, 0, At, B0); PG8_BAR; PG8_SCHED;
            PG8_LDB(B1, 0, 1); PG8_STAGE(PG8_SB(0, 0), b2, voffB);
            PG8_BAR; PG8_WAIT_L(0); PG8_MMA(0, 1, At, B1); PG8_BAR;
            PG8_LDA(At, 0, 1); PG8_STAGE(PG8_SA(0, 0), a2, voffA);
            PG8_BAR; PG8_WAIT_L(0); PG8_MMA(1, 0, At, B0); PG8_BAR; PG8_SCHED;
            PG8_STAGE(PG8_SB(0, 1), b2 + hstep, voffB);
            PG8_WAIT_V(6); PG8_BAR; PG8_MMA(1, 1, At, B1); PG8_BAR;
            PG8_LDB(B0, 1, 0); PG8_SCHED; PG8_LDA(At, 1, 0); PG8_STAGE(PG8_SA(0, 1), a2 + hstep, voffA);
            PG8_WAIT_L(8); PG8_BAR; PG8_WAIT_L(0); PG8_MMA(0, 0, At, B0); PG8_BAR; PG8_SCHED;
            PG8_LDB(B1, 1, 1); PG8_STAGE(PG8_SB(1, 0), b3, voffB);
            PG8_BAR; PG8_WAIT_L(0); PG8_MMA(0, 1, At, B1); PG8_BAR;
            PG8_LDA(At, 1, 1); PG8_STAGE(PG8_SA(1, 0), a3, voffA);
            PG8_BAR; PG8_WAIT_L(0); PG8_MMA(1, 0, At, B0); PG8_BAR; PG8_SCHED;
            PG8_STAGE(PG8_SB(1, 1), b3 + hstep, voffB);
            PG8_WAIT_V(6); PG8_BAR; PG8_MMA(1, 1, At, B1); PG8_BAR;
            }
        }
        if constexpr (ALIGN_EPI) { if (wr == 0) PG8_BAR; }
#if MK_STAMP == 20 || MK_STAMP == 21 || MK_STAMP == 22 || MK_STAMP == 23
        if (threadIdx.x == 0) *(volatile PG8_LAS unsigned long long*)(lds + 147392) = __builtin_amdgcn_s_memrealtime();
#endif
        if constexpr (!Epi::AFTER_DRAIN) { E(acc, cur, wr, wc, fr, fq); S.done(cur); }
        if (!has_next) break;
#pragma unroll
        for (int a = 0; a < 2; ++a)
#pragma unroll
            for (int b = 0; b < 2; ++b)
#pragma unroll
                for (int m = 0; m < 4; ++m)
#pragma unroll
                    for (int n = 0; n < 2; ++n) acc[a][b][m][n] = (f32x4){0.f, 0.f, 0.f, 0.f};
        cur = nxt; cA = nA; cB = nB; ++ui;
        if constexpr (ALIGN_EPI) { if (wr == 1) PG8_BAR; }
    }
    PG8_WAIT_V(0);
    if constexpr (!ALIGN_EPI) { if (wr == 0) PG8_BAR; }
    PG8_BAR;
    if constexpr (Epi::AFTER_DRAIN) { E.fused(acc, cur, wr, wc, fr, fq, lds, wid, lane); S.done(cur); }
#undef PG8_SA
#undef PG8_SB
#undef PG8_STAGE
#undef PG8_LDA
#undef PG8_LDB
#undef PG8_MMA
#undef PG8_WAIT_V
#undef PG8_WAIT_L
#undef PG8_BAR
#undef PG8_SCHED
}
}

constexpr int NWAVES = 8;
constexpr int BATCH = 8, SEQ = 2048, DM = 1024, M = BATCH * SEQ, DIN = 3072, DH = 64, NH = 8, DA = 512;
constexpr size_t MiB = 1u << 20;
constexpr size_t WS_CTL = 0, CTL_ZERO_BYTES = 64 * 1024;
constexpr size_t WS_MOD = 1 * MiB;
constexpr size_t WS_WIN = 2 * MiB;
constexpr size_t WS_WOUT = 8 * MiB;
constexpr size_t WS_WPOOL = 10 * MiB;
constexpr size_t WS_XN = 16 * MiB;
constexpr size_t WS_PROJ = 48 * MiB;
constexpr size_t PROJ_STRIDE = (size_t)M * 512;
constexpr size_t WS_CAT = 144 * MiB;
constexpr size_t WS_END = 176 * MiB;
constexpr int RING_BYTES = 131072, LDS_BYTES = 147456, MISC_OFF = LDS_BYTES - 128;
constexpr int CW_BAR = 1024;

#define GAS __attribute__((address_space(1)))
#define LAS __attribute__((address_space(3)))
typedef unsigned short bf16;
typedef unsigned v4u __attribute__((ext_vector_type(4)));
typedef unsigned v2u __attribute__((ext_vector_type(2)));
typedef float f32x4 __attribute__((ext_vector_type(4)));
typedef float f32x16 __attribute__((ext_vector_type(16)));
typedef short bf16x8 __attribute__((ext_vector_type(8)));
typedef short s16x4 __attribute__((ext_vector_type(4)));
#define LDS_WAIT() asm volatile("s_waitcnt lgkmcnt(0)" ::: "memory")
#define VM_WAIT() asm volatile("s_waitcnt vmcnt(0)" ::: "memory")
__device__ __forceinline__ unsigned pk2(float lo, float hi) { return pg8::cvt_pk_bf16(lo, hi); }
__device__ __forceinline__ float bf_lo(unsigned u) { return __builtin_bit_cast(float, u << 16); }
__device__ __forceinline__ float bf_hi(unsigned u) { return __builtin_bit_cast(float, u & 0xffff0000u); }
#define XB_TMO      128
#define XB_XCNT(j)  (256  + 64 * (j))
#define XB_XSUB(j)  (1280 + 64 * (j))
#define XB_XGEN(j)  (2304 + 64 * (j))
#define XB_TOP      3328
#define XB_TOPGEN   3392
#define XCD_BAR_WORDS 3456
#define XB_SPIN_CAP (1u << 18)

__device__ __forceinline__ unsigned xb_ld(unsigned* p)              { return __hip_atomic_load(p, __ATOMIC_RELAXED, __HIP_MEMORY_SCOPE_AGENT); }
__device__ __forceinline__ unsigned xb_add(unsigned* p, unsigned v) { return __hip_atomic_fetch_add(p, v, __ATOMIC_RELAXED, __HIP_MEMORY_SCOPE_AGENT); }
__device__ __forceinline__ unsigned xb_xcc_id() { return (unsigned)__builtin_amdgcn_s_getreg((3 << 11) | 20) & 0xFu; }
#define XB_SPIN(cond, bar) do { unsigned _sp = 0; while (cond) { __builtin_amdgcn_s_sleep(1); \
    if ((++_sp & 255u) == 0u) { if (xb_ld(&(bar)[XB_TMO])) break; if (_sp > XB_SPIN_CAP) { atomicAdd(&(bar)[XB_TMO], 1u); break; } } } } while (0)

struct XcdBarrier {
    unsigned* bar; unsigned x;
    volatile LAS unsigned* st;
};

__device__ __forceinline__ XcdBarrier xcd_barrier_post(unsigned* bar, volatile LAS unsigned* st) {
    XcdBarrier b; b.bar = bar; b.x = xb_xcc_id(); b.st = st;
    if (threadIdx.x == 0) (void)xb_add(&bar[XB_XCNT(b.x)], 1u);
    return b;
}
__device__ __forceinline__ void xcd_barrier_complete(unsigned* bar, unsigned x, unsigned& nloc, unsigned& nx) {
    const unsigned G = gridDim.x * gridDim.y * gridDim.z;
    unsigned sum, cnt, mine, sp = 0u;
    for (;;) {
        sum = 0u; cnt = 0u; mine = 0u;
#pragma unroll
        for (unsigned j = 0; j < 16; ++j) { const unsigned c = xb_ld(&bar[XB_XCNT(j)]); sum += c; cnt += (c > 0u) ? 1u : 0u; mine = (j == x) ? c : mine; }
        if (sum == G) break;
        __builtin_amdgcn_s_sleep(1);
        if ((++sp & 255u) == 0u) { if (xb_ld(&bar[XB_TMO])) break; if (sp > XB_SPIN_CAP) { atomicAdd(&bar[XB_TMO], 1u); break; } }
    }
    nloc = mine > 0u ? mine : 1u; nx = cnt > 0u ? cnt : 1u;
}

__device__ __forceinline__ void xcd_barrier(const XcdBarrier& b) {
    asm volatile("s_waitcnt vmcnt(0)" ::: "memory");
    __syncthreads();
    if (threadIdx.x == 0) {
        unsigned* bar = b.bar;
        __builtin_amdgcn_s_waitcnt(0);
        unsigned nloc = b.st[0], nx = b.st[1];
        if (nloc == 0u) { xcd_barrier_complete(bar, b.x, nloc, nx); b.st[0] = nloc; b.st[1] = nx; }
        const unsigned old = xb_add(&bar[XB_XSUB(b.x)], 1u);
        const unsigned gen = old / nloc;
        if (old + 1u == (gen + 1u) * nloc) {
            __builtin_amdgcn_fence(__ATOMIC_RELEASE, "agent");
            asm volatile("s_waitcnt vmcnt(0)" ::: "memory");
            const unsigned og = xb_add(&bar[XB_TOP], 1u);
            const unsigned tg = og / nx;
            if (og + 1u == (tg + 1u) * nx) xb_add(&bar[XB_TOPGEN], 1u);
            else XB_SPIN(xb_ld(&bar[XB_TOPGEN]) == tg, bar);
            __builtin_amdgcn_fence(__ATOMIC_ACQUIRE, "agent");
            xb_add(&bar[XB_XGEN(b.x)], 1u);
            asm volatile("s_waitcnt vmcnt(0)" ::: "memory");
        } else {
            XB_SPIN(xb_ld(&bar[XB_XGEN(b.x)]) == gen, bar);
            __builtin_amdgcn_fence(__ATOMIC_ACQUIRE, "agent");
            asm volatile("s_waitcnt vmcnt(0)" ::: "memory");
        }
    }
    __syncthreads();
}

#ifndef MK_SEAMB
#define MK_SEAMB 1
#endif
__device__ __forceinline__ void cat_store16(bf16* CAT, size_t elem, v4u w) {
#if MK_SEAMB
    const __amdgpu_buffer_rsrc_t rs = __builtin_amdgcn_make_buffer_rsrc(CAT, 0, (int)((size_t)M * DM * 2), 0x00020000);
    __builtin_amdgcn_raw_buffer_store_b128(w, rs, (unsigned)(elem * 2), 0, 16);
#else
    *(v4u*)(CAT + elem) = w;
#endif
}
namespace att {
__device__ __forceinline__ void glds16(const void* gsrc, unsigned lds_dst) { unsigned keep;
    asm volatile("s_mov_b32 %0, m0\n\ts_mov_b32 m0, %2\n\ts_nop 0\n\tglobal_load_lds_dwordx4 %1, off\n\ts_mov_b32 m0, %0" : "=&s"(keep) : "v"(gsrc), "s"(lds_dst) : "memory"); }
typedef short v4i16_t __attribute__((ext_vector_type(4)));
__device__ __forceinline__ s16x4 vtr(LAS const char* p) { return __builtin_bit_cast(s16x4, __builtin_amdgcn_ds_read_tr16_b64_v4i16((LAS v4i16_t*)p)); }
constexpr int TILEB = 8192, VOFF = 4096, STAGE_OFF = 12 * TILEB, STAGE_B = 4608;
#ifndef ATT_HIST
#define ATT_HIST 0
#endif

template <bool DIAG>
__device__ __forceinline__ void tile_weights(f32x16& p0, float& carry, unsigned (&pw)[2][4], int kv0, int qabs, int hi) {
    float G[4];
#pragma unroll
    for (int i = 0; i < 4; ++i) {
        float rr[4], be[4];
#pragma unroll
        for (int j = 0; j < 4; ++j) {
            const float e = __builtin_amdgcn_exp2f(p0[4 * i + j]);
            float rv = __builtin_amdgcn_rcpf(1.0f + e); float bv = e * rv;
            if (DIAG) { const int kv = kv0 + 8 * i + 4 * hi + j; if (kv >= qabs) { rv = 1.0f; bv = 0.0f; } }
            rr[j] = rv; be[j] = bv;
        }
        const float s2 = rr[3], s1 = s2 * rr[2], s0 = s1 * rr[1];
        G[i] = s0 * rr[0];
        p0[4 * i + 3] = be[3]; p0[4 * i + 2] = be[2] * s2; p0[4 * i + 1] = be[1] * s1; p0[4 * i] = be[0] * s0;
    }
    float F[4]; float run = carry;
#pragma unroll
    for (int p = 3; p >= 0; --p) {
        auto sw = __builtin_amdgcn_permlane32_swap(__float_as_uint(G[p]), __float_as_uint(G[p]), false, false);
        const float g0 = __uint_as_float(sw[0]), g1 = __uint_as_float(sw[1]);
        F[p] = run * (hi ? 1.0f : g1);
        run = run * (g0 * g1);
    }
    carry = run;
#pragma unroll
    for (int i = 0; i < 4; ++i) { const float f = F[i];
        pw[i >> 1][2 * (i & 1)] = pk2(p0[4 * i] * f, p0[4 * i + 1] * f); pw[i >> 1][2 * (i & 1) + 1] = pk2(p0[4 * i + 2] * f, p0[4 * i + 3] * f); }
}

template <bool EARLY>
__device__ __forceinline__ void attn_pass(int b, int h, int qb0, const bf16* Q, const bf16* K, const bf16* V, const bf16* GA, bf16* CAT, LAS char* shm) {
    const int tid = threadIdx.x, lane = tid & 63, r32 = lane & 31, hi = lane >> 5; const int wid = __builtin_amdgcn_readfirstlane(tid >> 6);
    const size_t hb = ((size_t)(b * NH + h) * SEQ) * DH;
    const bf16* Qh = Q + hb; const bf16* Kh = K + hb; const bf16* Vh = V + hb;
    const unsigned lds0 = (unsigned)__builtin_amdgcn_readfirstlane((int)(unsigned)(uintptr_t)shm);
    const int wb = qb0 - ATT_HIST > 0 ? qb0 - ATT_HIST : 0, nw = qb0 + 8 - wb;
    const bf16* ksrc = Kh + (size_t)(lane >> 3) * DH + (((lane & 7) ^ ((lane >> 3) & 7)) * 8);
    const bf16* vsrc = Vh + (size_t)(lane >> 2) * DH + (lane & 3) * 8;
    for (int p = wid; p < nw * 8; p += NWAVES) {
        const int w = p >> 3, pc = p & 7; const size_t trow = (size_t)(wb + w) * 32;
        const unsigned dst = lds0 + w * TILEB + pc * 1024;
        if (pc < 4) glds16(ksrc + (trow + 8 * pc) * DH, dst);
        else glds16(vsrc + (trow + 16 * ((pc - 4) & 1)) * DH + 32 * ((pc - 4) >> 1), dst);
    }
    const int qblk = qb0 + wid, q0 = qblk * 32, qabs = q0 + r32;
    bf16x8 qr[4];
#pragma unroll
    for (int d0 = 0; d0 < 4; ++d0) qr[d0] = *reinterpret_cast<const bf16x8*>(&Qh[(size_t)qabs * DH + d0 * 16 + hi * 8]);
    const size_t tok0 = (size_t)b * SEQ + q0;
    v4u gpre[2][2];
#pragma unroll
    for (int dh = 0; dh < 2; ++dh)
#pragma unroll
        for (int k = 0; k < 2; ++k) gpre[dh][k] = *(const v4u*)(GA + hb + (size_t)(q0 + 16 * k + (lane >> 2)) * DH + 32 * dh + (lane & 3) * 8);
    asm volatile("s_waitcnt vmcnt(0)" ::: "memory");
    __syncthreads();
    f32x16 o[2]; o[0] = f32x16{}; o[1] = f32x16{};
    float carry = 1.0f; bool dead = false;
    LAS const char* kp0 = shm + r32 * 128;
    LAS const char* vp0 = shm + VOFF + ((lane >> 4) & 1) * 32 + (lane & 3) * 8 + (4 * hi + ((lane & 15) >> 2)) * 64;
#define ATT_TILE(DG) do { \
        const int w = t - wb; LAS const char* kp = kp0 + w * TILEB; f32x16 p0 = f32x16{}; \
        _Pragma("unroll") for (int d0 = 0; d0 < 4; ++d0) { const bf16x8 kf = *(LAS const bf16x8*)(kp + (((2 * d0 + hi) ^ (r32 & 7)) * 16)); p0 = __builtin_amdgcn_mfma_f32_32x32x16_bf16(kf, qr[d0], p0, 0, 0, 0); } \
        unsigned pw[2][4]; tile_weights<DG>(p0, carry, pw, t * 32, qabs, hi); \
        LAS const char* vp = vp0 + w * TILEB; \
        _Pragma("unroll") for (int dh = 0; dh < 2; ++dh) _Pragma("unroll") for (int ks = 0; ks < 2; ++ks) { \
            const s16x4 lo = vtr(vp + dh * 2048 + ks * 1024), hh = vtr(vp + dh * 2048 + ks * 1024 + 512); \
            const bf16x8 vf = (bf16x8){lo[0], lo[1], lo[2], lo[3], hh[0], hh[1], hh[2], hh[3]}; \
            const v4u pwv = (v4u){pw[ks][0], pw[ks][1], pw[ks][2], pw[ks][3]}; \
            o[dh] = __builtin_amdgcn_mfma_f32_32x32x16_bf16(vf, __builtin_bit_cast(bf16x8, pwv), o[dh], 0, 0, 0); } } while (0)
    int t = qblk;
    ATT_TILE(true);
    if (EARLY && __all(carry < 1e-30f)) dead = true;
    if (!dead) for (t = qblk - 1; t >= wb; --t) {
        ATT_TILE(false);
        if (EARLY) { if (__all(carry < 1e-30f)) { dead = true; break; } }
    }
#undef ATT_TILE
    if (!dead) {
        for (t = wb - 1; t >= 0; --t) {
            f32x16 p0 = f32x16{};
#pragma unroll
            for (int d0 = 0; d0 < 4; ++d0) {
                const bf16x8 kf = *reinterpret_cast<const bf16x8*>(&Kh[((size_t)t * 32 + r32) * DH + (2 * d0 + hi) * 8]);
                p0 = __builtin_amdgcn_mfma_f32_32x32x16_bf16(kf, qr[d0], p0, 0, 0, 0);
            }
            unsigned pw[2][4];
            tile_weights<false>(p0, carry, pw, t * 32, qabs, hi);
#pragma unroll
            for (int dh = 0; dh < 2; ++dh)
#pragma unroll
                for (int ks = 0; ks < 2; ++ks) {
                    bf16x8 vf;
#pragma unroll
                    for (int j = 0; j < 8; ++j) vf[j] = (short)Vh[((size_t)t * 32 + 16 * ks + 8 * (j >> 2) + 4 * hi + (j & 3)) * DH + 32 * dh + r32];
                    const v4u pwv = (v4u){pw[ks][0], pw[ks][1], pw[ks][2], pw[ks][3]};
                    o[dh] = __builtin_amdgcn_mfma_f32_32x32x16_bf16(vf, __builtin_bit_cast(bf16x8, pwv), o[dh], 0, 0, 0);
                }
            if (EARLY) { if (__all(carry < 1e-30f)) break; }
        }
    }
    {
        LAS char* st = shm + STAGE_OFF + wid * STAGE_B;
        const int rr = lane >> 2, ch = lane & 3;
#pragma unroll
        for (int dh = 0; dh < 2; ++dh) {
#pragma unroll
            for (int i = 0; i < 4; ++i) *(LAS f32x4*)(st + r32 * 144 + (8 * i + 4 * hi) * 4) = (f32x4){o[dh][4 * i], o[dh][4 * i + 1], o[dh][4 * i + 2], o[dh][4 * i + 3]};
            asm volatile("s_waitcnt lgkmcnt(0)" ::: "memory");
#pragma unroll
            for (int k = 0; k < 2; ++k) { const int row = 16 * k + rr;
                const f32x4 a0 = *(LAS const f32x4*)(st + row * 144 + ch * 32), a1 = *(LAS const f32x4*)(st + row * 144 + ch * 32 + 16);
                const v4u g = gpre[dh][k];
                v4u w; w.x = pk2(a0[0] * bf_lo(g.x), a0[1] * bf_hi(g.x)); w.y = pk2(a0[2] * bf_lo(g.y), a0[3] * bf_hi(g.y));
                w.z = pk2(a1[0] * bf_lo(g.z), a1[1] * bf_hi(g.z)); w.w = pk2(a1[2] * bf_lo(g.w), a1[3] * bf_hi(g.w));
                cat_store16(CAT, (tok0 + row) * DM + h * DH + 32 * dh + ch * 8, w); }
            asm volatile("s_waitcnt lgkmcnt(0)" ::: "memory");
        }
    }
    asm volatile("s_waitcnt vmcnt(0)" ::: "memory");
    __syncthreads();
}
}

namespace pool {
constexpr int UP = 272;
constexpr int UROWS = 272;
constexpr int WOFF = UROWS * UP;
typedef short v4i16_t __attribute__((ext_vector_type(4)));
__device__ __forceinline__ s16x4 vtr(LAS const char* p) { return __builtin_bit_cast(s16x4, __builtin_amdgcn_ds_read_tr16_b64_v4i16((LAS v4i16_t*)p)); }
template <int WIN>
__device__ __forceinline__ void pool_unit_w(int pm, int g, const bf16* U, const bf16* GP, const bf16* WpT, const float* bp, const float* ps, bf16* CAT, LAS char* shm) {
    const int tid = threadIdx.x, lane = tid & 63, r32 = lane & 31, hi = lane >> 5; const int wid = __builtin_amdgcn_readfirstlane(tid >> 6);
    asm volatile("" : "+s"(pm), "+s"(g));
    const int t0 = pm * 256, tpos0 = t0 & (SEQ - 1);
    v4u tu[9], tw[4];
#pragma unroll
    for (int k = 0; k < 9; ++k) { const int c = tid + k * 512, row = c >> 4, ch = c & 15; tu[k] = (v4u){0u, 0u, 0u, 0u};
        if (c < UROWS * 16 && tpos0 - 16 + row >= 0) tu[k] = *(const v4u*)(U + ((size_t)g * M + (t0 - 16 + row)) * 128 + ch * 8); }
#pragma unroll
    for (int k = 0; k < 4; ++k) { const int c = tid + k * 512; tw[k] = *(const v4u*)(WpT + (size_t)g * 16384 + (size_t)c * 8); }
#pragma unroll
    for (int k = 0; k < 9; ++k) { const int c = tid + k * 512, row = c >> 4, ch = c & 15; if (c < UROWS * 16) *(LAS v4u*)(shm + row * UP + ch * 16) = tu[k]; }
#pragma unroll
    for (int k = 0; k < 4; ++k) { const int c = tid + k * 512, row = c >> 4, ch = c & 15; *(LAS v4u*)(shm + WOFF + row * UP + ch * 16) = tw[k]; }
    v4u gpre[2][4];
#pragma unroll
    for (int half = 0; half < 2; ++half)
#pragma unroll
        for (int k = 0; k < 4; ++k) gpre[half][k] = *(const v4u*)(GP + ((size_t)g * M + t0 + wid * 32 + 8 * k + (lane >> 3)) * 128 + 64 * half + (lane & 7) * 8);
    __syncthreads();
    const int r = wid * 32 + r32, tpos = tpos0 + r;
    const float inv = 1.0f / (float)(tpos + 1 < WIN ? tpos + 1 : WIN);
    bf16x8 band[3];
#pragma unroll
    for (int ks = 0; ks < 3; ++ks)
#pragma unroll
        for (int j = 0; j < 8; ++j) { const int dlt = (r32 + 16) - (16 * ks + 8 * (j >> 2) + 4 * hi + (j & 3));
            band[ks][j] = (dlt >= 0 && dlt < WIN) ? (short)0x3F80 : (short)0; }
    LAS const char* ub = shm + (32 * wid + 4 * hi + ((lane & 15) >> 2)) * UP + (16 * ((lane >> 4) & 1) + 4 * (lane & 3)) * 2;
    LAS const char* urow = shm + (32 * wid + r32 + 16) * UP + 8 * hi;
    LAS const char* wl = shm + WOFF + r32 * UP + 8 * hi;
    f32x16 acc[4]; acc[0] = f32x16{}; acc[1] = f32x16{}; acc[2] = f32x16{}; acc[3] = f32x16{};
#pragma unroll 1
    for (int ct = 0; ct < 4; ++ct) {
        f32x16 X = f32x16{};
#pragma unroll
        for (int ks = 0; ks < 3; ++ks) {
            const s16x4 lo = vtr(ub + (16 * ks) * UP + ct * 64), hh = vtr(ub + (16 * ks + 8) * UP + ct * 64);
            const bf16x8 uf = (bf16x8){lo[0], lo[1], lo[2], lo[3], hh[0], hh[1], hh[2], hh[3]};
            X = __builtin_amdgcn_mfma_f32_32x32x16_bf16(uf, band[ks], X, 0, 0, 0);
        }
        unsigned pw[2][4];
#pragma unroll
        for (int i = 0; i < 4; ++i) { const v2u ut = *(LAS const v2u*)(urow + (32 * ct + 8 * i) * 2);
            pw[i >> 1][2 * (i & 1)] = pk2(X[4 * i] * inv - bf_lo(ut.x), X[4 * i + 1] * inv - bf_hi(ut.x));
            pw[i >> 1][2 * (i & 1) + 1] = pk2(X[4 * i + 2] * inv - bf_lo(ut.y), X[4 * i + 3] * inv - bf_hi(ut.y)); }
#pragma unroll
        for (int s2 = 0; s2 < 2; ++s2) { const int S = 2 * ct + s2;
            const v4u pv = (v4u){pw[s2][0], pw[s2][1], pw[s2][2], pw[s2][3]};
            const bf16x8 pfr = __builtin_bit_cast(bf16x8, pv);
#pragma unroll
            for (int n = 0; n < 4; ++n) { const v2u w0 = *(LAS const v2u*)(wl + n * 32 * UP + 32 * S), w1 = *(LAS const v2u*)(wl + n * 32 * UP + 32 * S + 16);
                const v4u wv = (v4u){w0.x, w0.y, w1.x, w1.y};
                acc[n] = __builtin_amdgcn_mfma_f32_32x32x16_bf16(__builtin_bit_cast(bf16x8, wv), pfr, acc[n], 0, 0, 0); }
        }
    }
    __syncthreads();
    {
        LAS char* st = shm + wid * 16384;
        const size_t tokw = (size_t)t0 + wid * 32;
        const int rr = lane >> 3, ch = lane & 7;
#pragma unroll
        for (int half = 0; half < 2; ++half) {
#pragma unroll
            for (int nn = 0; nn < 2; ++nn)
#pragma unroll
                for (int i = 0; i < 4; ++i) { const int n = 2 * half + nn;
                    *(LAS f32x4*)(st + r32 * 272 + (32 * nn + 8 * i + 4 * hi) * 4) = (f32x4){acc[n][4 * i], acc[n][4 * i + 1], acc[n][4 * i + 2], acc[n][4 * i + 3]}; }
            asm volatile("s_waitcnt lgkmcnt(0)" ::: "memory");
            const int col = g * 128 + 64 * half + ch * 8;
            const f32x4 b0 = *(const f32x4*)(bp + col), b1 = *(const f32x4*)(bp + col + 4), s0 = *(const f32x4*)(ps + col), s1 = *(const f32x4*)(ps + col + 4);
#pragma unroll
            for (int k = 0; k < 4; ++k) { const int row = 8 * k + rr;
                const f32x4 a0 = (*(LAS const f32x4*)(st + row * 272 + ch * 32) + b0) * s0, a1 = (*(LAS const f32x4*)(st + row * 272 + ch * 32 + 16) + b1) * s1;
                const v4u gv = gpre[half][k];
                v4u w; w.x = pk2(a0[0] * bf_lo(gv.x), a0[1] * bf_hi(gv.x)); w.y = pk2(a0[2] * bf_lo(gv.y), a0[3] * bf_hi(gv.y));
                w.z = pk2(a1[0] * bf_lo(gv.z), a1[1] * bf_hi(gv.z)); w.w = pk2(a1[2] * bf_lo(gv.w), a1[3] * bf_hi(gv.w));
                cat_store16(CAT, (tokw + row) * DM + 512 + col, w); }
            asm volatile("s_waitcnt lgkmcnt(0)" ::: "memory");
        }
    }
    asm volatile("s_waitcnt vmcnt(0)" ::: "memory");
    __syncthreads();
}
__device__ __forceinline__ void pool_unit(int pm, int g, const bf16* U, const bf16* GP, const bf16* WpT, const float* bp, const float* ps, bf16* CAT, LAS char* shm) {
    if (g == 0) pool_unit_w<2>(pm, g, U, GP, WpT, bp, ps, CAT, shm);
    else if (g == 1) pool_unit_w<4>(pm, g, U, GP, WpT, bp, ps, CAT, shm);
    else if (g == 2) pool_unit_w<8>(pm, g, U, GP, WpT, bp, ps, CAT, shm);
    else pool_unit_w<16>(pm, g, U, GP, WpT, bp, ps, CAT, shm);
}
}

__device__ __forceinline__ float wave_sum(float v) {
#pragma unroll
    for (int o = 1; o < 64; o <<= 1) v += __shfl_xor(v, o);
    return v;
}
struct TrItem { const float* W; bf16* WT; int K, N, item; bool permn; };
__device__ __forceinline__ void tr_load(const TrItem& t, float (&v)[32], int lane) {
    const int nblk = t.N / 32, kb = t.item / nblk, nb = t.item % nblk, k0 = 64 * kb, n0 = 32 * nb;
#pragma unroll
    for (int i = 0; i < 32; ++i) { const int kk = 2 * i + (lane >> 5); v[i] = t.W[(size_t)(k0 + kk) * t.N + n0 + (lane & 31)]; }
}
__device__ __forceinline__ void tr_finish(const TrItem& t, const float (&v)[32], LAS float* scr, int lane) {
    const int nblk = t.N / 32, kb = t.item / nblk, nb = t.item % nblk, k0 = 64 * kb, n0 = 32 * nb;
#pragma unroll
    for (int i = 0; i < 32; ++i) { const int kk = 2 * i + (lane >> 5); scr[kk * 33 + (lane & 31)] = v[i]; }
    LDS_WAIT(); asm volatile("" ::: "memory");
    const int c = lane & 7;
#pragma unroll
    for (int j = 0; j < 4; ++j) { const int n = (lane >> 3) + 8 * j; const LAS float* s = scr + (8 * c) * 33 + n;
        v4u o; o.x = pk2(s[0 * 33], s[1 * 33]); o.y = pk2(s[2 * 33], s[3 * 33]); o.z = pk2(s[4 * 33], s[5 * 33]); o.w = pk2(s[6 * 33], s[7 * 33]);
        int na = n0 + n;
        if (t.permn) na = (na & ~255) + 128 * ((na >> 5) & 1) + 32 * ((na >> 6) & 3) + (na & 31);
        *(GAS v4u*)(t.WT + (size_t)na * t.K + k0 + 8 * c) = o; }
    LDS_WAIT(); asm volatile("" ::: "memory");
}

struct Args { const float* in[12]; float* out; unsigned char* ws; int ph_lo, ph_hi; int coop, pad; };
constexpr int N_PHASES = 5;

__global__ void __launch_bounds__(NWAVES * 64, 2) hybrid_fwd(Args args) {
    extern __shared__ __attribute__((aligned(16))) unsigned char lds[];
    LAS unsigned char* L = (LAS unsigned char*)lds;
    const int tid = threadIdx.x, lane = tid & 63, wave = __builtin_amdgcn_readfirstlane(tid >> 6);
    const int G = gridDim.x, bx = blockIdx.x;
    const int vcu = (G % 8 == 0) ? (bx % 8) * (G / 8) + bx / 8 : bx;
    const float* x = args.in[0]; const float* c = args.in[1]; const float* w_ada = args.in[2]; const float* b_ada = args.in[3]; const float* norm_g = args.in[4];
    const float* w_in = args.in[5]; const float* qg = args.in[6]; const float* kg = args.in[7]; const float* w_pool = args.in[8]; const float* b_pool = args.in[9];
    const float* pool_scale = args.in[10]; const float* w_out = args.in[11];
    unsigned char* ws = args.ws;
    float* mod = (float*)(ws + WS_MOD);
    bf16* Win_t = (bf16*)(ws + WS_WIN); bf16* Wout_t = (bf16*)(ws + WS_WOUT); bf16* WpT = (bf16*)(ws + WS_WPOOL);
    bf16* XN = (bf16*)(ws + WS_XN); bf16* PROJ = (bf16*)(ws + WS_PROJ); bf16* CAT = (bf16*)(ws + WS_CAT);
    const int lo = args.ph_lo, hi = args.ph_hi;
#define IN(k) (lo <= (k) && (k) < hi)
#define BOTH(k) (IN(k) && IN((k) + 1))
#if MK_COOP
    if (tid < 32) ((LAS unsigned*)(L + MISC_OFF))[tid] = 0u;
    __syncthreads();
    XcdBarrier bar = xcd_barrier_post((unsigned*)(ws + WS_CTL) + CW_BAR, (volatile LAS unsigned*)(L + MISC_OFF) + 8);
#define GRID_BAR() do { if (args.coop == 2) cg::this_grid().sync(); else xcd_barrier(bar); } while (0)
#else
#define GRID_BAR() do { } while (0)
#endif
    const int gw = vcu * NWAVES + wave, NGW = G * NWAVES;
    unsigned* ctl = (unsigned*)(ws + WS_CTL); constexpr int CW_SEAM_B = 12288;
    const bool pseamB = MK_SEAMB && MK_COOP && G == 256 && lo == 0 && hi == N_PHASES && MK_STAMP < 0 && MK_REP3 == 1;
    constexpr int CW_SEAM_A = 8192;
    const bool pseamA = pseamB && MK_REP1 == 1;
    pg8::Unit u2; u2.pm = 0; u2.pn = 0; if (pseamA) { pg8::StaticOrder S2; S2.init(M, DIN, G, bx); S2.next(0, u2); }
#define PANEL_ARRIVE(p_) do { if (pseamB && tid == 0) __hip_atomic_fetch_add(ctl + CW_SEAM_B + 64 * (p_), 1u, __ATOMIC_RELAXED, __HIP_MEMORY_SCOPE_AGENT); } while (0)
#if MK_STAMP >= 0
    unsigned long long ts_[8]; ts_[0] = __builtin_amdgcn_s_memrealtime();
#define STAMP(k) do { ts_[k] = __builtin_amdgcn_s_memrealtime(); } while (0)
    unsigned long long tsub_[4] = {0, 0, 0, 0}; unsigned long long tk2_ = 0, tk2e_ = 0;
#define SUBSTAMP(k) do { tsub_[k] = __builtin_amdgcn_s_memrealtime(); } while (0)
#else
#define STAMP(k) do { } while (0)
#define SUBSTAMP(k) do { } while (0)
#endif

    const bool fuse01 = false;
    f32x4 xr_[8][4]; float xs_[8];
    if (fuse01) {
#pragma unroll
        for (int q = 0; q < 8; ++q) { const GAS f32x4* xp = (const GAS f32x4*)(x + (size_t)(gw + q * NGW) * DM) + lane;
#pragma unroll
            for (int j = 0; j < 4; ++j) xr_[q][j] = xp[64 * j]; }
    }
    if (IN(0)) { for (int rep_ = 0; rep_ < MK_REP0; ++rep_) {
        LAS float* cact = (LAS float*)L;
        LAS float* red = (LAS float*)(L + 32768);
        LAS float* scr = (LAS float*)(L + 40960 + wave * 8448);
        constexpr int I_IN = (DM / 64) * (DIN / 32), I_OUT = (DM / 64) * (DM / 32), I_P = 4 * (128 / 64) * (128 / 32), I_ALL = I_IN + I_OUT;
        auto mk_item = [&](int it) { TrItem t; int r = it;
            if (r < I_IN) { t.W = w_in; t.WT = Win_t; t.K = DM; t.N = DIN; t.item = r; t.permn = true; return t; } r -= I_IN;
            if (r < I_OUT) { t.W = w_out; t.WT = Wout_t; t.K = DM; t.N = DM; t.item = r; t.permn = false; return t; } r -= I_OUT;
            const int g = r >> 3; t.W = w_pool + (size_t)g * 16384; t.WT = WpT + (size_t)g * 16384; t.K = 128; t.N = 128; t.item = r & 7; t.permn = false; return t; };
        const int kq = tid >> 2, cq = tid & 3, cgp0 = bx < 256 ? bx : 0;
        float cv[16], wv[8][3], tv[32]; const int it0 = gw; const TrItem ti0 = mk_item(it0 < I_ALL ? it0 : 0);
#pragma unroll
        for (int i = 0; i < 16; ++i) cv[i] = c[tid + i * 512];
#pragma unroll
        for (int kk = 0; kk < 8; ++kk) { const float* wr = w_ada + (size_t)(kq * 8 + kk) * DIN + cgp0 * 12 + cq * 3; wv[kk][0] = wr[0]; wv[kk][1] = wr[1]; wv[kk][2] = wr[2]; }
        const float bias0 = (tid < 96) ? b_ada[cgp0 * 12 + tid % 12] : 0.f;
        if (it0 < I_ALL) tr_load(ti0, tv, lane);
#pragma unroll
        for (int i = 0; i < 16; ++i) { const float v = cv[i]; cact[tid + i * 512] = v / (1.0f + __expf(-v)); }
        __syncthreads();
        for (int cgp = bx; cgp < 256; cgp += G) {
            float a[8][3];
#pragma unroll
            for (int b = 0; b < 8; ++b) { a[b][0] = 0.f; a[b][1] = 0.f; a[b][2] = 0.f; }
            if (cgp != cgp0) {
#pragma unroll
                for (int kk = 0; kk < 8; ++kk) { const float* wr = w_ada + (size_t)(kq * 8 + kk) * DIN + cgp * 12 + cq * 3; wv[kk][0] = wr[0]; wv[kk][1] = wr[1]; wv[kk][2] = wr[2]; } }
#pragma unroll
            for (int kk = 0; kk < 8; ++kk) { const int k = kq * 8 + kk;
#pragma unroll
                for (int b = 0; b < 8; ++b) { const float ca = cact[b * DM + k]; a[b][0] += ca * wv[kk][0]; a[b][1] += ca * wv[kk][1]; a[b][2] += ca * wv[kk][2]; } }
            float v24[24];
#pragma unroll
            for (int b = 0; b < 8; ++b)
#pragma unroll
                for (int j = 0; j < 3; ++j) v24[b * 3 + j] = a[b][j];
#pragma unroll
            for (int i = 0; i < 12; ++i) { const bool up = (lane & 32) != 0; const float keep = up ? v24[i + 12] : v24[i], give = up ? v24[i] : v24[i + 12]; v24[i] = keep + __shfl_xor(give, 32); }
#pragma unroll
            for (int i = 0; i < 6; ++i) { const bool up = (lane & 16) != 0; const float keep = up ? v24[i + 6] : v24[i], give = up ? v24[i] : v24[i + 6]; v24[i] = keep + __shfl_xor(give, 16); }
#pragma unroll
            for (int i = 0; i < 3; ++i) { const bool up = (lane & 8) != 0; const float keep = up ? v24[i + 3] : v24[i], give = up ? v24[i] : v24[i + 3]; v24[i] = keep + __shfl_xor(give, 8); }
#pragma unroll
            for (int i = 0; i < 3; ++i) { v24[i] += __shfl_xor(v24[i], 4);
                const int idx = 12 * ((lane >> 5) & 1) + 6 * ((lane >> 4) & 1) + 3 * ((lane >> 3) & 1) + i;
                if ((lane & 4) == 0) red[wave * 96 + (idx / 3) * 12 + cq * 3 + (idx % 3)] = v24[i]; }
            __syncthreads();
            if (tid < 96) { float s = 0.f;
#pragma unroll
                for (int w = 0; w < 8; ++w) s += red[w * 96 + tid];
                const int b = tid / 12, n = cgp * 12 + tid % 12; mod[b * DIN + n] = s + (cgp == cgp0 ? bias0 : b_ada[n]); }
            __syncthreads();
        }
        if (it0 < I_ALL) tr_finish(ti0, tv, scr, lane);
        for (int it = gw + NGW; it < I_ALL; it += NGW) { float tv[32]; const TrItem ti = mk_item(it); tr_load(ti, tv, lane); tr_finish(ti, tv, scr, lane); }
        __syncthreads(); }
        if (BOTH(0)) GRID_BAR();
        STAMP(1);
    }
    if (IN(1) && fuse01) {
#pragma unroll
        for (int q = 0; q < 8; ++q) { float t = 0.f;
#pragma unroll
            for (int j = 0; j < 4; ++j) t += (xr_[q][j].x * xr_[q][j].x + xr_[q][j].y * xr_[q][j].y) + (xr_[q][j].z * xr_[q][j].z + xr_[q][j].w * xr_[q][j].w);
            xs_[q] = t; }
#pragma unroll
        for (int q = 0; q < 8; ++q) { const int m = gw + q * NGW;
            const float* mb = mod + (size_t)(m >> 11) * DIN;
            const float inv = 1.0f / sqrtf(wave_sum(xs_[q]) * (1.0f / DM) + 1e-6f);
            GAS unsigned long long* o8 = (GAS unsigned long long*)(XN + (size_t)m * DM) + lane;
#pragma unroll
            for (int j = 0; j < 4; ++j) { const int k = 4 * lane + 256 * j;
                const f32x4 gg = *(const f32x4*)(norm_g + k), sh = *(const f32x4*)(mb + k), sc = *(const f32x4*)(mb + DM + k);
                const f32x4 y = xr_[q][j] * inv * gg * (sc + 1.0f) + sh;
                o8[64 * j] = (unsigned long long)pk2(y.x, y.y) | ((unsigned long long)pk2(y.z, y.w) << 32); } }
        if (BOTH(1)) GRID_BAR();
        STAMP(2);
    } else
    if (IN(1)) { for (int rep_ = 0; rep_ < MK_REP1; ++rep_) {
        { constexpr int I_P = 4 * (128 / 64) * (128 / 32);
            LAS float* scr = (LAS float*)(L + 40960 + wave * 8448);
            for (int it = gw; it < I_P; it += NGW) { float tv[32]; TrItem t; const int g = it >> 3; t.W = w_pool + (size_t)g * 16384; t.WT = WpT + (size_t)g * 16384; t.K = 128; t.N = 128; t.item = it & 7; t.permn = false;
                tr_load(t, tv, lane); tr_finish(t, tv, scr, lane); } }
        if (pseamA) {
            const int mb0 = 256 * u2.pm + 64 * u2.pn + 8 * wave; const float* mb = mod + (size_t)(mb0 >> 11) * DIN;
            f32x4 v[8][4], ga[4], sh4[4];
#pragma unroll
            for (int q = 0; q < 8; ++q) { const GAS f32x4* xr = (const GAS f32x4*)(x + (size_t)(mb0 + q) * DM) + lane;
#pragma unroll
                for (int j = 0; j < 4; ++j) v[q][j] = xr[64 * j]; }
#pragma unroll
            for (int j = 0; j < 4; ++j) { const int k = 4 * lane + 256 * j; ga[j] = *(const f32x4*)(norm_g + k) * (*(const f32x4*)(mb + DM + k) + 1.0f); sh4[j] = *(const f32x4*)(mb + k); }
#pragma unroll
            for (int q = 0; q < 8; ++q) { float t = 0.f;
#pragma unroll
                for (int j = 0; j < 4; ++j) t += (v[q][j].x * v[q][j].x + v[q][j].y * v[q][j].y) + (v[q][j].z * v[q][j].z + v[q][j].w * v[q][j].w);
                const float inv = 1.0f / sqrtf(wave_sum(t) * (1.0f / DM) + 1e-6f);
                GAS unsigned long long* o8 = (GAS unsigned long long*)(XN + (size_t)(mb0 + q) * DM) + lane;
#pragma unroll
                for (int j = 0; j < 4; ++j) { const f32x4 y = v[q][j] * inv * ga[j] + sh4[j];
                    __hip_atomic_store(o8 + 64 * j, (unsigned long long)pk2(y.x, y.y) | ((unsigned long long)pk2(y.z, y.w) << 32), __ATOMIC_RELAXED, __HIP_MEMORY_SCOPE_AGENT); } }
        }
        const int mfirst = pseamA ? M : gw, mstep = NGW, mend = M;
        for (int m0 = mfirst; m0 < mend; m0 += 4 * mstep) {
            f32x4 v[4][4]; float s[4];
#pragma unroll
            for (int q = 0; q < 4; ++q) { const int m = m0 + q * mstep; const GAS f32x4* xr = (const GAS f32x4*)(x + (size_t)(m < M ? m : m0) * DM) + lane;
#pragma unroll
                for (int j = 0; j < 4; ++j) v[q][j] = xr[64 * j]; }
#pragma unroll
            for (int q = 0; q < 4; ++q) { float t = 0.f;
#pragma unroll
                for (int j = 0; j < 4; ++j) t += (v[q][j].x * v[q][j].x + v[q][j].y * v[q][j].y) + (v[q][j].z * v[q][j].z + v[q][j].w * v[q][j].w);
                s[q] = t; }
#pragma unroll
            for (int q = 0; q < 4; ++q) { const int m = m0 + q * mstep; if (m >= M) break;
                const float* mb = mod + (size_t)(m >> 11) * DIN;
                const float inv = 1.0f / sqrtf(wave_sum(s[q]) * (1.0f / DM) + 1e-6f);
                GAS unsigned long long* o8 = (GAS unsigned long long*)(XN + (size_t)m * DM) + lane;
#pragma unroll
                for (int j = 0; j < 4; ++j) { const int k = 4 * lane + 256 * j;
                    const f32x4 gg = *(const f32x4*)(norm_g + k), sh = *(const f32x4*)(mb + k), sc = *(const f32x4*)(mb + DM + k);
                    const f32x4 y = v[q][j] * inv * gg * (sc + 1.0f) + sh;
                    const unsigned long long pk8 = (unsigned long long)pk2(y.x, y.y) | ((unsigned long long)pk2(y.z, y.w) << 32);
                    if (pseamA) __hip_atomic_store(o8 + 64 * j, pk8, __ATOMIC_RELAXED, __HIP_MEMORY_SCOPE_AGENT); else o8[64 * j] = pk8; } }
        }
        }
        if (pseamA) {
            asm volatile("s_waitcnt vmcnt(0)" ::: "memory");
            __syncthreads();
            if (tid == 0) { unsigned* cnt = ctl + CW_SEAM_A + 64 * u2.pm;
                __hip_atomic_fetch_add(cnt, 1u, __ATOMIC_RELAXED, __HIP_MEMORY_SCOPE_AGENT);
                while (__hip_atomic_load(cnt, __ATOMIC_RELAXED, __HIP_MEMORY_SCOPE_AGENT) < 4u) __builtin_amdgcn_s_sleep(1);
                __builtin_amdgcn_fence(__ATOMIC_ACQUIRE, "agent"); asm volatile("s_waitcnt vmcnt(0)" ::: "memory"); }
            __syncthreads();
        } else if (BOTH(1)) GRID_BAR();
        STAMP(2);
    }
    if (IN(2)) { for (int rep_ = 0; rep_ < MK_REP2; ++rep_) {
        pg8::Gemm g{XN, Win_t, M, DIN, DM}; pg8::StaticOrder S; S.init(M, DIN, G, bx);
        pg8::EpiInProj E{PROJ, PROJ_STRIDE, qg, kg};
        pg8::gemm_phase<pg8::EpiInProj, pg8::StaticOrder, true, true>(L, g, S, E);
#if MK_STAMP == 22 || MK_STAMP == 23
        tk2_ = *(volatile LAS unsigned long long*)(L + 147392); tk2e_ = __builtin_amdgcn_s_memrealtime();
#endif
        }
        if (BOTH(2)) GRID_BAR();
        STAMP(3);
    }
    if (IN(3)) { for (int rep_ = 0; rep_ < MK_REP3; ++rep_) {
        const bf16* Qb = PROJ; const bf16* Kb = PROJ + PROJ_STRIDE; const bf16* Vb = PROJ + 2 * PROJ_STRIDE; const bf16* GAb = PROJ + 3 * PROJ_STRIDE;
        const bf16* Ub = PROJ + 4 * PROJ_STRIDE; const bf16* GPb = PROJ + 5 * PROJ_STRIDE;
        for (int i = vcu; i < 256; i += G) {
            const int bh = i >> 2, qq = i & 3;
            if (i & 1) { pool::pool_unit(i >> 2, i & 3, Ub, GPb, WpT, b_pool, pool_scale, CAT, (LAS char*)L); PANEL_ARRIVE(i >> 2); }
            SUBSTAMP(0);
            att::attn_pass<MK_EARLY>(bh >> 3, bh & 7, 16 * qq + 8, Qb, Kb, Vb, GAb, CAT, (LAS char*)L);
            PANEL_ARRIVE((bh >> 3) * 8 + 2 * qq + 1);
            SUBSTAMP(1);
            att::attn_pass<MK_EARLY>(bh >> 3, bh & 7, 16 * qq, Qb, Kb, Vb, GAb, CAT, (LAS char*)L);
            PANEL_ARRIVE((bh >> 3) * 8 + 2 * qq);
            VM_WAIT(); __syncthreads();
            SUBSTAMP(2);
            if (!(i & 1)) { pool::pool_unit(i >> 2, i & 3, Ub, GPb, WpT, b_pool, pool_scale, CAT, (LAS char*)L); PANEL_ARRIVE(i >> 2); }
            VM_WAIT(); SUBSTAMP(3);
        }
        }
        if (!pseamB && BOTH(3)) GRID_BAR();
        STAMP(4);
    }
    if (IN(4)) { for (int rep_ = 0; rep_ < MK_REP4; ++rep_) {
        pg8::Gemm g{CAT, Wout_t, M, DM, DM}; pg8::StaticOrder S; S.init(M, DM, G, bx);
        if (pseamB) { pg8::Unit u4; S.next(0, u4);
            if (tid == 0) { unsigned* cnt = ctl + CW_SEAM_B + 64 * u4.pm;
                while (__hip_atomic_load(cnt, __ATOMIC_RELAXED, __HIP_MEMORY_SCOPE_AGENT) < 12u) __builtin_amdgcn_s_sleep(1);
                __builtin_amdgcn_fence(__ATOMIC_ACQUIRE, "agent"); asm volatile("s_waitcnt vmcnt(0)" ::: "memory"); }
            __syncthreads(); }
        pg8::EpiOutRes E{x, args.out, mod + 2 * DM};
        pg8::gemm_phase<pg8::EpiOutRes, pg8::StaticOrder, true, true>(L, g, S, E);
    } }
#if MK_STAMP >= 0
    GRID_BAR(); STAMP(5);
#if MK_STAMP == 22 || MK_STAMP == 23
    if (bx == 0 && tid == 0) args.out[0] += (MK_STAMP == 22) ? (float)(tk2e_ - tk2_) * 0.01f : (float)(ts_[3] - tk2e_) * 0.01f;
    if (false)
#endif
#if MK_STAMP == 20 || MK_STAMP == 21
    if (bx == 0 && tid == 0) { const unsigned long long tk = *(volatile LAS unsigned long long*)(L + 147392);
        args.out[0] += (MK_STAMP == 20) ? (float)(tk - ts_[4]) * 0.01f : (float)(ts_[5] - tk) * 0.01f; }
    if (false)
#endif
    if (bx == 0 && tid == 0) { const float T = (MK_STAMP >= 10) ? (float)((MK_STAMP == 13 ? ts_[4] : tsub_[(MK_STAMP - 9) & 3]) - tsub_[(MK_STAMP - 10) & 3]) * 0.01f : (float)(ts_[(MK_STAMP + 1) & 7] - ts_[MK_STAMP & 7]) * 0.01f; args.out[0] += (MK_STAMP == 5 ? (float)(ts_[5] - ts_[0]) * 0.01f : T); }
#endif
#undef IN
#undef BOTH
}

extern "C" void kernel_launch(void* const* d_in, const int* in_sizes, int n_in, void* d_out, int out_size, void* d_ws, size_t ws_size, hipStream_t stream) {
    static int grid = 0;
    if (grid == 0) {
        if (n_in != 12 || out_size != M * DM || ws_size < WS_END) { fprintf(stderr, "kernel_launch: unexpected shapes (n_in %d out %d ws %zu)\n", n_in, out_size, ws_size); grid = -1; return; }
        int dev = 0, cus = 0, per_cu = 0;
        if (hipGetDevice(&dev) != hipSuccess || hipDeviceGetAttribute(&cus, hipDeviceAttributeMultiprocessorCount, dev) != hipSuccess) { grid = -1; return; }
        if (hipFuncSetAttribute((const void*)hybrid_fwd, hipFuncAttributeMaxDynamicSharedMemorySize, LDS_BYTES) != hipSuccess) { fprintf(stderr, "kernel_launch: hipFuncSetAttribute failed\n"); grid = -1; return; }
        if (hipOccupancyMaxActiveBlocksPerMultiprocessor(&per_cu, (const void*)hybrid_fwd, NWAVES * 64, LDS_BYTES) != hipSuccess || per_cu < 1) { fprintf(stderr, "kernel_launch: occupancy query says %d\n", per_cu); per_cu = 1; }
        (void)hipGetLastError();
        grid = cus;
    }
    if (grid < 0) return;
#if MK_COOP
    if (hipMemsetAsync((char*)d_ws + WS_CTL, 0, CTL_ZERO_BYTES, stream) != hipSuccess) { fprintf(stderr, "kernel_launch: hipMemsetAsync failed\n"); return; }
#endif
    Args a{};
    for (int i = 0; i < 12; ++i) a.in[i] = (const float*)d_in[i];
    a.out = (float*)d_out; a.ws = (unsigned char*)d_ws;
#if MK_COOP
    a.ph_lo = 0; a.ph_hi = N_PHASES; a.coop = 1;
    void* kargs[] = {&a};
    hipError_t e = hipLaunchCooperativeKernel((const void*)hybrid_fwd, dim3(grid), dim3(NWAVES * 64), kargs, LDS_BYTES, stream);
    if (e != hipSuccess) fprintf(stderr, "kernel_launch: cooperative launch failed: %s (grid %d)\n", hipGetErrorString(e), grid);
#else
    for (int p = 0; p < N_PHASES; ++p) { a.ph_lo = p; a.ph_hi = p + 1; a.coop = 0;
        hipLaunchKernelGGL(hybrid_fwd, dim3(grid), dim3(NWAVES * 64), LDS_BYTES, stream, a); }
#endif
}
```

```cpp
#include <hip/hip_runtime.h>
#include <hip/hip_cooperative_groups.h>
#include <cstdio>
#include <cstdint>
namespace cg = cooperative_groups;
#ifndef MK_COOP
#define MK_COOP 1
#endif
#ifndef MK_EARLY
#define MK_EARLY true
#endif
#define PG8_SP2 true
#define PG8_ALIGN true
#ifndef MK_REP0
#define MK_REP0 1
#endif
#ifndef MK_REP1
#define MK_REP1 1
#endif
#ifndef MK_REP2
#define MK_REP2 1
#endif
#ifndef MK_REP3
#define MK_REP3 1
#endif
#ifndef MK_REP4
#define MK_REP4 1
#endif
#ifndef MK_REP3A
#define MK_REP3A 1
#endif
#ifndef MK_REP3P
#define MK_REP3P 1
#endif
#ifndef MK_STAMP
#define MK_STAMP -1
#endif
namespace pg8 {
#define PG8_LAS __attribute__((address_space(3)))
typedef unsigned short bf16_t;
typedef short bf16x8 __attribute__((ext_vector_type(8)));
typedef float f32x4 __attribute__((ext_vector_type(4)));
typedef unsigned u32x4 __attribute__((ext_vector_type(4)));
constexpr int BM = 256, BK = 64, HALF = 128, HTB = HALF * BK * 2  , STAGE_BYTES = 8 * HTB, NXCD = 8, WGM = 8;

__host__ __device__ __forceinline__ int lds_byte(int r, int c) { const int st = (r >> 4) * 2 + (c >> 5), rr = r & 15, cc = c & 31, ob = rr * 64 + cc * 2; return st * 1024 + (ob ^ (((ob >> 9) & 1) << 5)); }
__host__ __device__ __forceinline__ void stage_rc(int b, int& R, int& C) { const int st = b / 1024, sb = b % 1024, swz = sb ^ (((sb >> 9) & 1) << 5); R = (st >> 1) * 16 + swz / 64; C = (st & 1) * 32 + (swz % 64) / 2; }
__host__ __device__ __forceinline__ int perm32(int rho) { const int n = rho >> 4, i = rho & 15; return 8 * (i >> 2) + 4 * n + (i & 3); }

struct Unit { int pm, pn; };
struct Gemm { const bf16_t* A; const bf16_t* Bt; int M, N, K; };

struct StaticOrder {
    int nM, nN, nwg, G, c;
    __host__ __device__ void init(int M, int N, int G_, int c_) { nM = M / BM; nN = N / BM; nwg = nM * nN; G = G_; c = c_; }
    __host__ __device__ bool next(int i, Unit& u) const {
        const long L = (long)i * G + c; if (L >= nwg) return false;
        int wgid = (int)L; { const int q = nwg / NXCD, r = nwg % NXCD, xcd = wgid % NXCD, off = wgid / NXCD; wgid = (xcd < r ? xcd * (q + 1) : r * (q + 1) + (xcd - r) * q) + off; }
        const int nig = WGM * nN, gid = wgid / nig, fm = gid * WGM, gsz = (nM - fm) < WGM ? (nM - fm) : WGM;
        u.pm = fm + ((wgid % nig) % gsz); u.pn = (wgid % nig) / gsz; return true;
    }
    __device__ __forceinline__ void a_ready(const Unit&) const {}
    __device__ __forceinline__ void done(const Unit&) const {}
};
__device__ __forceinline__ unsigned cvt_pk_bf16(float lo, float hi) { unsigned r; asm volatile("v_cvt_pk_bf16_f32 %0, %1, %2" : "=v"(r) : "v"(lo), "v"(hi)); return r; }
typedef float f32x2 __attribute__((ext_vector_type(2)));
__device__ __forceinline__ float silu_f(float v) { return v * __builtin_amdgcn_rcpf(1.0f + __builtin_amdgcn_exp2f(-1.4426950408889634f * v)); }
constexpr float QSCALE = 0.125f * 1.4426950408889634f;
__device__ __forceinline__ size_t hm_off(int row, int head) { return ((size_t)((row >> 11) * 8 + head) * 2048 + (row & 2047)) * 64; }
struct EpiInProj {
    static constexpr bool PERM = true, AFTER_DRAIN = false;
    __amdgpu_buffer_rsrc_t rs; size_t stride; const float* gq; const float* gk;
    __device__ __forceinline__ void operator()(const f32x4 (&acc)[2][2][4][2], const Unit& u, int wr, int wc, int fr, int fq) const {
        const int type = u.pn >> 1;
        const size_t O = (size_t)type * stride;
        const int row0 = u.pm * BM + wr * 64 + fr;
        const int col0 = (u.pn & 1) * 256 + wc * 64 + 8 * fq;
        if (type < 2) {
            const float* g = type == 0 ? gq : gk; const float s = type == 0 ? QSCALE : 1.0f;
            f32x4 gs[2][2];
#pragma unroll
            for (int bj = 0; bj < 2; ++bj)
#pragma unroll
                for (int n = 0; n < 2; ++n) gs[bj][n] = *(const f32x4*)(g + 32 * bj + 8 * fq + 4 * n) * s;
#pragma unroll
            for (int ai = 0; ai < 2; ++ai)
#pragma unroll
                for (int m = 0; m < 4; ++m) {
                    float ss = 0.f;
#pragma unroll
                    for (int bj = 0; bj < 2; ++bj)
#pragma unroll
                        for (int n = 0; n < 2; ++n) { const f32x4 x = acc[ai][bj][m][n]; ss += (x[0] * x[0] + x[1] * x[1]) + (x[2] * x[2] + x[3] * x[3]); }
                    ss += __shfl_xor(ss, 16); ss += __shfl_xor(ss, 32);
                    const float inv = 1.0f / sqrtf(ss * (1.0f / 64.0f) + 1e-6f);
                    const size_t rowp = O + hm_off(row0 + ai * HALF + m * 16, (u.pn & 1) * 4 + wc) + 8 * fq;
#pragma unroll
                    for (int bj = 0; bj < 2; ++bj) { const f32x4 v0 = acc[ai][bj][m][0] * inv * gs[bj][0], v1 = acc[ai][bj][m][1] * inv * gs[bj][1];
                        u32x4 w; w.x = cvt_pk_bf16(v0[0], v0[1]); w.y = cvt_pk_bf16(v0[2], v0[3]); w.z = cvt_pk_bf16(v1[0], v1[1]); w.w = cvt_pk_bf16(v1[2], v1[3]);
                        __builtin_amdgcn_raw_buffer_store_b128(w, rs, (unsigned)((rowp + bj * 32) * 2), 0, 16); }
                }
        } else {
            const bool act = (type == 3) || (type == 5);
#pragma unroll
            for (int ai = 0; ai < 2; ++ai)
#pragma unroll
                for (int m = 0; m < 4; ++m) {
                    const int row = row0 + ai * HALF + m * 16;
                    const size_t rowp = (type <= 3) ? O + hm_off(row, (u.pn & 1) * 4 + wc) + 8 * fq : O + ((size_t)((u.pn & 1) * 2 + (wc >> 1)) * 16384 + row) * 128 + (wc & 1) * 64 + 8 * fq;
#pragma unroll
                    for (int bj = 0; bj < 2; ++bj) { f32x4 v0 = acc[ai][bj][m][0], v1 = acc[ai][bj][m][1];
                        if (act) { v0 = (f32x4){silu_f(v0[0]), silu_f(v0[1]), silu_f(v0[2]), silu_f(v0[3])}; v1 = (f32x4){silu_f(v1[0]), silu_f(v1[1]), silu_f(v1[2]), silu_f(v1[3])}; }
                        u32x4 w; w.x = cvt_pk_bf16(v0[0], v0[1]); w.y = cvt_pk_bf16(v0[2], v0[3]); w.z = cvt_pk_bf16(v1[0], v1[1]); w.w = cvt_pk_bf16(v1[2], v1[3]);
                        __builtin_amdgcn_raw_buffer_store_b128(w, rs, (unsigned)((rowp + bj * 32) * 2), 0, 16); }
                }
        }
    }
};
struct EpiOutRes {
    static constexpr bool PERM = false, AFTER_DRAIN = false;
    const float* x; float* out; const float* gate;
    __device__ __forceinline__ void operator()(const f32x4 (&acc)[2][2][4][2], const Unit& u, int wr, int wc, int fr, int fq) const {
        const int col0 = u.pn * BM + wc * 32 + 4 * fq;
        const float* gp = gate + (size_t)((u.pm * BM) >> 11) * 3072 + col0;
        f32x4 gv[2][2];
#pragma unroll
        for (int bj = 0; bj < 2; ++bj)
#pragma unroll
            for (int n = 0; n < 2; ++n) gv[bj][n] = *(const f32x4*)(gp + bj * HALF + n * 16);
#pragma unroll
        for (int ai = 0; ai < 2; ++ai)
#pragma unroll
            for (int m = 0; m < 4; ++m) { const size_t off = (size_t)(u.pm * BM + ai * HALF + wr * 64 + m * 16 + fr) * 1024 + col0;
#pragma unroll
                for (int bj = 0; bj < 2; ++bj)
#pragma unroll
                    for (int n = 0; n < 2; ++n) { const f32x4 xv = *(const f32x4*)(x + off + bj * HALF + n * 16);
                        *(f32x4*)(out + off + bj * HALF + n * 16) = xv + gv[bj][n] * acc[ai][bj][m][n]; } }
    }
};
template <class Epi, class Sched, bool ALIGN_EPI = false, bool SP2 = false>
__device__ __forceinline__ void gemm_phase(PG8_LAS unsigned char* lds, const Gemm g, const Sched& S, const Epi& E) {
    const int tid = threadIdx.x, wid = __builtin_amdgcn_readfirstlane(tid >> 6), lane = tid & 63, wr = wid >> 2, wc = wid & 3, fr = lane & 15, fq = lane >> 4;
    const int K = g.K, nt = K / BK;
    unsigned voffA[2], voffB[2];
#pragma unroll
    for (int i = 0; i < 2; ++i) { int R, C; stage_rc(tid * 16 + i * 8192, R, C); const int Rb = Epi::PERM ? ((R & ~31) + perm32(R & 31)) : R;
        voffA[i] = (unsigned)(R * K + C) * 2u; voffB[i] = (unsigned)(Rb * K + C) * 2u; }
    const size_t kstep = (size_t)(BK * 2);
    const size_t hstep = (size_t)HALF * K * 2;
    const size_t tstep = 2 * hstep;
    const unsigned ldsw = (unsigned)wid * 1024u;
    const int aoff = lds_byte(wr * 64 + fr, fq * 8), boff = lds_byte(wc * 32 + fr, fq * 8);
#define PG8_SA(b, h) (((b) * 2 + (h)) * HTB)
#define PG8_SB(b, h) ((4 + (b) * 2 + (h)) * HTB)
#define PG8_STAGE(bufoff, gbase, voff) do { _Pragma("unroll") for (int _i = 0; _i < 2; ++_i) \
        __builtin_amdgcn_global_load_lds((const unsigned*)((const char*)(gbase) + (voff)[_i]), (PG8_LAS unsigned*)(lds + (bufoff) + ldsw + _i * 8192), 16, 0, 0); } while (0)
#define PG8_LDA(dst, b, h) do { _Pragma("unroll") for (int m = 0; m < 4; ++m) _Pragma("unroll") for (int k = 0; k < 2; ++k) dst[m][k] = *(const PG8_LAS bf16x8*)(lds + PG8_SA(b, h) + aoff + m * 2048 + k * 1024); } while (0)
#define PG8_LDB(dst, b, h) do { _Pragma("unroll") for (int n = 0; n < 2; ++n) _Pragma("unroll") for (int k = 0; k < 2; ++k) dst[n][k] = *(const PG8_LAS bf16x8*)(lds + PG8_SB(b, h) + boff + n * 2048 + k * 1024); } while (0)
#define PG8_MMA(ai, bj, At, Bt) do { __builtin_amdgcn_s_setprio(1); _Pragma("unroll") for (int m = 0; m < 4; ++m) _Pragma("unroll") for (int n = 0; n < 2; ++n) _Pragma("unroll") for (int k = 0; k < 2; ++k) \
        acc[ai][bj][m][n] = __builtin_amdgcn_mfma_f32_16x16x32_bf16(Bt[n][k], At[m][k], acc[ai][bj][m][n], 0, 0, 0); __builtin_amdgcn_s_setprio(0); } while (0)
#define PG8_WAIT_V(n) asm volatile("s_waitcnt vmcnt(" #n ")" ::: "memory")
#define PG8_WAIT_L(n) asm volatile("s_waitcnt lgkmcnt(" #n ")" ::: "memory")
#define PG8_BAR __builtin_amdgcn_s_barrier()
#define PG8_SCHED __builtin_amdgcn_sched_barrier(0)
    Unit cur, nxt; int ui = 0;
    if (!S.next(0, cur)) return;
    f32x4 acc[2][2][4][2];
#pragma unroll
    for (int a = 0; a < 2; ++a)
#pragma unroll
        for (int b = 0; b < 2; ++b)
#pragma unroll
            for (int m = 0; m < 4; ++m)
#pragma unroll
                for (int n = 0; n < 2; ++n) acc[a][b][m][n] = (f32x4){0.f, 0.f, 0.f, 0.f};
    bf16x8 At[4][2], B0[2][2], B1[2][2];
    const char* cA = (const char*)g.A + (size_t)cur.pm * tstep; const char* cB = (const char*)g.Bt + (size_t)cur.pn * tstep;
    S.a_ready(cur);
    if constexpr (SP2) {
        PG8_STAGE(PG8_SB(0, 0), cB, voffB); PG8_STAGE(PG8_SB(0, 1), cB + hstep, voffB); PG8_STAGE(PG8_SA(0, 0), cA, voffA); PG8_STAGE(PG8_SA(0, 1), cA + hstep, voffA);
        if (wr == 1) PG8_BAR;
        PG8_WAIT_V(2); PG8_BAR;
        PG8_STAGE(PG8_SB(1, 0), cB + kstep, voffB); PG8_STAGE(PG8_SA(1, 0), cA + kstep, voffA); PG8_STAGE(PG8_SB(1, 1), cB + hstep + kstep, voffB);
        PG8_WAIT_V(6); PG8_BAR;
    } else {
        PG8_STAGE(PG8_SB(0, 0), cB, voffB); PG8_STAGE(PG8_SA(0, 0), cA, voffA); PG8_STAGE(PG8_SB(0, 1), cB + hstep, voffB); PG8_STAGE(PG8_SA(0, 1), cA + hstep, voffA);
        if (wr == 1) PG8_BAR;
        PG8_WAIT_V(4); PG8_BAR;
        PG8_STAGE(PG8_SB(1, 0), cB + kstep, voffB); PG8_STAGE(PG8_SA(1, 0), cA + kstep, voffA); PG8_STAGE(PG8_SB(1, 1), cB + hstep + kstep, voffB);
        PG8_WAIT_V(6); PG8_BAR;
    }
    for (;;) {
        const bool has_next = S.next(ui + 1, nxt);
        const char* nA = has_next ? (const char*)g.A + (size_t)nxt.pm * tstep : cA; const char* nB = has_next ? (const char*)g.Bt + (size_t)nxt.pn * tstep : cB;
        for (int t = 0; t < nt; t += 2) {
            const bool last = (t == nt - 2);
            const char* a1 = cA + (size_t)(t + 1) * kstep;
            const char* a2 = last ? nA : cA + (size_t)(t + 2) * kstep; const char* b2 = last ? nB : cB + (size_t)(t + 2) * kstep;
            const char* a3 = a2 + kstep; const char* b3 = b2 + kstep;
            if (last && has_next) S.a_ready(nxt);
            if constexpr (SP2) {
            PG8_LDB(B0, 0, 0); PG8_LDB(B1, 0, 1); PG8_SCHED; PG8_LDA(At, 0, 0); PG8_STAGE(PG8_SA(1, 1), a1 + hstep, voffA);
            PG8_WAIT_V(8); PG8_WAIT_L(0); PG8_BAR; PG8_MMA(0, 0, At, B0); PG8_MMA(0, 1, At, B1); PG8_BAR; PG8_SCHED;
            PG8_LDA(At, 0, 1); PG8_STAGE(PG8_SB(0, 0), b2, voffB); PG8_STAGE(PG8_SB(0, 1), b2 + hstep, voffB); PG8_STAGE(PG8_SA(0, 0), a2, voffA);
            PG8_WAIT_V(8); PG8_WAIT_L(0); PG8_BAR; PG8_MMA(1, 0, At, B0); PG8_MMA(1, 1, At, B1); PG8_BAR; PG8_SCHED;
            PG8_LDB(B0, 1, 0); PG8_LDB(B1, 1, 1); PG8_SCHED; PG8_LDA(At, 1, 0); PG8_STAGE(PG8_SA(0, 1), a2 + hstep, voffA);
            PG8_WAIT_V(8); PG8_WAIT_L(0); PG8_BAR; PG8_MMA(0, 0, At, B0); PG8_MMA(0, 1, At, B1); PG8_BAR; PG8_SCHED;
            PG8_LDA(At, 1, 1); PG8_STAGE(PG8_SB(1, 0), b3, voffB); PG8_STAGE(PG8_SB(1, 1), b3 + hstep, voffB); PG8_STAGE(PG8_SA(1, 0), a3, voffA);
            PG8_WAIT_V(8); PG8_WAIT_L(0); PG8_BAR; PG8_MMA(1, 0, At, B0); PG8_MMA(1, 1, At, B1); PG8_BAR; PG8_SCHED;
            } else {
            PG8_LDB(B0, 0, 0); PG8_SCHED; PG8_LDA(At, 0, 0); PG8_STAGE(PG8_SA(1, 1), a1 + hstep, voffA);
            PG8_WAIT_L(8); PG8_BAR; PG8_WAIT_L(0); PG8_MMA(0, 0, At, B0); PG8_BAR; PG8_SCHED;
            PG8_LDB(B1, 0, 1); PG8_STAGE(PG8_SB(0, 0), b2, voffB);
            PG8_BAR; PG8_WAIT_L(0); PG8_MMA(0, 1, At, B1); PG8_BAR;
            PG8_LDA(At, 0, 1); PG8_STAGE(PG8_SA(0, 0), a2, voffA);
            PG8_BAR; PG8_WAIT_L(0); PG8_MMA(1, 0, At, B0); PG8_BAR; PG8_SCHED;
            PG8_STAGE(PG8_SB(0, 1), b2 + hstep, voffB);
            PG8_WAIT_V(6); PG8_BAR; PG8_MMA(1, 1, At, B1); PG8_BAR;
            PG8_LDB(B0, 1, 0); PG8_SCHED; PG8_LDA(At, 1, 0); PG8_STAGE(PG8_SA(0, 1), a2 + hstep, voffA);
            PG8_WAIT_L(8); PG8_BAR; PG8_WAIT_L(0); PG8_MMA(0, 0, At, B0); PG8_BAR; PG8_SCHED;
            PG8_LDB(B1, 1, 1); PG8_STAGE(PG8_SB(1, 0), b3, voffB);
            PG8_BAR; PG8_WAIT_L(0); PG8_MMA(0, 1, At, B1); PG8_BAR;
            PG8_LDA(At, 1, 1); PG8_STAGE(PG8_SA(1, 0), a3, voffA);
            PG8_BAR; PG8_WAIT_L(0); PG8_MMA(1, 0, At, B0); PG8_BAR; PG8_SCHED;
            PG8_STAGE(PG8_SB(1, 1), b3 + hstep, voffB);
            PG8_WAIT_V(6); PG8_BAR; PG8_MMA(1, 1, At, B1); PG8_BAR;
            }
        }
        if constexpr (ALIGN_EPI) { if (wr == 0) PG8_BAR; }
#if MK_STAMP == 20 || MK_STAMP == 21 || MK_STAMP == 22 || MK_STAMP == 23
        if (threadIdx.x == 0) *(volatile PG8_LAS unsigned long long*)(lds + 147392) = __builtin_amdgcn_s_memrealtime();
#endif
        if constexpr (!Epi::AFTER_DRAIN) { E(acc, cur, wr, wc, fr, fq); S.done(cur); }
        if (!has_next) break;
#pragma unroll
        for (int a = 0; a < 2; ++a)
#pragma unroll
            for (int b = 0; b < 2; ++b)
#pragma unroll
                for (int m = 0; m < 4; ++m)
#pragma unroll
                    for (int n = 0; n < 2; ++n) acc[a][b][m][n] = (f32x4){0.f, 0.f, 0.f, 0.f};
        cur = nxt; cA = nA; cB = nB; ++ui;
        if constexpr (ALIGN_EPI) { if (wr == 1) PG8_BAR; }
    }
    PG8_WAIT_V(0);
    if constexpr (!ALIGN_EPI) { if (wr == 0) PG8_BAR; }
    PG8_BAR;
    if constexpr (Epi::AFTER_DRAIN) { E.fused(acc, cur, wr, wc, fr, fq, lds, wid, lane); S.done(cur); }
#undef PG8_SA
#undef PG8_SB
#undef PG8_STAGE
#undef PG8_LDA
#undef PG8_LDB
#undef PG8_MMA
#undef PG8_WAIT_V
#undef PG8_WAIT_L
#undef PG8_BAR
#undef PG8_SCHED
}
}

constexpr int NWAVES = 8;
constexpr int BATCH = 8, SEQ = 2048, DM = 1024, M = BATCH * SEQ, DIN = 3072, DH = 64, NH = 8, DA = 512;
constexpr size_t MiB = 1u << 20;
constexpr size_t WS_CTL = 0, CTL_ZERO_BYTES = 64 * 1024;
constexpr size_t WS_MOD = 1 * MiB;
constexpr size_t WS_WIN = 2 * MiB;
constexpr size_t WS_WOUT = 8 * MiB;
constexpr size_t WS_WPOOL = 10 * MiB;
constexpr size_t WS_XN = 16 * MiB;
constexpr size_t WS_PROJ = 48 * MiB;
constexpr size_t PROJ_STRIDE = (size_t)M * 512;
constexpr size_t WS_CAT = 144 * MiB;
constexpr size_t WS_END = 176 * MiB;
constexpr int RING_BYTES = 131072, LDS_BYTES = 147456, MISC_OFF = LDS_BYTES - 128;
constexpr int CW_BAR = 1024;

#define GAS __attribute__((address_space(1)))
#define LAS __attribute__((address_space(3)))
typedef unsigned short bf16;
typedef unsigned v4u __attribute__((ext_vector_type(4)));
typedef unsigned v2u __attribute__((ext_vector_type(2)));
typedef float f32x4 __attribute__((ext_vector_type(4)));
typedef float f32x16 __attribute__((ext_vector_type(16)));
typedef short bf16x8 __attribute__((ext_vector_type(8)));
typedef short s16x4 __attribute__((ext_vector_type(4)));
#define LDS_WAIT() asm volatile("s_waitcnt lgkmcnt(0)" ::: "memory")
#define VM_WAIT() asm volatile("s_waitcnt vmcnt(0)" ::: "memory")
__device__ __forceinline__ unsigned pk2(float lo, float hi) { return pg8::cvt_pk_bf16(lo, hi); }
__device__ __forceinline__ float bf_lo(unsigned u) { return __builtin_bit_cast(float, u << 16); }
__device__ __forceinline__ float bf_hi(unsigned u) { return __builtin_bit_cast(float, u & 0xffff0000u); }
#define XB_TMO      128
#define XB_XCNT(j)  (256  + 64 * (j))
#define XB_XSUB(j)  (1280 + 64 * (j))
#define XB_XGEN(j)  (2304 + 64 * (j))
#define XB_TOP      3328
#define XB_TOPGEN   3392
#define XCD_BAR_WORDS 3456
#define XB_SPIN_CAP (1u << 18)

__device__ __forceinline__ unsigned xb_ld(unsigned* p)              { return __hip_atomic_load(p, __ATOMIC_RELAXED, __HIP_MEMORY_SCOPE_AGENT); }
__device__ __forceinline__ unsigned xb_add(unsigned* p, unsigned v) { return __hip_atomic_fetch_add(p, v, __ATOMIC_RELAXED, __HIP_MEMORY_SCOPE_AGENT); }
__device__ __forceinline__ unsigned xb_xcc_id() { return (unsigned)__builtin_amdgcn_s_getreg((3 << 11) | 20) & 0xFu; }
#define XB_SPIN(cond, bar) do { unsigned _sp = 0; while (cond) { __builtin_amdgcn_s_sleep(1); \
    if ((++_sp & 255u) == 0u) { if (xb_ld(&(bar)[XB_TMO])) break; if (_sp > XB_SPIN_CAP) { atomicAdd(&(bar)[XB_TMO], 1u); break; } } } } while (0)

struct XcdBarrier {
    unsigned* bar; unsigned x;
    volatile LAS unsigned* st;
};

__device__ __forceinline__ XcdBarrier xcd_barrier_post(unsigned* bar, volatile LAS unsigned* st) {
    XcdBarrier b; b.bar = bar; b.x = xb_xcc_id(); b.st = st;
    if (threadIdx.x == 0) (void)xb_add(&bar[XB_XCNT(b.x)], 1u);
    return b;
}
__device__ __forceinline__ void xcd_barrier_complete(unsigned* bar, unsigned x, unsigned& nloc, unsigned& nx) {
    const unsigned G = gridDim.x * gridDim.y * gridDim.z;
    unsigned sum, cnt, mine, sp = 0u;
    for (;;) {
        sum = 0u; cnt = 0u; mine = 0u;
#pragma unroll
        for (unsigned j = 0; j < 16; ++j) { const unsigned c = xb_ld(&bar[XB_XCNT(j)]); sum += c; cnt += (c > 0u) ? 1u : 0u; mine = (j == x) ? c : mine; }
        if (sum == G) break;
        __builtin_amdgcn_s_sleep(1);
        if ((++sp & 255u) == 0u) { if (xb_ld(&bar[XB_TMO])) break; if (sp > XB_SPIN_CAP) { atomicAdd(&bar[XB_TMO], 1u); break; } }
    }
    nloc = mine > 0u ? mine : 1u; nx = cnt > 0u ? cnt : 1u;
}

__device__ __forceinline__ void xcd_barrier(const XcdBarrier& b) {
    asm volatile("s_waitcnt vmcnt(0)" ::: "memory");
    __syncthreads();
    if (threadIdx.x == 0) {
        unsigned* bar = b.bar;
        __builtin_amdgcn_s_waitcnt(0);
        unsigned nloc = b.st[0], nx = b.st[1];
        if (nloc == 0u) { xcd_barrier_complete(bar, b.x, nloc, nx); b.st[0] = nloc; b.st[1] = nx; }
        const unsigned old = xb_add(&bar[XB_XSUB(b.x)], 1u);
        const unsigned gen = old / nloc;
        if (old + 1u == (gen + 1u) * nloc) {
            __builtin_amdgcn_fence(__ATOMIC_RELEASE, "agent");
            asm volatile("s_waitcnt vmcnt(0)" ::: "memory");
            const unsigned og = xb_add(&bar[XB_TOP], 1u);
            const unsigned tg = og / nx;
            if (og + 1u == (tg + 1u) * nx) xb_add(&bar[XB_TOPGEN], 1u);
            else XB_SPIN(xb_ld(&bar[XB_TOPGEN]) == tg, bar);
            __builtin_amdgcn_fence(__ATOMIC_ACQUIRE, "agent");
            xb_add(&bar[XB_XGEN(b.x)], 1u);
            asm volatile("s_waitcnt vmcnt(0)" ::: "memory");
        } else {
            XB_SPIN(xb_ld(&bar[XB_XGEN(b.x)]) == gen, bar);
            __builtin_amdgcn_fence(__ATOMIC_ACQUIRE, "agent");
            asm volatile("s_waitcnt vmcnt(0)" ::: "memory");
        }
    }
    __syncthreads();
}

#ifndef MK_SEAMB
#define MK_SEAMB 1
#endif
__device__ __forceinline__ void cat_store16(bf16* CAT, size_t elem, v4u w) {
#if MK_SEAMB
    const __amdgpu_buffer_rsrc_t rs = __builtin_amdgcn_make_buffer_rsrc(CAT, 0, (int)((size_t)M * DM * 2), 0x00020000);
    __builtin_amdgcn_raw_buffer_store_b128(w, rs, (unsigned)(elem * 2), 0, 16);
#else
    *(v4u*)(CAT + elem) = w;
#endif
}
namespace att {
__device__ __forceinline__ void glds16(const void* gsrc, unsigned lds_dst) { unsigned keep;
    asm volatile("s_mov_b32 %0, m0\n\ts_mov_b32 m0, %2\n\ts_nop 0\n\tglobal_load_lds_dwordx4 %1, off\n\ts_mov_b32 m0, %0" : "=&s"(keep) : "v"(gsrc), "s"(lds_dst) : "memory"); }
typedef short v4i16_t __attribute__((ext_vector_type(4)));
__device__ __forceinline__ s16x4 vtr(LAS const char* p) { return __builtin_bit_cast(s16x4, __builtin_amdgcn_ds_read_tr16_b64_v4i16((LAS v4i16_t*)p)); }
constexpr int TILEB = 8192, VOFF = 4096, STAGE_OFF = 12 * TILEB, STAGE_B = 4608;
#ifndef ATT_HIST
#define ATT_HIST 0
#endif

template <bool DIAG>
__device__ __forceinline__ void tile_weights(f32x16& p0, float& carry, unsigned (&pw)[2][4], int kv0, int qabs, int hi) {
    float G[4];
#pragma unroll
    for (int i = 0; i < 4; ++i) {
        float rr[4], be[4];
#pragma unroll
        for (int j = 0; j < 4; ++j) {
            const float e = __builtin_amdgcn_exp2f(p0[4 * i + j]);
            float rv = __builtin_amdgcn_rcpf(1.0f + e); float bv = e * rv;
            if (DIAG) { const int kv = kv0 + 8 * i + 4 * hi + j; if (kv >= qabs) { rv = 1.0f; bv = 0.0f; } }
            rr[j] = rv; be[j] = bv;
        }
        const float s2 = rr[3], s1 = s2 * rr[2], s0 = s1 * rr[1];
        G[i] = s0 * rr[0];
        p0[4 * i + 3] = be[3]; p0[4 * i + 2] = be[2] * s2; p0[4 * i + 1] = be[1] * s1; p0[4 * i] = be[0] * s0;
    }
    float F[4]; float run = carry;
#pragma unroll
    for (int p = 3; p >= 0; --p) {
        auto sw = __builtin_amdgcn_permlane32_swap(__float_as_uint(G[p]), __float_as_uint(G[p]), false, false);
        const float g0 = __uint_as_float(sw[0]), g1 = __uint_as_float(sw[1]);
        F[p] = run * (hi ? 1.0f : g1);
        run = run * (g0 * g1);
    }
    carry = run;
#pragma unroll
    for (int i = 0; i < 4; ++i) { const float f = F[i];
        pw[i >> 1][2 * (i & 1)] = pk2(p0[4 * i] * f, p0[4 * i + 1] * f); pw[i >> 1][2 * (i & 1) + 1] = pk2(p0[4 * i + 2] * f, p0[4 * i + 3] * f); }
}

template <bool EARLY>
__device__ __forceinline__ void attn_pass(int b, int h, int qb0, const bf16* Q, const bf16* K, const bf16* V, const bf16* GA, bf16* CAT, LAS char* shm) {
    const int tid = threadIdx.x, lane = tid & 63, r32 = lane & 31, hi = lane >> 5; const int wid = __builtin_amdgcn_readfirstlane(tid >> 6);
    const size_t hb = ((size_t)(b * NH + h) * SEQ) * DH;
    const bf16* Qh = Q + hb; const bf16* Kh = K + hb; const bf16* Vh = V + hb;
    const unsigned lds0 = (unsigned)__builtin_amdgcn_readfirstlane((int)(unsigned)(uintptr_t)shm);
    const int wb = qb0 - ATT_HIST > 0 ? qb0 - ATT_HIST : 0, nw = qb0 + 8 - wb;
    const bf16* ksrc = Kh + (size_t)(lane >> 3) * DH + (((lane & 7) ^ ((lane >> 3) & 7)) * 8);
    const bf16* vsrc = Vh + (size_t)(lane >> 2) * DH + (lane & 3) * 8;
    for (int p = wid; p < nw * 8; p += NWAVES) {
        const int w = p >> 3, pc = p & 7; const size_t trow = (size_t)(wb + w) * 32;
        const unsigned dst = lds0 + w * TILEB + pc * 1024;
        if (pc < 4) glds16(ksrc + (trow + 8 * pc) * DH, dst);
        else glds16(vsrc + (trow + 16 * ((pc - 4) & 1)) * DH + 32 * ((pc - 4) >> 1), dst);
    }
    const int qblk = qb0 + wid, q0 = qblk * 32, qabs = q0 + r32;
    bf16x8 qr[4];
#pragma unroll
    for (int d0 = 0; d0 < 4; ++d0) qr[d0] = *reinterpret_cast<const bf16x8*>(&Qh[(size_t)qabs * DH + d0 * 16 + hi * 8]);
    const size_t tok0 = (size_t)b * SEQ + q0;
    v4u gpre[2][2];
#pragma unroll
    for (int dh = 0; dh < 2; ++dh)
#pragma unroll
        for (int k = 0; k < 2; ++k) gpre[dh][k] = *(const v4u*)(GA + hb + (size_t)(q0 + 16 * k + (lane >> 2)) * DH + 32 * dh + (lane & 3) * 8);
    asm volatile("s_waitcnt vmcnt(0)" ::: "memory");
    __syncthreads();
    f32x16 o[2]; o[0] = f32x16{}; o[1] = f32x16{};
    float carry = 1.0f; bool dead = false;
    LAS const char* kp0 = shm + r32 * 128;
    LAS const char* vp0 = shm + VOFF + ((lane >> 4) & 1) * 32 + (lane & 3) * 8 + (4 * hi + ((lane & 15) >> 2)) * 64;
#define ATT_TILE(DG) do { \
        const int w = t - wb; LAS const char* kp = kp0 + w * TILEB; f32x16 p0 = f32x16{}; \
        _Pragma("unroll") for (int d0 = 0; d0 < 4; ++d0) { const bf16x8 kf = *(LAS const bf16x8*)(kp + (((2 * d0 + hi) ^ (r32 & 7)) * 16)); p0 = __builtin_amdgcn_mfma_f32_32x32x16_bf16(kf, qr[d0], p0, 0, 0, 0); } \
        unsigned pw[2][4]; tile_weights<DG>(p0, carry, pw, t * 32, qabs, hi); \
        LAS const char* vp = vp0 + w * TILEB; \
        _Pragma("unroll") for (int dh = 0; dh < 2; ++dh) _Pragma("unroll") for (int ks = 0; ks < 2; ++ks) { \
            const s16x4 lo = vtr(vp + dh * 2048 + ks * 1024), hh = vtr(vp + dh * 2048 + ks * 1024 + 512); \
            const bf16x8 vf = (bf16x8){lo[0], lo[1], lo[2], lo[3], hh[0], hh[1], hh[2], hh[3]}; \
            const v4u pwv = (v4u){pw[ks][0], pw[ks][1], pw[ks][2], pw[ks][3]}; \
            o[dh] = __builtin_amdgcn_mfma_f32_32x32x16_bf16(vf, __builtin_bit_cast(bf16x8, pwv), o[dh], 0, 0, 0); } } while (0)
    int t = qblk;
    ATT_TILE(true);
    if (EARLY && __all(carry < 1e-30f)) dead = true;
    if (!dead) for (t = qblk - 1; t >= wb; --t) {
        ATT_TILE(false);
        if (EARLY) { if (__all(carry < 1e-30f)) { dead = true; break; } }
    }
#undef ATT_TILE
    if (!dead) {
        for (t = wb - 1; t >= 0; --t) {
            f32x16 p0 = f32x16{};
#pragma unroll
            for (int d0 = 0; d0 < 4; ++d0) {
                const bf16x8 kf = *reinterpret_cast<const bf16x8*>(&Kh[((size_t)t * 32 + r32) * DH + (2 * d0 + hi) * 8]);
                p0 = __builtin_amdgcn_mfma_f32_32x32x16_bf16(kf, qr[d0], p0, 0, 0, 0);
            }
            unsigned pw[2][4];
            tile_weights<false>(p0, carry, pw, t * 32, qabs, hi);
#pragma unroll
            for (int dh = 0; dh < 2; ++dh)
#pragma unroll
                for (int ks = 0; ks < 2; ++ks) {
                    bf16x8 vf;
#pragma unroll
                    for (int j = 0; j < 8; ++j) vf[j] = (short)Vh[((size_t)t * 32 + 16 * ks + 8 * (j >> 2) + 4 * hi + (j & 3)) * DH + 32 * dh + r32];
                    const v4u pwv = (v4u){pw[ks][0], pw[ks][1], pw[ks][2], pw[ks][3]};
                    o[dh] = __builtin_amdgcn_mfma_f32_32x32x16_bf16(vf, __builtin_bit_cast(bf16x8, pwv), o[dh], 0, 0, 0);
                }
            if (EARLY) { if (__all(carry < 1e-30f)) break; }
        }
    }
    {
        LAS char* st = shm + STAGE_OFF + wid * STAGE_B;
        const int rr = lane >> 2, ch = lane & 3;
#pragma unroll
        for (int dh = 0; dh < 2; ++dh) {
#pragma unroll
            for (int i = 0; i < 4; ++i) *(LAS f32x4*)(st + r32 * 144 + (8 * i + 4 * hi) * 4) = (f32x4){o[dh][4 * i], o[dh][4 * i + 1], o[dh][4 * i + 2], o[dh][4 * i + 3]};
            asm volatile("s_waitcnt lgkmcnt(0)" ::: "memory");
#pragma unroll
            for (int k = 0; k < 2; ++k) { const int row = 16 * k + rr;
                const f32x4 a0 = *(LAS const f32x4*)(st + row * 144 + ch * 32), a1 = *(LAS const f32x4*)(st + row * 144 + ch * 32 + 16);
                const v4u g = gpre[dh][k];
                v4u w; w.x = pk2(a0[0] * bf_lo(g.x), a0[1] * bf_hi(g.x)); w.y = pk2(a0[2] * bf_lo(g.y), a0[3] * bf_hi(g.y));
                w.z = pk2(a1[0] * bf_lo(g.z), a1[1] * bf_hi(g.z)); w.w = pk2(a1[2] * bf_lo(g.w), a1[3] * bf_hi(g.w));
                cat_store16(CAT, (tok0 + row) * DM + h * DH + 32 * dh + ch * 8, w); }
            asm volatile("s_waitcnt lgkmcnt(0)" ::: "memory");
        }
    }
    asm volatile("s_waitcnt vmcnt(0)" ::: "memory");
    __syncthreads();
}
}

namespace pool {
constexpr int UP = 272;
constexpr int UROWS = 272;
constexpr int WOFF = UROWS * UP;
typedef short v4i16_t __attribute__((ext_vector_type(4)));
__device__ __forceinline__ s16x4 vtr(LAS const char* p) { return __builtin_bit_cast(s16x4, __builtin_amdgcn_ds_read_tr16_b64_v4i16((LAS v4i16_t*)p)); }
template <int WIN>
__device__ __forceinline__ void pool_unit_w(int pm, int g, const bf16* U, const bf16* GP, const bf16* WpT, const float* bp, const float* ps, bf16* CAT, LAS char* shm) {
    const int tid = threadIdx.x, lane = tid & 63, r32 = lane & 31, hi = lane >> 5; const int wid = __builtin_amdgcn_readfirstlane(tid >> 6);
    asm volatile("" : "+s"(pm), "+s"(g));
    const int t0 = pm * 256, tpos0 = t0 & (SEQ - 1);
    v4u tu[9], tw[4];
#pragma unroll
    for (int k = 0; k < 9; ++k) { const int c = tid + k * 512, row = c >> 4, ch = c & 15; tu[k] = (v4u){0u, 0u, 0u, 0u};
        if (c < UROWS * 16 && tpos0 - 16 + row >= 0) tu[k] = *(const v4u*)(U + ((size_t)g * M + (t0 - 16 + row)) * 128 + ch * 8); }
#pragma unroll
    for (int k = 0; k < 4; ++k) { const int c = tid + k * 512; tw[k] = *(const v4u*)(WpT + (size_t)g * 16384 + (size_t)c * 8); }
#pragma unroll
    for (int k = 0; k < 9; ++k) { const int c = tid + k * 512, row = c >> 4, ch = c & 15; if (c < UROWS * 16) *(LAS v4u*)(shm + row * UP + ch * 16) = tu[k]; }
#pragma unroll
    for (int k = 0; k < 4; ++k) { const int c = tid + k * 512, row = c >> 4, ch = c & 15; *(LAS v4u*)(shm + WOFF + row * UP + ch * 16) = tw[k]; }
    v4u gpre[2][4];
#pragma unroll
    for (int half = 0; half < 2; ++half)
#pragma unroll
        for (int k = 0; k < 4; ++k) gpre[half][k] = *(const v4u*)(GP + ((size_t)g * M + t0 + wid * 32 + 8 * k + (lane >> 3)) * 128 + 64 * half + (lane & 7) * 8);
    __syncthreads();
    const int r = wid * 32 + r32, tpos = tpos0 + r;
    const float inv = 1.0f / (float)(tpos + 1 < WIN ? tpos + 1 : WIN);
    bf16x8 band[3];
#pragma unroll
    for (int ks = 0; ks < 3; ++ks)
#pragma unroll
        for (int j = 0; j < 8; ++j) { const int dlt = (r32 + 16) - (16 * ks + 8 * (j >> 2) + 4 * hi + (j & 3));
            band[ks][j] = (dlt >= 0 && dlt < WIN) ? (short)0x3F80 : (short)0; }
    LAS const char* ub = shm + (32 * wid + 4 * hi + ((lane & 15) >> 2)) * UP + (16 * ((lane >> 4) & 1) + 4 * (lane & 3)) * 2;
    LAS const char* urow = shm + (32 * wid + r32 + 16) * UP + 8 * hi;
    LAS const char* wl = shm + WOFF + r32 * UP + 8 * hi;
    f32x16 acc[4]; acc[0] = f32x16{}; acc[1] = f32x16{}; acc[2] = f32x16{}; acc[3] = f32x16{};
#pragma unroll 1
    for (int ct = 0; ct < 4; ++ct) {
        f32x16 X = f32x16{};
#pragma unroll
        for (int ks = 0; ks < 3; ++ks) {
            const s16x4 lo = vtr(ub + (16 * ks) * UP + ct * 64), hh = vtr(ub + (16 * ks + 8) * UP + ct * 64);
            const bf16x8 uf = (bf16x8){lo[0], lo[1], lo[2], lo[3], hh[0], hh[1], hh[2], hh[3]};
            X = __builtin_amdgcn_mfma_f32_32x32x16_bf16(uf, band[ks], X, 0, 0, 0);
        }
        unsigned pw[2][4];
#pragma unroll
        for (int i = 0; i < 4; ++i) { const v2u ut = *(LAS const v2u*)(urow + (32 * ct + 8 * i) * 2);
            pw[i >> 1][2 * (i & 1)] = pk2(X[4 * i] * inv - bf_lo(ut.x), X[4 * i + 1] * inv - bf_hi(ut.x));
            pw[i >> 1][2 * (i & 1) + 1] = pk2(X[4 * i + 2] * inv - bf_lo(ut.y), X[4 * i + 3] * inv - bf_hi(ut.y)); }
#pragma unroll
        for (int s2 = 0; s2 < 2; ++s2) { const int S = 2 * ct + s2;
            const v4u pv = (v4u){pw[s2][0], pw[s2][1], pw[s2][2], pw[s2][3]};
            const bf16x8 pfr = __builtin_bit_cast(bf16x8, pv);
#pragma unroll
            for (int n = 0; n < 4; ++n) { const v2u w0 = *(LAS const v2u*)(wl + n * 32 * UP + 32 * S), w1 = *(LAS const v2u*)(wl + n * 32 * UP + 32 * S + 16);
                const v4u wv = (v4u){w0.x, w0.y, w1.x, w1.y};
                acc[n] = __builtin_amdgcn_mfma_f32_32x32x16_bf16(__builtin_bit_cast(bf16x8, wv), pfr, acc[n], 0, 0, 0); }
        }
    }
    __syncthreads();
    {
        LAS char* st = shm + wid * 16384;
        const size_t tokw = (size_t)t0 + wid * 32;
        const int rr = lane >> 3, ch = lane & 7;
#pragma unroll
        for (int half = 0; half < 2; ++half) {
#pragma unroll
            for (int nn = 0; nn < 2; ++nn)
#pragma unroll
                for (int i = 0; i < 4; ++i) { const int n = 2 * half + nn;
                    *(LAS f32x4*)(st + r32 * 272 + (32 * nn + 8 * i + 4 * hi) * 4) = (f32x4){acc[n][4 * i], acc[n][4 * i + 1], acc[n][4 * i + 2], acc[n][4 * i + 3]}; }
            asm volatile("s_waitcnt lgkmcnt(0)" ::: "memory");
            const int col = g * 128 + 64 * half + ch * 8;
            const f32x4 b0 = *(const f32x4*)(bp + col), b1 = *(const f32x4*)(bp + col + 4), s0 = *(const f32x4*)(ps + col), s1 = *(const f32x4*)(ps + col + 4);
#pragma unroll
            for (int k = 0; k < 4; ++k) { const int row = 8 * k + rr;
                const f32x4 a0 = (*(LAS const f32x4*)(st + row * 272 + ch * 32) + b0) * s0, a1 = (*(LAS const f32x4*)(st + row * 272 + ch * 32 + 16) + b1) * s1;
                const v4u gv = gpre[half][k];
                v4u w; w.x = pk2(a0[0] * bf_lo(gv.x), a0[1] * bf_hi(gv.x)); w.y = pk2(a0[2] * bf_lo(gv.y), a0[3] * bf_hi(gv.y));
                w.z = pk2(a1[0] * bf_lo(gv.z), a1[1] * bf_hi(gv.z)); w.w = pk2(a1[2] * bf_lo(gv.w), a1[3] * bf_hi(gv.w));
                cat_store16(CAT, (tokw + row) * DM + 512 + col, w); }
            asm volatile("s_waitcnt lgkmcnt(0)" ::: "memory");
        }
    }
    asm volatile("s_waitcnt vmcnt(0)" ::: "memory");
    __syncthreads();
}
__device__ __forceinline__ void pool_unit(int pm, int g, const bf16* U, const bf16* GP, const bf16* WpT, const float* bp, const float* ps, bf16* CAT, LAS char* shm) {
    if (g == 0) pool_unit_w<2>(pm, g, U, GP, WpT, bp, ps, CAT, shm);
    else if (g == 1) pool_unit_w<4>(pm, g, U, GP, WpT, bp, ps, CAT, shm);
    else if (g == 2) pool_unit_w<8>(pm, g, U, GP, WpT, bp, ps, CAT, shm);
    else pool_unit_w<16>(pm, g, U, GP, WpT, bp, ps, CAT, shm);
}
}

__device__ __forceinline__ float wave_sum(float v) {
#pragma unroll
    for (int o = 1; o < 64; o <<= 1) v += __shfl_xor(v, o);
    return v;
}
struct TrItem { const float* W; bf16* WT; int K, N, item; bool permn; };
__device__ __forceinline__ void tr_load(const TrItem& t, float (&v)[32], int lane) {
    const int nblk = t.N / 32, kb = t.item / nblk, nb = t.item % nblk, k0 = 64 * kb, n0 = 32 * nb;
#pragma unroll
    for (int i = 0; i < 32; ++i) { const int kk = 2 * i + (lane >> 5); v[i] = t.W[(size_t)(k0 + kk) * t.N + n0 + (lane & 31)]; }
}
__device__ __forceinline__ void tr_finish(const TrItem& t, const float (&v)[32], LAS float* scr, int lane) {
    const int nblk = t.N / 32, kb = t.item / nblk, nb = t.item % nblk, k0 = 64 * kb, n0 = 32 * nb;
#pragma unroll
    for (int i = 0; i < 32; ++i) { const int kk = 2 * i + (lane >> 5); scr[kk * 33 + (lane & 31)] = v[i]; }
    LDS_WAIT(); asm volatile("" ::: "memory");
    const int c = lane & 7;
#pragma unroll
    for (int j = 0; j < 4; ++j) { const int n = (lane >> 3) + 8 * j; const LAS float* s = scr + (8 * c) * 33 + n;
        v4u o; o.x = pk2(s[0 * 33], s[1 * 33]); o.y = pk2(s[2 * 33], s[3 * 33]); o.z = pk2(s[4 * 33], s[5 * 33]); o.w = pk2(s[6 * 33], s[7 * 33]);
        int na = n0 + n;
        if (t.permn) na = (na & ~255) + 128 * ((na >> 5) & 1) + 32 * ((na >> 6) & 3) + (na & 31);
        *(GAS v4u*)(t.WT + (size_t)na * t.K + k0 + 8 * c) = o; }
    LDS_WAIT(); asm volatile("" ::: "memory");
}

struct Args { const float* in[12]; float* out; unsigned char* ws; int ph_lo, ph_hi; int coop, pad; };
constexpr int N_PHASES = 5;

__global__ void __launch_bounds__(NWAVES * 64, 2) hybrid_fwd(Args args) {
    extern __shared__ __attribute__((aligned(16))) unsigned char lds[];
    LAS unsigned char* L = (LAS unsigned char*)lds;
    const int tid = threadIdx.x, lane = tid & 63, wave = __builtin_amdgcn_readfirstlane(tid >> 6);
    const int G = gridDim.x, bx = blockIdx.x;
    const int vcu = (G % 8 == 0) ? (bx % 8) * (G / 8) + bx / 8 : bx;
    const float* x = args.in[0]; const float* c = args.in[1]; const float* w_ada = args.in[2]; const float* b_ada = args.in[3]; const float* norm_g = args.in[4];
    const float* w_in = args.in[5]; const float* qg = args.in[6]; const float* kg = args.in[7]; const float* w_pool = args.in[8]; const float* b_pool = args.in[9];
    const float* pool_scale = args.in[10]; const float* w_out = args.in[11];
    unsigned char* ws = args.ws;
    float* mod = (float*)(ws + WS_MOD);
    bf16* Win_t = (bf16*)(ws + WS_WIN); bf16* Wout_t = (bf16*)(ws + WS_WOUT); bf16* WpT = (bf16*)(ws + WS_WPOOL);
    bf16* XN = (bf16*)(ws + WS_XN); bf16* PROJ = (bf16*)(ws + WS_PROJ); bf16* CAT = (bf16*)(ws + WS_CAT);
    const int lo = args.ph_lo, hi = args.ph_hi;
#define IN(k) (lo <= (k) && (k) < hi)
#define BOTH(k) (IN(k) && IN((k) + 1))
#if MK_COOP
    if (tid < 32) ((LAS unsigned*)(L + MISC_OFF))[tid] = 0u;
    __syncthreads();
    XcdBarrier bar = xcd_barrier_post((unsigned*)(ws + WS_CTL) + CW_BAR, (volatile LAS unsigned*)(L + MISC_OFF) + 8);
#define GRID_BAR() do { if (args.coop == 2) cg::this_grid().sync(); else xcd_barrier(bar); } while (0)
#else
#define GRID_BAR() do { } while (0)
#endif
    const int gw = vcu * NWAVES + wave, NGW = G * NWAVES;
    unsigned* ctl = (unsigned*)(ws + WS_CTL); constexpr int CW_SEAM_B = 12288;
    const bool pseamB = MK_SEAMB && MK_COOP && G == 256 && lo == 0 && hi == N_PHASES && MK_STAMP < 0 && MK_REP3 == 1;
    constexpr int CW_SEAM_A = 8192;
    const bool pseamA = pseamB && MK_REP1 == 1;
    pg8::Unit u2; u2.pm = 0; u2.pn = 0; if (pseamA) { pg8::StaticOrder S2; S2.init(M, DIN, G, bx); S2.next(0, u2); }
    f32x4 xrow_[8][4];
    const int mb0_ = 256 * u2.pm + 64 * u2.pn + 8 * wave;
#define PANEL_ARRIVE(p_) do { if (pseamB && tid == 0) __hip_atomic_fetch_add(ctl + CW_SEAM_B + 64 * (p_), 1u, __ATOMIC_RELAXED, __HIP_MEMORY_SCOPE_AGENT); } while (0)
#if MK_STAMP >= 0
    unsigned long long ts_[8]; ts_[0] = __builtin_amdgcn_s_memrealtime();
#define STAMP(k) do { ts_[k] = __builtin_amdgcn_s_memrealtime(); } while (0)
    unsigned long long tsub_[4] = {0, 0, 0, 0}; unsigned long long tk2_ = 0, tk2e_ = 0;
#define SUBSTAMP(k) do { tsub_[k] = __builtin_amdgcn_s_memrealtime(); } while (0)
#else
#define STAMP(k) do { } while (0)
#define SUBSTAMP(k) do { } while (0)
#endif

    const bool fuse01 = false;
    f32x4 xr_[8][4]; float xs_[8];
    if (fuse01) {
#pragma unroll
        for (int q = 0; q < 8; ++q) { const GAS f32x4* xp = (const GAS f32x4*)(x + (size_t)(gw + q * NGW) * DM) + lane;
#pragma unroll
            for (int j = 0; j < 4; ++j) xr_[q][j] = xp[64 * j]; }
    }
    if (IN(0)) { for (int rep_ = 0; rep_ < MK_REP0; ++rep_) {
        LAS float* cact = (LAS float*)L;
        LAS float* red = (LAS float*)(L + 32768);
        LAS float* scr = (LAS float*)(L + 40960 + wave * 8448);
        constexpr int I_IN = (DM / 64) * (DIN / 32), I_OUT = (DM / 64) * (DM / 32), I_P = 4 * (128 / 64) * (128 / 32), I_ALL = I_IN + I_OUT + I_P;
        auto mk_item = [&](int it) { TrItem t; int r = it;
            if (r < I_IN) { t.W = w_in; t.WT = Win_t; t.K = DM; t.N = DIN; t.item = r; t.permn = true; return t; } r -= I_IN;
            if (r < I_OUT) { t.W = w_out; t.WT = Wout_t; t.K = DM; t.N = DM; t.item = r; t.permn = false; return t; } r -= I_OUT;
            const int g = r >> 3; t.W = w_pool + (size_t)g * 16384; t.WT = WpT + (size_t)g * 16384; t.K = 128; t.N = 128; t.item = r & 7; t.permn = false; return t; };
        const int kq = tid >> 2, cq = tid & 3, cgp0 = bx < 256 ? bx : 0;
        float cv[16], wv[8][3], tv[32]; const int it0 = gw; const TrItem ti0 = mk_item(it0 < I_ALL ? it0 : 0);
#pragma unroll
        for (int i = 0; i < 16; ++i) cv[i] = c[tid + i * 512];
#pragma unroll
        for (int kk = 0; kk < 8; ++kk) { const float* wr = w_ada + (size_t)(kq * 8 + kk) * DIN + cgp0 * 12 + cq * 3; wv[kk][0] = wr[0]; wv[kk][1] = wr[1]; wv[kk][2] = wr[2]; }
        const float bias0 = (tid < 96) ? b_ada[cgp0 * 12 + tid % 12] : 0.f;
        if (it0 < I_ALL) tr_load(ti0, tv, lane);
#pragma unroll
        for (int i = 0; i < 16; ++i) { const float v = cv[i]; cact[tid + i * 512] = v / (1.0f + __expf(-v)); }
        __syncthreads();
        for (int cgp = bx; cgp < 256; cgp += G) {
            float a[8][3];
#pragma unroll
            for (int b = 0; b < 8; ++b) { a[b][0] = 0.f; a[b][1] = 0.f; a[b][2] = 0.f; }
            if (cgp != cgp0) {
#pragma unroll
                for (int kk = 0; kk < 8; ++kk) { const float* wr = w_ada + (size_t)(kq * 8 + kk) * DIN + cgp * 12 + cq * 3; wv[kk][0] = wr[0]; wv[kk][1] = wr[1]; wv[kk][2] = wr[2]; } }
#pragma unroll
            for (int kk = 0; kk < 8; ++kk) { const int k = kq * 8 + kk;
#pragma unroll
                for (int b = 0; b < 8; ++b) { const float ca = cact[b * DM + k]; a[b][0] += ca * wv[kk][0]; a[b][1] += ca * wv[kk][1]; a[b][2] += ca * wv[kk][2]; } }
            float v24[24];
#pragma unroll
            for (int b = 0; b < 8; ++b)
#pragma unroll
                for (int j = 0; j < 3; ++j) v24[b * 3 + j] = a[b][j];
#pragma unroll
            for (int i = 0; i < 12; ++i) { const bool up = (lane & 32) != 0; const float keep = up ? v24[i + 12] : v24[i], give = up ? v24[i] : v24[i + 12]; v24[i] = keep + __shfl_xor(give, 32); }
#pragma unroll
            for (int i = 0; i < 6; ++i) { const bool up = (lane & 16) != 0; const float keep = up ? v24[i + 6] : v24[i], give = up ? v24[i] : v24[i + 6]; v24[i] = keep + __shfl_xor(give, 16); }
#pragma unroll
            for (int i = 0; i < 3; ++i) { const bool up = (lane & 8) != 0; const float keep = up ? v24[i + 3] : v24[i], give = up ? v24[i] : v24[i + 3]; v24[i] = keep + __shfl_xor(give, 8); }
#pragma unroll
            for (int i = 0; i < 3; ++i) { v24[i] += __shfl_xor(v24[i], 4);
                const int idx = 12 * ((lane >> 5) & 1) + 6 * ((lane >> 4) & 1) + 3 * ((lane >> 3) & 1) + i;
                if ((lane & 4) == 0) red[wave * 96 + (idx / 3) * 12 + cq * 3 + (idx % 3)] = v24[i]; }
            __syncthreads();
            if (tid < 96) { float s = 0.f;
#pragma unroll
                for (int w = 0; w < 8; ++w) s += red[w * 96 + tid];
                const int b = tid / 12, n = cgp * 12 + tid % 12; mod[b * DIN + n] = s + (cgp == cgp0 ? bias0 : b_ada[n]); }
            __syncthreads();
        }
        if (it0 < I_ALL) tr_finish(ti0, tv, scr, lane);
        for (int it = gw + NGW; it < I_ALL; it += NGW) { float tv[32]; const TrItem ti = mk_item(it); tr_load(ti, tv, lane); tr_finish(ti, tv, scr, lane); }
        __syncthreads(); }
        if (pseamA && MK_REP0 == 1 && IN(0)) {
#pragma unroll
            for (int q = 0; q < 8; ++q) { const GAS f32x4* xr = (const GAS f32x4*)(x + (size_t)(mb0_ + q) * DM) + lane;
#pragma unroll
                for (int j = 0; j < 4; ++j) xrow_[q][j] = xr[64 * j]; } }
        if (BOTH(0)) GRID_BAR();
        STAMP(1);
    }
    if (IN(1) && fuse01) {
#pragma unroll
        for (int q = 0; q < 8; ++q) { float t = 0.f;
#pragma unroll
            for (int j = 0; j < 4; ++j) t += (xr_[q][j].x * xr_[q][j].x + xr_[q][j].y * xr_[q][j].y) + (xr_[q][j].z * xr_[q][j].z + xr_[q][j].w * xr_[q][j].w);
            xs_[q] = t; }
#pragma unroll
        for (int q = 0; q < 8; ++q) { const int m = gw + q * NGW;
            const float* mb = mod + (size_t)(m >> 11) * DIN;
            const float inv = 1.0f / sqrtf(wave_sum(xs_[q]) * (1.0f / DM) + 1e-6f);
            GAS unsigned long long* o8 = (GAS unsigned long long*)(XN + (size_t)m * DM) + lane;
#pragma unroll
            for (int j = 0; j < 4; ++j) { const int k = 4 * lane + 256 * j;
                const f32x4 gg = *(const f32x4*)(norm_g + k), sh = *(const f32x4*)(mb + k), sc = *(const f32x4*)(mb + DM + k);
                const f32x4 y = xr_[q][j] * inv * gg * (sc + 1.0f) + sh;
                o8[64 * j] = (unsigned long long)pk2(y.x, y.y) | ((unsigned long long)pk2(y.z, y.w) << 32); } }
        if (BOTH(1)) GRID_BAR();
        STAMP(2);
    } else
    if (IN(1)) { for (int rep_ = 0; rep_ < MK_REP1; ++rep_) {
        if (pseamA) {
            const int mb0 = mb0_; const float* mb = mod + (size_t)(mb0 >> 11) * DIN;
            f32x4 (&v)[8][4] = xrow_; f32x4 ga[4], sh4[4];
#pragma unroll
            for (int j = 0; j < 4; ++j) { const int k = 4 * lane + 256 * j; ga[j] = *(const f32x4*)(norm_g + k) * (*(const f32x4*)(mb + DM + k) + 1.0f); sh4[j] = *(const f32x4*)(mb + k); }
#pragma unroll
            for (int q = 0; q < 8; ++q) { float t = 0.f;
#pragma unroll
                for (int j = 0; j < 4; ++j) t += (v[q][j].x * v[q][j].x + v[q][j].y * v[q][j].y) + (v[q][j].z * v[q][j].z + v[q][j].w * v[q][j].w);
                const float inv = 1.0f / sqrtf(wave_sum(t) * (1.0f / DM) + 1e-6f);
                GAS unsigned long long* o8 = (GAS unsigned long long*)(XN + (size_t)(mb0 + q) * DM) + lane;
#pragma unroll
                for (int j = 0; j < 4; ++j) { const f32x4 y = v[q][j] * inv * ga[j] + sh4[j];
                    __hip_atomic_store(o8 + 64 * j, (unsigned long long)pk2(y.x, y.y) | ((unsigned long long)pk2(y.z, y.w) << 32), __ATOMIC_RELAXED, __HIP_MEMORY_SCOPE_AGENT); } }
        }
        const int mfirst = pseamA ? M : gw, mstep = NGW, mend = M;
        for (int m0 = mfirst; m0 < mend; m0 += 4 * mstep) {
            f32x4 v[4][4]; float s[4];
#pragma unroll
            for (int q = 0; q < 4; ++q) { const int m = m0 + q * mstep; const GAS f32x4* xr = (const GAS f32x4*)(x + (size_t)(m < M ? m : m0) * DM) + lane;
#pragma unroll
                for (int j = 0; j < 4; ++j) v[q][j] = xr[64 * j]; }
#pragma unroll
            for (int q = 0; q < 4; ++q) { float t = 0.f;
#pragma unroll
                for (int j = 0; j < 4; ++j) t += (v[q][j].x * v[q][j].x + v[q][j].y * v[q][j].y) + (v[q][j].z * v[q][j].z + v[q][j].w * v[q][j].w);
                s[q] = t; }
#pragma unroll
            for (int q = 0; q < 4; ++q) { const int m = m0 + q * mstep; if (m >= M) break;
                const float* mb = mod + (size_t)(m >> 11) * DIN;
                const float inv = 1.0f / sqrtf(wave_sum(s[q]) * (1.0f / DM) + 1e-6f);
                GAS unsigned long long* o8 = (GAS unsigned long long*)(XN + (size_t)m * DM) + lane;
#pragma unroll
                for (int j = 0; j < 4; ++j) { const int k = 4 * lane + 256 * j;
                    const f32x4 gg = *(const f32x4*)(norm_g + k), sh = *(const f32x4*)(mb + k), sc = *(const f32x4*)(mb + DM + k);
                    const f32x4 y = v[q][j] * inv * gg * (sc + 1.0f) + sh;
                    const unsigned long long pk8 = (unsigned long long)pk2(y.x, y.y) | ((unsigned long long)pk2(y.z, y.w) << 32);
                    if (pseamA) __hip_atomic_store(o8 + 64 * j, pk8, __ATOMIC_RELAXED, __HIP_MEMORY_SCOPE_AGENT); else o8[64 * j] = pk8; } }
        }
        }
        if (pseamA) {
            asm volatile("s_waitcnt vmcnt(0)" ::: "memory");
            __syncthreads();
            if (tid == 0) { unsigned* cnt = ctl + CW_SEAM_A + 64 * u2.pm;
                __hip_atomic_fetch_add(cnt, 1u, __ATOMIC_RELAXED, __HIP_MEMORY_SCOPE_AGENT);
                while (__hip_atomic_load(cnt, __ATOMIC_RELAXED, __HIP_MEMORY_SCOPE_AGENT) < 4u) __builtin_amdgcn_s_sleep(1);
                __builtin_amdgcn_fence(__ATOMIC_ACQUIRE, "agent"); asm volatile("s_waitcnt vmcnt(0)" ::: "memory"); }
            __syncthreads();
        } else if (BOTH(1)) GRID_BAR();
        STAMP(2);
    }
    if (IN(2)) { for (int rep_ = 0; rep_ < MK_REP2; ++rep_) {
        pg8::Gemm g{XN, Win_t, M, DIN, DM}; pg8::StaticOrder S; S.init(M, DIN, G, bx);
        pg8::EpiInProj E{__builtin_amdgcn_make_buffer_rsrc(ws + WS_PROJ, 0, (int)(6 * PROJ_STRIDE * 2), 0x00020000), PROJ_STRIDE, qg, kg};
        pg8::gemm_phase<pg8::EpiInProj, pg8::StaticOrder, true, true>(L, g, S, E);
#if MK_STAMP == 22 || MK_STAMP == 23
        tk2_ = *(volatile LAS unsigned long long*)(L + 147392); tk2e_ = __builtin_amdgcn_s_memrealtime();
#endif
        }
        if (pseamB) {
            __syncthreads();
            if (tid == 0) { unsigned* cnt = ctl + 6144 + 64 * (bx & 7);
                __hip_atomic_fetch_add(cnt, 1u, __ATOMIC_RELAXED, __HIP_MEMORY_SCOPE_AGENT);
                while (__hip_atomic_load(cnt, __ATOMIC_RELAXED, __HIP_MEMORY_SCOPE_AGENT) < 32u) __builtin_amdgcn_s_sleep(1);
                __builtin_amdgcn_fence(__ATOMIC_ACQUIRE, "agent"); asm volatile("s_waitcnt vmcnt(0)" ::: "memory"); }
            __syncthreads();
        } else if (BOTH(2)) GRID_BAR();
        STAMP(3);
    }
    if (IN(3)) { for (int rep_ = 0; rep_ < MK_REP3; ++rep_) {
        const bf16* Qb = PROJ; const bf16* Kb = PROJ + PROJ_STRIDE; const bf16* Vb = PROJ + 2 * PROJ_STRIDE; const bf16* GAb = PROJ + 3 * PROJ_STRIDE;
        const bf16* Ub = PROJ + 4 * PROJ_STRIDE; const bf16* GPb = PROJ + 5 * PROJ_STRIDE;
        for (int i = vcu; i < 256; i += G) {
            const int bh = i >> 2, qq = i & 3;
            if (i & 1) { pool::pool_unit(i >> 2, i & 3, Ub, GPb, WpT, b_pool, pool_scale, CAT, (LAS char*)L); PANEL_ARRIVE(i >> 2); }
            SUBSTAMP(0);
            att::attn_pass<MK_EARLY>(bh >> 3, bh & 7, 16 * qq + 8, Qb, Kb, Vb, GAb, CAT, (LAS char*)L);
            PANEL_ARRIVE((bh >> 3) * 8 + 2 * qq + 1);
            SUBSTAMP(1);
            att::attn_pass<MK_EARLY>(bh >> 3, bh & 7, 16 * qq, Qb, Kb, Vb, GAb, CAT, (LAS char*)L);
            PANEL_ARRIVE((bh >> 3) * 8 + 2 * qq);
            VM_WAIT(); __syncthreads();
            SUBSTAMP(2);
            if (!(i & 1)) { pool::pool_unit(i >> 2, i & 3, Ub, GPb, WpT, b_pool, pool_scale, CAT, (LAS char*)L); PANEL_ARRIVE(i >> 2); }
            VM_WAIT(); SUBSTAMP(3);
        }
        }
        if (!pseamB && BOTH(3)) GRID_BAR();
        STAMP(4);
    }
    if (IN(4)) { for (int rep_ = 0; rep_ < MK_REP4; ++rep_) {
        pg8::Gemm g{CAT, Wout_t, M, DM, DM}; pg8::StaticOrder S; S.init(M, DM, G, bx);
        if (pseamB) { pg8::Unit u4; S.next(0, u4);
            if (tid == 0) { unsigned* cnt = ctl + CW_SEAM_B + 64 * u4.pm;
                while (__hip_atomic_load(cnt, __ATOMIC_RELAXED, __HIP_MEMORY_SCOPE_AGENT) < 12u) __builtin_amdgcn_s_sleep(1);
                __builtin_amdgcn_fence(__ATOMIC_ACQUIRE, "agent"); asm volatile("s_waitcnt vmcnt(0)" ::: "memory"); }
            __syncthreads(); }
        pg8::EpiOutRes E{x, args.out, mod + 2 * DM};
        pg8::gemm_phase<pg8::EpiOutRes, pg8::StaticOrder, true, true>(L, g, S, E);
    } }
#if MK_STAMP >= 0
    GRID_BAR(); STAMP(5);
#if MK_STAMP == 22 || MK_STAMP == 23
    if (bx == 0 && tid == 0) args.out[0] += (MK_STAMP == 22) ? (float)(tk2e_ - tk2_) * 0.01f : (float)(ts_[3] - tk2e_) * 0.01f;
    if (false)
#endif
#if MK_STAMP == 20 || MK_STAMP == 21
    if (bx == 0 && tid == 0) { const unsigned long long tk = *(volatile LAS unsigned long long*)(L + 147392);
        args.out[0] += (MK_STAMP == 20) ? (float)(tk - ts_[4]) * 0.01f : (float)(ts_[5] - tk) * 0.01f; }
    if (false)
#endif
    if (bx == 0 && tid == 0) { const float T = (MK_STAMP >= 10) ? (float)((MK_STAMP == 13 ? ts_[4] : tsub_[(MK_STAMP - 9) & 3]) - tsub_[(MK_STAMP - 10) & 3]) * 0.01f : (float)(ts_[(MK_STAMP + 1) & 7] - ts_[MK_STAMP & 7]) * 0.01f; args.out[0] += (MK_STAMP == 5 ? (float)(ts_[5] - ts_[0]) * 0.01f : T); }
#endif
#undef IN
#undef BOTH
}

extern "C" void kernel_launch(void* const* d_in, const int* in_sizes, int n_in, void* d_out, int out_size, void* d_ws, size_t ws_size, hipStream_t stream) {
    static int grid = 0;
    if (grid == 0) {
        if (n_in != 12 || out_size != M * DM || ws_size < WS_END) { fprintf(stderr, "kernel_launch: unexpected shapes (n_in %d out %d ws %zu)\n", n_in, out_size, ws_size); grid = -1; return; }
        int dev = 0, cus = 0, per_cu = 0;
        if (hipGetDevice(&dev) != hipSuccess || hipDeviceGetAttribute(&cus, hipDeviceAttributeMultiprocessorCount, dev) != hipSuccess) { grid = -1; return; }
        if (hipFuncSetAttribute((const void*)hybrid_fwd, hipFuncAttributeMaxDynamicSharedMemorySize, LDS_BYTES) != hipSuccess) { fprintf(stderr, "kernel_launch: hipFuncSetAttribute failed\n"); grid = -1; return; }
        if (hipOccupancyMaxActiveBlocksPerMultiprocessor(&per_cu, (const void*)hybrid_fwd, NWAVES * 64, LDS_BYTES) != hipSuccess || per_cu < 1) { fprintf(stderr, "kernel_launch: occupancy query says %d\n", per_cu); per_cu = 1; }
        (void)hipGetLastError();
        grid = cus;
    }
    if (grid < 0) return;
#if MK_COOP
    if (hipMemsetAsync((char*)d_ws + WS_CTL, 0, CTL_ZERO_BYTES, stream) != hipSuccess) { fprintf(stderr, "kernel_launch: hipMemsetAsync failed\n"); return; }
#endif
    Args a{};
    for (int i = 0; i < 12; ++i) a.in[i] = (const float*)d_in[i];
    a.out = (float*)d_out; a.ws = (unsigned char*)d_ws;
#if MK_COOP
    a.ph_lo = 0; a.ph_hi = N_PHASES; a.coop = 1;
    void* kargs[] = {&a};
    hipError_t e = hipLaunchCooperativeKernel((const void*)hybrid_fwd, dim3(grid), dim3(NWAVES * 64), kargs, LDS_BYTES, stream);
    if (e != hipSuccess) fprintf(stderr, "kernel_launch: cooperative launch failed: %s (grid %d)\n", hipGetErrorString(e), grid);
#else
    for (int p = 0; p < N_PHASES; ++p) { a.ph_lo = p; a.ph_hi = p + 1; a.coop = 0;
        hipLaunchKernelGGL(hybrid_fwd, dim3(grid), dim3(NWAVES * 64), LDS_BYTES, stream, a); }
#endif
}
```

```cpp
#include <hip/hip_runtime.h>
#include <hip/hip_cooperative_groups.h>
#include <cstdio>
#include <cstdint>
namespace cg = cooperative_groups;
#ifndef MK_COOP
#define MK_COOP 1
#endif
#ifndef MK_EARLY
#define MK_EARLY true
#endif
#define PG8_SP2 true
#define PG8_ALIGN true
#ifndef MK_REP0
#define MK_REP0 1
#endif
#ifndef MK_REP1
#define MK_REP1 1
#endif
#ifndef MK_REP2
#define MK_REP2 1
#endif
#ifndef MK_REP3
#define MK_REP3 1
#endif
#ifndef MK_REP4
#define MK_REP4 1
#endif
#ifndef MK_REP3A
#define MK_REP3A 1
#endif
#ifndef MK_REP3P
#define MK_REP3P 1
#endif
#ifndef MK_STAMP
#define MK_STAMP -1
#endif
namespace pg8 {
#define PG8_LAS __attribute__((address_space(3)))
typedef unsigned short bf16_t;
typedef short bf16x8 __attribute__((ext_vector_type(8)));
typedef float f32x4 __attribute__((ext_vector_type(4)));
typedef unsigned u32x4 __attribute__((ext_vector_type(4)));
constexpr int BM = 256, BK = 64, HALF = 128, HTB = HALF * BK * 2  , STAGE_BYTES = 8 * HTB, NXCD = 8, WGM = 8;

__host__ __device__ __forceinline__ int lds_byte(int r, int c) { const int st = (r >> 4) * 2 + (c >> 5), rr = r & 15, cc = c & 31, ob = rr * 64 + cc * 2; return st * 1024 + (ob ^ (((ob >> 9) & 1) << 5)); }
__host__ __device__ __forceinline__ void stage_rc(int b, int& R, int& C) { const int st = b / 1024, sb = b % 1024, swz = sb ^ (((sb >> 9) & 1) << 5); R = (st >> 1) * 16 + swz / 64; C = (st & 1) * 32 + (swz % 64) / 2; }
__host__ __device__ __forceinline__ int perm32(int rho) { const int n = rho >> 4, i = rho & 15; return 8 * (i >> 2) + 4 * n + (i & 3); }

struct Unit { int pm, pn; };
struct Gemm { const bf16_t* A; const bf16_t* Bt; int M, N, K; };

struct StaticOrder {
    int nM, nN, nwg, G, c;
    __host__ __device__ void init(int M, int N, int G_, int c_) { nM = M / BM; nN = N / BM; nwg = nM * nN; G = G_; c = c_; }
    __host__ __device__ bool next(int i, Unit& u) const {
        const long L = (long)i * G + c; if (L >= nwg) return false;
        int wgid = (int)L; { const int q = nwg / NXCD, r = nwg % NXCD, xcd = wgid % NXCD, off = wgid / NXCD; wgid = (xcd < r ? xcd * (q + 1) : r * (q + 1) + (xcd - r) * q) + off; }
        const int nig = WGM * nN, gid = wgid / nig, fm = gid * WGM, gsz = (nM - fm) < WGM ? (nM - fm) : WGM;
        u.pm = fm + ((wgid % nig) % gsz); u.pn = (wgid % nig) / gsz; return true;
    }
    __device__ __forceinline__ void a_ready(const Unit&) const {}
    __device__ __forceinline__ void done(const Unit&) const {}
};
__device__ __forceinline__ unsigned cvt_pk_bf16(float lo, float hi) { unsigned r; asm volatile("v_cvt_pk_bf16_f32 %0, %1, %2" : "=v"(r) : "v"(lo), "v"(hi)); return r; }
typedef float f32x2 __attribute__((ext_vector_type(2)));
__device__ __forceinline__ float silu_f(float v) { return v * __builtin_amdgcn_rcpf(1.0f + __builtin_amdgcn_exp2f(-1.4426950408889634f * v)); }
constexpr float QSCALE = 0.125f * 1.4426950408889634f;
__device__ __forceinline__ size_t hm_off(int row, int head) { return ((size_t)((row >> 11) * 8 + head) * 2048 + (row & 2047)) * 64; }
struct EpiInProj {
    static constexpr bool PERM = true, AFTER_DRAIN = false;
    __amdgpu_buffer_rsrc_t rs; size_t stride; const float* gq; const float* gk;
    __device__ __forceinline__ void operator()(const f32x4 (&acc)[2][2][4][2], const Unit& u, int wr, int wc, int fr, int fq) const {
        const int type = u.pn >> 1;
        const size_t O = (size_t)type * stride;
        const int row0 = u.pm * BM + wr * 64 + fr;
        const int col0 = (u.pn & 1) * 256 + wc * 64 + 8 * fq;
        if (type < 2) {
            const float* g = type == 0 ? gq : gk; const float s = type == 0 ? QSCALE : 1.0f;
            f32x4 gs[2][2];
#pragma unroll
            for (int bj = 0; bj < 2; ++bj)
#pragma unroll
                for (int n = 0; n < 2; ++n) gs[bj][n] = *(const f32x4*)(g + 32 * bj + 8 * fq + 4 * n) * s;
#pragma unroll
            for (int ai = 0; ai < 2; ++ai)
#pragma unroll
                for (int m = 0; m < 4; ++m) {
                    float ss = 0.f;
#pragma unroll
                    for (int bj = 0; bj < 2; ++bj)
#pragma unroll
                        for (int n = 0; n < 2; ++n) { const f32x4 x = acc[ai][bj][m][n]; ss += (x[0] * x[0] + x[1] * x[1]) + (x[2] * x[2] + x[3] * x[3]); }
                    ss += __shfl_xor(ss, 16); ss += __shfl_xor(ss, 32);
                    const float inv = 1.0f / sqrtf(ss * (1.0f / 64.0f) + 1e-6f);
                    const size_t rowp = O + hm_off(row0 + ai * HALF + m * 16, (u.pn & 1) * 4 + wc) + 8 * fq;
#pragma unroll
                    for (int bj = 0; bj < 2; ++bj) { const f32x4 v0 = acc[ai][bj][m][0] * inv * gs[bj][0], v1 = acc[ai][bj][m][1] * inv * gs[bj][1];
                        u32x4 w; w.x = cvt_pk_bf16(v0[0], v0[1]); w.y = cvt_pk_bf16(v0[2], v0[3]); w.z = cvt_pk_bf16(v1[0], v1[1]); w.w = cvt_pk_bf16(v1[2], v1[3]);
                        __builtin_amdgcn_raw_buffer_store_b128(w, rs, (unsigned)((rowp + bj * 32) * 2), 0, 16); }
                }
        } else {
            const bool act = (type == 3) || (type == 5);
#pragma unroll
            for (int ai = 0; ai < 2; ++ai)
#pragma unroll
                for (int m = 0; m < 4; ++m) {
                    const int row = row0 + ai * HALF + m * 16;
                    const size_t rowp = (type <= 3) ? O + hm_off(row, (u.pn & 1) * 4 + wc) + 8 * fq : O + ((size_t)((u.pn & 1) * 2 + (wc >> 1)) * 16384 + row) * 128 + (wc & 1) * 64 + 8 * fq;
#pragma unroll
                    for (int bj = 0; bj < 2; ++bj) { f32x4 v0 = acc[ai][bj][m][0], v1 = acc[ai][bj][m][1];
                        if (act) { v0 = (f32x4){silu_f(v0[0]), silu_f(v0[1]), silu_f(v0[2]), silu_f(v0[3])}; v1 = (f32x4){silu_f(v1[0]), silu_f(v1[1]), silu_f(v1[2]), silu_f(v1[3])}; }
                        u32x4 w; w.x = cvt_pk_bf16(v0[0], v0[1]); w.y = cvt_pk_bf16(v0[2], v0[3]); w.z = cvt_pk_bf16(v1[0], v1[1]); w.w = cvt_pk_bf16(v1[2], v1[3]);
                        __builtin_amdgcn_raw_buffer_store_b128(w, rs, (unsigned)((rowp + bj * 32) * 2), 0, 16); }
                }
        }
    }
};
struct EpiOutRes {
    static constexpr bool PERM = false, AFTER_DRAIN = false;
    const float* x; float* out; const float* gate;
    __device__ __forceinline__ void operator()(const f32x4 (&acc)[2][2][4][2], const Unit& u, int wr, int wc, int fr, int fq) const {
        const int col0 = u.pn * BM + wc * 32 + 4 * fq;
        const float* gp = gate + (size_t)((u.pm * BM) >> 11) * 3072 + col0;
        f32x4 gv[2][2];
#pragma unroll
        for (int bj = 0; bj < 2; ++bj)
#pragma unroll
            for (int n = 0; n < 2; ++n) gv[bj][n] = *(const f32x4*)(gp + bj * HALF + n * 16);
#pragma unroll
        for (int ai = 0; ai < 2; ++ai) {
            f32x4 xv[4][2][2];
#pragma unroll
            for (int m = 0; m < 4; ++m) { const size_t off = (size_t)(u.pm * BM + ai * HALF + wr * 64 + m * 16 + fr) * 1024 + col0;
#pragma unroll
                for (int bj = 0; bj < 2; ++bj)
#pragma unroll
                    for (int n = 0; n < 2; ++n) xv[m][bj][n] = *(const f32x4*)(x + off + bj * HALF + n * 16); }
            asm volatile("" ::: "memory");
#pragma unroll
            for (int m = 0; m < 4; ++m) { const size_t off = (size_t)(u.pm * BM + ai * HALF + wr * 64 + m * 16 + fr) * 1024 + col0;
#pragma unroll
                for (int bj = 0; bj < 2; ++bj)
#pragma unroll
                    for (int n = 0; n < 2; ++n) *(f32x4*)(out + off + bj * HALF + n * 16) = xv[m][bj][n] + gv[bj][n] * acc[ai][bj][m][n]; }
        }
    }
};
template <class Epi, class Sched, bool ALIGN_EPI = false, bool SP2 = false>
__device__ __forceinline__ void gemm_phase(PG8_LAS unsigned char* lds, const Gemm g, const Sched& S, const Epi& E) {
    const int tid = threadIdx.x, wid = __builtin_amdgcn_readfirstlane(tid >> 6), lane = tid & 63, wr = wid >> 2, wc = wid & 3, fr = lane & 15, fq = lane >> 4;
    const int K = g.K, nt = K / BK;
    unsigned voffA[2], voffB[2];
#pragma unroll
    for (int i = 0; i < 2; ++i) { int R, C; stage_rc(tid * 16 + i * 8192, R, C); const int Rb = Epi::PERM ? ((R & ~31) + perm32(R & 31)) : R;
        voffA[i] = (unsigned)(R * K + C) * 2u; voffB[i] = (unsigned)(Rb * K + C) * 2u; }
    const size_t kstep = (size_t)(BK * 2);
    const size_t hstep = (size_t)HALF * K * 2;
    const size_t tstep = 2 * hstep;
    const unsigned ldsw = (unsigned)wid * 1024u;
    const int aoff = lds_byte(wr * 64 + fr, fq * 8), boff = lds_byte(wc * 32 + fr, fq * 8);
#define PG8_SA(b, h) (((b) * 2 + (h)) * HTB)
#define PG8_SB(b, h) ((4 + (b) * 2 + (h)) * HTB)
#define PG8_STAGE(bufoff, gbase, voff) do { _Pragma("unroll") for (int _i = 0; _i < 2; ++_i) \
        __builtin_amdgcn_global_load_lds((const unsigned*)((const char*)(gbase) + (voff)[_i]), (PG8_LAS unsigned*)(lds + (bufoff) + ldsw + _i * 8192), 16, 0, 0); } while (0)
#define PG8_LDA(dst, b, h) do { _Pragma("unroll") for (int m = 0; m < 4; ++m) _Pragma("unroll") for (int k = 0; k < 2; ++k) dst[m][k] = *(const PG8_LAS bf16x8*)(lds + PG8_SA(b, h) + aoff + m * 2048 + k * 1024); } while (0)
#define PG8_LDB(dst, b, h) do { _Pragma("unroll") for (int n = 0; n < 2; ++n) _Pragma("unroll") for (int k = 0; k < 2; ++k) dst[n][k] = *(const PG8_LAS bf16x8*)(lds + PG8_SB(b, h) + boff + n * 2048 + k * 1024); } while (0)
#define PG8_MMA(ai, bj, At, Bt) do { __builtin_amdgcn_s_setprio(1); _Pragma("unroll") for (int m = 0; m < 4; ++m) _Pragma("unroll") for (int n = 0; n < 2; ++n) _Pragma("unroll") for (int k = 0; k < 2; ++k) \
        acc[ai][bj][m][n] = __builtin_amdgcn_mfma_f32_16x16x32_bf16(Bt[n][k], At[m][k], acc[ai][bj][m][n], 0, 0, 0); __builtin_amdgcn_s_setprio(0); } while (0)
#define PG8_WAIT_V(n) asm volatile("s_waitcnt vmcnt(" #n ")" ::: "memory")
#define PG8_WAIT_L(n) asm volatile("s_waitcnt lgkmcnt(" #n ")" ::: "memory")
#define PG8_BAR __builtin_amdgcn_s_barrier()
#define PG8_SCHED __builtin_amdgcn_sched_barrier(0)
    Unit cur, nxt; int ui = 0;
    if (!S.next(0, cur)) return;
    f32x4 acc[2][2][4][2];
#pragma unroll
    for (int a = 0; a < 2; ++a)
#pragma unroll
        for (int b = 0; b < 2; ++b)
#pragma unroll
            for (int m = 0; m < 4; ++m)
#pragma unroll
                for (int n = 0; n < 2; ++n) acc[a][b][m][n] = (f32x4){0.f, 0.f, 0.f, 0.f};
    bf16x8 At[4][2], B0[2][2], B1[2][2];
    const char* cA = (const char*)g.A + (size_t)cur.pm * tstep; const char* cB = (const char*)g.Bt + (size_t)cur.pn * tstep;
    S.a_ready(cur);
    if constexpr (SP2) {
        PG8_STAGE(PG8_SB(0, 0), cB, voffB); PG8_STAGE(PG8_SB(0, 1), cB + hstep, voffB); PG8_STAGE(PG8_SA(0, 0), cA, voffA); PG8_STAGE(PG8_SA(0, 1), cA + hstep, voffA);
        if (wr == 1) PG8_BAR;
        PG8_WAIT_V(2); PG8_BAR;
        PG8_STAGE(PG8_SB(1, 0), cB + kstep, voffB); PG8_STAGE(PG8_SA(1, 0), cA + kstep, voffA); PG8_STAGE(PG8_SB(1, 1), cB + hstep + kstep, voffB);
        PG8_WAIT_V(6); PG8_BAR;
    } else {
        PG8_STAGE(PG8_SB(0, 0), cB, voffB); PG8_STAGE(PG8_SA(0, 0), cA, voffA); PG8_STAGE(PG8_SB(0, 1), cB + hstep, voffB); PG8_STAGE(PG8_SA(0, 1), cA + hstep, voffA);
        if (wr == 1) PG8_BAR;
        PG8_WAIT_V(4); PG8_BAR;
        PG8_STAGE(PG8_SB(1, 0), cB + kstep, voffB); PG8_STAGE(PG8_SA(1, 0), cA + kstep, voffA); PG8_STAGE(PG8_SB(1, 1), cB + hstep + kstep, voffB);
        PG8_WAIT_V(6); PG8_BAR;
    }
    for (;;) {
        const bool has_next = S.next(ui + 1, nxt);
        const char* nA = has_next ? (const char*)g.A + (size_t)nxt.pm * tstep : cA; const char* nB = has_next ? (const char*)g.Bt + (size_t)nxt.pn * tstep : cB;
        for (int t = 0; t < nt; t += 2) {
            const bool last = (t == nt - 2);
            const char* a1 = cA + (size_t)(t + 1) * kstep;
            const char* a2 = last ? nA : cA + (size_t)(t + 2) * kstep; const char* b2 = last ? nB : cB + (size_t)(t + 2) * kstep;
            const char* a3 = a2 + kstep; const char* b3 = b2 + kstep;
            if (last && has_next) S.a_ready(nxt);
            if constexpr (SP2) {
            PG8_LDB(B0, 0, 0); PG8_LDB(B1, 0, 1); PG8_SCHED; PG8_LDA(At, 0, 0); PG8_STAGE(PG8_SA(1, 1), a1 + hstep, voffA);
            PG8_WAIT_V(8); PG8_WAIT_L(0); PG8_BAR; PG8_MMA(0, 0, At, B0); PG8_MMA(0, 1, At, B1); PG8_BAR; PG8_SCHED;
            PG8_LDA(At, 0, 1); PG8_STAGE(PG8_SB(0, 0), b2, voffB); PG8_STAGE(PG8_SB(0, 1), b2 + hstep, voffB); PG8_STAGE(PG8_SA(0, 0), a2, voffA);
            PG8_WAIT_V(8); PG8_WAIT_L(0); PG8_BAR; PG8_MMA(1, 0, At, B0); PG8_MMA(1, 1, At, B1); PG8_BAR; PG8_SCHED;
            PG8_LDB(B0, 1, 0); PG8_LDB(B1, 1, 1); PG8_SCHED; PG8_LDA(At, 1, 0); PG8_STAGE(PG8_SA(0, 1), a2 + hstep, voffA);
            PG8_WAIT_V(8); PG8_WAIT_L(0); PG8_BAR; PG8_MMA(0, 0, At, B0); PG8_MMA(0, 1, At, B1); PG8_BAR; PG8_SCHED;
            PG8_LDA(At, 1, 1); PG8_STAGE(PG8_SB(1, 0), b3, voffB); PG8_STAGE(PG8_SB(1, 1), b3 + hstep, voffB); PG8_STAGE(PG8_SA(1, 0), a3, voffA);
            PG8_WAIT_V(8); PG8_WAIT_L(0); PG8_BAR; PG8_MMA(1, 0, At, B0); PG8_MMA(1, 1, At, B1); PG8_BAR; PG8_SCHED;
            } else {
            PG8_LDB(B0, 0, 0); PG8_SCHED; PG8_LDA(At, 0, 0); PG8_STAGE(PG8_SA(1, 1), a1 + hstep, voffA);
            PG8_WAIT_L(8); PG8_BAR; PG8_WAIT_L(0); PG8_MMA(0, 0, At, B0); PG8_BAR; PG8_SCHED;
            PG8_LDB(B1, 0, 1); PG8_STAGE(PG8_SB(0, 0), b2, voffB);
            PG8_BAR; PG8_WAIT_L(0); PG8_MMA(0, 1, At, B1); PG8_BAR;
            PG8_LDA(At, 0, 1); PG8_STAGE(PG8_SA(0, 0), a2, voffA);
            PG8_BAR; PG8_WAIT_L(0); PG8_MMA(1, 0, At, B0); PG8_BAR; PG8_SCHED;
            PG8_STAGE(PG8_SB(0, 1), b2 + hstep, voffB);
            PG8_WAIT_V(6); PG8_BAR; PG8_MMA(1, 1, At, B1); PG8_BAR;
            PG8_LDB(B0, 1, 0); PG8_SCHED; PG8_LDA(At, 1, 0); PG8_STAGE(PG8_SA(0, 1), a2 + hstep, voffA);
            PG8_WAIT_L(8); PG8_BAR; PG8_WAIT_L(0); PG8_MMA(0, 0, At, B0); PG8_BAR; PG8_SCHED;
            PG8_LDB(B1, 1, 1); PG8_STAGE(PG8_SB(1, 0), b3, voffB);
            PG8_BAR; PG8_WAIT_L(0); PG8_MMA(0, 1, At, B1); PG8_BAR;
            PG8_LDA(At, 1, 1); PG8_STAGE(PG8_SA(1, 0), a3, voffA);
            PG8_BAR; PG8_WAIT_L(0); PG8_MMA(1, 0, At, B0); PG8_BAR; PG8_SCHED;
            PG8_STAGE(PG8_SB(1, 1), b3 + hstep, voffB);
            PG8_WAIT_V(6); PG8_BAR; PG8_MMA(1, 1, At, B1); PG8_BAR;
            }
        }
        if constexpr (ALIGN_EPI) { if (wr == 0) PG8_BAR; }
#if MK_STAMP == 20 || MK_STAMP == 21 || MK_STAMP == 22 || MK_STAMP == 23
        if (threadIdx.x == 0) *(volatile PG8_LAS unsigned long long*)(lds + 147392) = __builtin_amdgcn_s_memrealtime();
#endif
        if constexpr (!Epi::AFTER_DRAIN) { E(acc, cur, wr, wc, fr, fq); S.done(cur); }
        if (!has_next) break;
#pragma unroll
        for (int a = 0; a < 2; ++a)
#pragma unroll
            for (int b = 0; b < 2; ++b)
#pragma unroll
                for (int m = 0; m < 4; ++m)
#pragma unroll
                    for (int n = 0; n < 2; ++n) acc[a][b][m][n] = (f32x4){0.f, 0.f, 0.f, 0.f};
        cur = nxt; cA = nA; cB = nB; ++ui;
        if constexpr (ALIGN_EPI) { if (wr == 1) PG8_BAR; }
    }
    PG8_WAIT_V(0);
    if constexpr (!ALIGN_EPI) { if (wr == 0) PG8_BAR; }
    PG8_BAR;
    if constexpr (Epi::AFTER_DRAIN) { E.fused(acc, cur, wr, wc, fr, fq, lds, wid, lane); S.done(cur); }
#undef PG8_SA
#undef PG8_SB
#undef PG8_STAGE
#undef PG8_LDA
#undef PG8_LDB
#undef PG8_MMA
#undef PG8_WAIT_V
#undef PG8_WAIT_L
#undef PG8_BAR
#undef PG8_SCHED
}
}

constexpr int NWAVES = 8;
constexpr int BATCH = 8, SEQ = 2048, DM = 1024, M = BATCH * SEQ, DIN = 3072, DH = 64, NH = 8, DA = 512;
constexpr size_t MiB = 1u << 20;
constexpr size_t WS_CTL = 0, CTL_ZERO_BYTES = 64 * 1024;
constexpr size_t WS_MOD = 1 * MiB;
constexpr size_t WS_WIN = 2 * MiB;
constexpr size_t WS_WOUT = 8 * MiB;
constexpr size_t WS_WPOOL = 10 * MiB;
constexpr size_t WS_XN = 16 * MiB;
constexpr size_t WS_PROJ = 48 * MiB;
constexpr size_t PROJ_STRIDE = (size_t)M * 512;
constexpr size_t WS_CAT = 144 * MiB;
constexpr size_t WS_END = 176 * MiB;
constexpr int RING_BYTES = 131072, LDS_BYTES = 147456, MISC_OFF = LDS_BYTES - 128;
constexpr int CW_BAR = 1024;

#define GAS __attribute__((address_space(1)))
#define LAS __attribute__((address_space(3)))
typedef unsigned short bf16;
typedef unsigned v4u __attribute__((ext_vector_type(4)));
typedef unsigned v2u __attribute__((ext_vector_type(2)));
typedef float f32x4 __attribute__((ext_vector_type(4)));
typedef float f32x16 __attribute__((ext_vector_type(16)));
typedef short bf16x8 __attribute__((ext_vector_type(8)));
typedef short s16x4 __attribute__((ext_vector_type(4)));
#define LDS_WAIT() asm volatile("s_waitcnt lgkmcnt(0)" ::: "memory")
#define VM_WAIT() asm volatile("s_waitcnt vmcnt(0)" ::: "memory")
__device__ __forceinline__ unsigned pk2(float lo, float hi) { return pg8::cvt_pk_bf16(lo, hi); }
__device__ __forceinline__ float bf_lo(unsigned u) { return __builtin_bit_cast(float, u << 16); }
__device__ __forceinline__ float bf_hi(unsigned u) { return __builtin_bit_cast(float, u & 0xffff0000u); }
#define XB_TMO      128
#define XB_XCNT(j)  (256  + 64 * (j))
#define XB_XSUB(j)  (1280 + 64 * (j))
#define XB_XGEN(j)  (2304 + 64 * (j))
#define XB_TOP      3328
#define XB_TOPGEN   3392
#define XCD_BAR_WORDS 3456
#define XB_SPIN_CAP (1u << 18)

__device__ __forceinline__ unsigned xb_ld(unsigned* p)              { return __hip_atomic_load(p, __ATOMIC_RELAXED, __HIP_MEMORY_SCOPE_AGENT); }
__device__ __forceinline__ unsigned xb_add(unsigned* p, unsigned v) { return __hip_atomic_fetch_add(p, v, __ATOMIC_RELAXED, __HIP_MEMORY_SCOPE_AGENT); }
__device__ __forceinline__ unsigned xb_xcc_id() { return (unsigned)__builtin_amdgcn_s_getreg((3 << 11) | 20) & 0xFu; }
#define XB_SPIN(cond, bar) do { unsigned _sp = 0; while (cond) { __builtin_amdgcn_s_sleep(1); \
    if ((++_sp & 255u) == 0u) { if (xb_ld(&(bar)[XB_TMO])) break; if (_sp > XB_SPIN_CAP) { atomicAdd(&(bar)[XB_TMO], 1u); break; } } } } while (0)

struct XcdBarrier {
    unsigned* bar; unsigned x;
    volatile LAS unsigned* st;
};

__device__ __forceinline__ XcdBarrier xcd_barrier_post(unsigned* bar, volatile LAS unsigned* st) {
    XcdBarrier b; b.bar = bar; b.x = xb_xcc_id(); b.st = st;
    if (threadIdx.x == 0) (void)xb_add(&bar[XB_XCNT(b.x)], 1u);
    return b;
}
__device__ __forceinline__ void xcd_barrier_complete(unsigned* bar, unsigned x, unsigned& nloc, unsigned& nx) {
    const unsigned G = gridDim.x * gridDim.y * gridDim.z;
    unsigned sum, cnt, mine, sp = 0u;
    for (;;) {
        sum = 0u; cnt = 0u; mine = 0u;
#pragma unroll
        for (unsigned j = 0; j < 16; ++j) { const unsigned c = xb_ld(&bar[XB_XCNT(j)]); sum += c; cnt += (c > 0u) ? 1u : 0u; mine = (j == x) ? c : mine; }
        if (sum == G) break;
        __builtin_amdgcn_s_sleep(1);
        if ((++sp & 255u) == 0u) { if (xb_ld(&bar[XB_TMO])) break; if (sp > XB_SPIN_CAP) { atomicAdd(&bar[XB_TMO], 1u); break; } }
    }
    nloc = mine > 0u ? mine : 1u; nx = cnt > 0u ? cnt : 1u;
}

__device__ __forceinline__ void xcd_barrier(const XcdBarrier& b) {
    asm volatile("s_waitcnt vmcnt(0)" ::: "memory");
    __syncthreads();
    if (threadIdx.x == 0) {
        unsigned* bar = b.bar;
        __builtin_amdgcn_s_waitcnt(0);
        unsigned nloc = b.st[0], nx = b.st[1];
        if (nloc == 0u) { xcd_barrier_complete(bar, b.x, nloc, nx); b.st[0] = nloc; b.st[1] = nx; }
        const unsigned old = xb_add(&bar[XB_XSUB(b.x)], 1u);
        const unsigned gen = old / nloc;
        if (old + 1u == (gen + 1u) * nloc) {
            __builtin_amdgcn_fence(__ATOMIC_RELEASE, "agent");
            asm volatile("s_waitcnt vmcnt(0)" ::: "memory");
            const unsigned og = xb_add(&bar[XB_TOP], 1u);
            const unsigned tg = og / nx;
            if (og + 1u == (tg + 1u) * nx) xb_add(&bar[XB_TOPGEN], 1u);
            else XB_SPIN(xb_ld(&bar[XB_TOPGEN]) == tg, bar);
            __builtin_amdgcn_fence(__ATOMIC_ACQUIRE, "agent");
            xb_add(&bar[XB_XGEN(b.x)], 1u);
            asm volatile("s_waitcnt vmcnt(0)" ::: "memory");
        } else {
            XB_SPIN(xb_ld(&bar[XB_XGEN(b.x)]) == gen, bar);
            __builtin_amdgcn_fence(__ATOMIC_ACQUIRE, "agent");
            asm volatile("s_waitcnt vmcnt(0)" ::: "memory");
        }
    }
    __syncthreads();
}

#ifndef MK_SEAMB
#define MK_SEAMB 1
#endif
__device__ __forceinline__ void cat_store16(bf16* CAT, size_t elem, v4u w) {
#if MK_SEAMB
    const __amdgpu_buffer_rsrc_t rs = __builtin_amdgcn_make_buffer_rsrc(CAT, 0, (int)((size_t)M * DM * 2), 0x00020000);
    __builtin_amdgcn_raw_buffer_store_b128(w, rs, (unsigned)(elem * 2), 0, 16);
#else
    *(v4u*)(CAT + elem) = w;
#endif
}
namespace att {
__device__ __forceinline__ void glds16(const void* gsrc, unsigned lds_dst) { unsigned keep;
    asm volatile("s_mov_b32 %0, m0\n\ts_mov_b32 m0, %2\n\ts_nop 0\n\tglobal_load_lds_dwordx4 %1, off\n\ts_mov_b32 m0, %0" : "=&s"(keep) : "v"(gsrc), "s"(lds_dst) : "memory"); }
typedef short v4i16_t __attribute__((ext_vector_type(4)));
__device__ __forceinline__ s16x4 vtr(LAS const char* p) { return __builtin_bit_cast(s16x4, __builtin_amdgcn_ds_read_tr16_b64_v4i16((LAS v4i16_t*)p)); }
constexpr int TILEB = 8192, VOFF = 4096, STAGE_OFF = 12 * TILEB, STAGE_B = 4608;
#ifndef ATT_HIST
#define ATT_HIST 0
#endif

template <bool DIAG>
__device__ __forceinline__ void tile_weights(f32x16& p0, float& carry, unsigned (&pw)[2][4], int kv0, int qabs, int hi) {
    float G[4];
#pragma unroll
    for (int i = 0; i < 4; ++i) {
        float rr[4], be[4];
#pragma unroll
        for (int j = 0; j < 4; ++j) {
            const float e = __builtin_amdgcn_exp2f(p0[4 * i + j]);
            float rv = __builtin_amdgcn_rcpf(1.0f + e); float bv = e * rv;
            if (DIAG) { const int kv = kv0 + 8 * i + 4 * hi + j; if (kv >= qabs) { rv = 1.0f; bv = 0.0f; } }
            rr[j] = rv; be[j] = bv;
        }
        const float s2 = rr[3], s1 = s2 * rr[2], s0 = s1 * rr[1];
        G[i] = s0 * rr[0];
        p0[4 * i + 3] = be[3]; p0[4 * i + 2] = be[2] * s2; p0[4 * i + 1] = be[1] * s1; p0[4 * i] = be[0] * s0;
    }
    float F[4]; float run = carry;
#pragma unroll
    for (int p = 3; p >= 0; --p) {
        auto sw = __builtin_amdgcn_permlane32_swap(__float_as_uint(G[p]), __float_as_uint(G[p]), false, false);
        const float g0 = __uint_as_float(sw[0]), g1 = __uint_as_float(sw[1]);
        F[p] = run * (hi ? 1.0f : g1);
        run = run * (g0 * g1);
    }
    carry = run;
#pragma unroll
    for (int i = 0; i < 4; ++i) { const float f = F[i];
        pw[i >> 1][2 * (i & 1)] = pk2(p0[4 * i] * f, p0[4 * i + 1] * f); pw[i >> 1][2 * (i & 1) + 1] = pk2(p0[4 * i + 2] * f, p0[4 * i + 3] * f); }
}

template <bool EARLY>
__device__ __forceinline__ void attn_pass(int b, int h, int qb0, const bf16* Q, const bf16* K, const bf16* V, const bf16* GA, bf16* CAT, LAS char* shm) {
    const int tid = threadIdx.x, lane = tid & 63, r32 = lane & 31, hi = lane >> 5; const int wid = __builtin_amdgcn_readfirstlane(tid >> 6);
    const size_t hb = ((size_t)(b * NH + h) * SEQ) * DH;
    const bf16* Qh = Q + hb; const bf16* Kh = K + hb; const bf16* Vh = V + hb;
    const unsigned lds0 = (unsigned)__builtin_amdgcn_readfirstlane((int)(unsigned)(uintptr_t)shm);
    const int wb = qb0 - ATT_HIST > 0 ? qb0 - ATT_HIST : 0, nw = qb0 + 8 - wb;
    const bf16* ksrc = Kh + (size_t)(lane >> 3) * DH + (((lane & 7) ^ ((lane >> 3) & 7)) * 8);
    const bf16* vsrc = Vh + (size_t)(lane >> 2) * DH + (lane & 3) * 8;
    for (int p = wid; p < nw * 8; p += NWAVES) {
        const int w = p >> 3, pc = p & 7; const size_t trow = (size_t)(wb + w) * 32;
        const unsigned dst = lds0 + w * TILEB + pc * 1024;
        if (pc < 4) glds16(ksrc + (trow + 8 * pc) * DH, dst);
        else glds16(vsrc + (trow + 16 * ((pc - 4) & 1)) * DH + 32 * ((pc - 4) >> 1), dst);
    }
    const int qblk = qb0 + wid, q0 = qblk * 32, qabs = q0 + r32;
    bf16x8 qr[4];
#pragma unroll
    for (int d0 = 0; d0 < 4; ++d0) qr[d0] = *reinterpret_cast<const bf16x8*>(&Qh[(size_t)qabs * DH + d0 * 16 + hi * 8]);
    const size_t tok0 = (size_t)b * SEQ + q0;
    v4u gpre[2][2];
#pragma unroll
    for (int dh = 0; dh < 2; ++dh)
#pragma unroll
        for (int k = 0; k < 2; ++k) gpre[dh][k] = *(const v4u*)(GA + hb + (size_t)(q0 + 16 * k + (lane >> 2)) * DH + 32 * dh + (lane & 3) * 8);
    asm volatile("s_waitcnt vmcnt(0)" ::: "memory");
    __syncthreads();
    f32x16 o[2]; o[0] = f32x16{}; o[1] = f32x16{};
    float carry = 1.0f; bool dead = false;
    LAS const char* kp0 = shm + r32 * 128;
    LAS const char* vp0 = shm + VOFF + ((lane >> 4) & 1) * 32 + (lane & 3) * 8 + (4 * hi + ((lane & 15) >> 2)) * 64;
#define ATT_TILE(DG) do { \
        const int w = t - wb; LAS const char* kp = kp0 + w * TILEB; f32x16 p0 = f32x16{}; \
        _Pragma("unroll") for (int d0 = 0; d0 < 4; ++d0) { const bf16x8 kf = *(LAS const bf16x8*)(kp + (((2 * d0 + hi) ^ (r32 & 7)) * 16)); p0 = __builtin_amdgcn_mfma_f32_32x32x16_bf16(kf, qr[d0], p0, 0, 0, 0); } \
        unsigned pw[2][4]; tile_weights<DG>(p0, carry, pw, t * 32, qabs, hi); \
        LAS const char* vp = vp0 + w * TILEB; \
        _Pragma("unroll") for (int dh = 0; dh < 2; ++dh) _Pragma("unroll") for (int ks = 0; ks < 2; ++ks) { \
            const s16x4 lo = vtr(vp + dh * 2048 + ks * 1024), hh = vtr(vp + dh * 2048 + ks * 1024 + 512); \
            const bf16x8 vf = (bf16x8){lo[0], lo[1], lo[2], lo[3], hh[0], hh[1], hh[2], hh[3]}; \
            const v4u pwv = (v4u){pw[ks][0], pw[ks][1], pw[ks][2], pw[ks][3]}; \
            o[dh] = __builtin_amdgcn_mfma_f32_32x32x16_bf16(vf, __builtin_bit_cast(bf16x8, pwv), o[dh], 0, 0, 0); } } while (0)
    int t = qblk;
    ATT_TILE(true);
    if (EARLY && __all(carry < 1e-30f)) dead = true;
    if (!dead) for (t = qblk - 1; t >= wb; --t) {
        ATT_TILE(false);
        if (EARLY) { if (__all(carry < 1e-30f)) { dead = true; break; } }
    }
#undef ATT_TILE
    if (!dead) {
        for (t = wb - 1; t >= 0; --t) {
            f32x16 p0 = f32x16{};
#pragma unroll
            for (int d0 = 0; d0 < 4; ++d0) {
                const bf16x8 kf = *reinterpret_cast<const bf16x8*>(&Kh[((size_t)t * 32 + r32) * DH + (2 * d0 + hi) * 8]);
                p0 = __builtin_amdgcn_mfma_f32_32x32x16_bf16(kf, qr[d0], p0, 0, 0, 0);
            }
            unsigned pw[2][4];
            tile_weights<false>(p0, carry, pw, t * 32, qabs, hi);
#pragma unroll
            for (int dh = 0; dh < 2; ++dh)
#pragma unroll
                for (int ks = 0; ks < 2; ++ks) {
                    bf16x8 vf;
#pragma unroll
                    for (int j = 0; j < 8; ++j) vf[j] = (short)Vh[((size_t)t * 32 + 16 * ks + 8 * (j >> 2) + 4 * hi + (j & 3)) * DH + 32 * dh + r32];
                    const v4u pwv = (v4u){pw[ks][0], pw[ks][1], pw[ks][2], pw[ks][3]};
                    o[dh] = __builtin_amdgcn_mfma_f32_32x32x16_bf16(vf, __builtin_bit_cast(bf16x8, pwv), o[dh], 0, 0, 0);
                }
            if (EARLY) { if (__all(carry < 1e-30f)) break; }
        }
    }
    {
        LAS char* st = shm + STAGE_OFF + wid * STAGE_B;
        const int rr = lane >> 2, ch = lane & 3;
#pragma unroll
        for (int dh = 0; dh < 2; ++dh) {
#pragma unroll
            for (int i = 0; i < 4; ++i) *(LAS f32x4*)(st + r32 * 144 + (8 * i + 4 * hi) * 4) = (f32x4){o[dh][4 * i], o[dh][4 * i + 1], o[dh][4 * i + 2], o[dh][4 * i + 3]};
            asm volatile("s_waitcnt lgkmcnt(0)" ::: "memory");
#pragma unroll
            for (int k = 0; k < 2; ++k) { const int row = 16 * k + rr;
                const f32x4 a0 = *(LAS const f32x4*)(st + row * 144 + ch * 32), a1 = *(LAS const f32x4*)(st + row * 144 + ch * 32 + 16);
                const v4u g = gpre[dh][k];
                v4u w; w.x = pk2(a0[0] * bf_lo(g.x), a0[1] * bf_hi(g.x)); w.y = pk2(a0[2] * bf_lo(g.y), a0[3] * bf_hi(g.y));
                w.z = pk2(a1[0] * bf_lo(g.z), a1[1] * bf_hi(g.z)); w.w = pk2(a1[2] * bf_lo(g.w), a1[3] * bf_hi(g.w));
                cat_store16(CAT, (tok0 + row) * DM + h * DH + 32 * dh + ch * 8, w); }
            asm volatile("s_waitcnt lgkmcnt(0)" ::: "memory");
        }
    }
    asm volatile("s_waitcnt vmcnt(0)" ::: "memory");
    __syncthreads();
}
}

namespace pool {
constexpr int UP = 272;
constexpr int UROWS = 272;
constexpr int WOFF = UROWS * UP;
typedef short v4i16_t __attribute__((ext_vector_type(4)));
__device__ __forceinline__ s16x4 vtr(LAS const char* p) { return __builtin_bit_cast(s16x4, __builtin_amdgcn_ds_read_tr16_b64_v4i16((LAS v4i16_t*)p)); }
template <int WIN>
__device__ __forceinline__ void pool_unit_w(int pm, int g, const bf16* U, const bf16* GP, const bf16* WpT, const float* bp, const float* ps, bf16* CAT, LAS char* shm) {
    const int tid = threadIdx.x, lane = tid & 63, r32 = lane & 31, hi = lane >> 5; const int wid = __builtin_amdgcn_readfirstlane(tid >> 6);
    asm volatile("" : "+s"(pm), "+s"(g));
    const int t0 = pm * 256, tpos0 = t0 & (SEQ - 1);
    v4u tu[9], tw[4];
#pragma unroll
    for (int k = 0; k < 9; ++k) { const int c = tid + k * 512, row = c >> 4, ch = c & 15; tu[k] = (v4u){0u, 0u, 0u, 0u};
        if (c < UROWS * 16 && tpos0 - 16 + row >= 0) tu[k] = *(const v4u*)(U + ((size_t)g * M + (t0 - 16 + row)) * 128 + ch * 8); }
#pragma unroll
    for (int k = 0; k < 4; ++k) { const int c = tid + k * 512; tw[k] = *(const v4u*)(WpT + (size_t)g * 16384 + (size_t)c * 8); }
#pragma unroll
    for (int k = 0; k < 9; ++k) { const int c = tid + k * 512, row = c >> 4, ch = c & 15; if (c < UROWS * 16) *(LAS v4u*)(shm + row * UP + ch * 16) = tu[k]; }
#pragma unroll
    for (int k = 0; k < 4; ++k) { const int c = tid + k * 512, row = c >> 4, ch = c & 15; *(LAS v4u*)(shm + WOFF + row * UP + ch * 16) = tw[k]; }
    v4u gpre[2][4];
#pragma unroll
    for (int half = 0; half < 2; ++half)
#pragma unroll
        for (int k = 0; k < 4; ++k) gpre[half][k] = *(const v4u*)(GP + ((size_t)g * M + t0 + wid * 32 + 8 * k + (lane >> 3)) * 128 + 64 * half + (lane & 7) * 8);
    __syncthreads();
    const int r = wid * 32 + r32, tpos = tpos0 + r;
    const float inv = 1.0f / (float)(tpos + 1 < WIN ? tpos + 1 : WIN);
    bf16x8 band[3];
#pragma unroll
    for (int ks = 0; ks < 3; ++ks)
#pragma unroll
        for (int j = 0; j < 8; ++j) { const int dlt = (r32 + 16) - (16 * ks + 8 * (j >> 2) + 4 * hi + (j & 3));
            band[ks][j] = (dlt >= 0 && dlt < WIN) ? (short)0x3F80 : (short)0; }
    LAS const char* ub = shm + (32 * wid + 4 * hi + ((lane & 15) >> 2)) * UP + (16 * ((lane >> 4) & 1) + 4 * (lane & 3)) * 2;
    LAS const char* urow = shm + (32 * wid + r32 + 16) * UP + 8 * hi;
    LAS const char* wl = shm + WOFF + r32 * UP + 8 * hi;
    f32x16 acc[4]; acc[0] = f32x16{}; acc[1] = f32x16{}; acc[2] = f32x16{}; acc[3] = f32x16{};
#pragma unroll 1
    for (int ct = 0; ct < 4; ++ct) {
        f32x16 X = f32x16{};
#pragma unroll
        for (int ks = 0; ks < 3; ++ks) {
            const s16x4 lo = vtr(ub + (16 * ks) * UP + ct * 64), hh = vtr(ub + (16 * ks + 8) * UP + ct * 64);
            const bf16x8 uf = (bf16x8){lo[0], lo[1], lo[2], lo[3], hh[0], hh[1], hh[2], hh[3]};
            X = __builtin_amdgcn_mfma_f32_32x32x16_bf16(uf, band[ks], X, 0, 0, 0);
        }
        unsigned pw[2][4];
#pragma unroll
        for (int i = 0; i < 4; ++i) { const v2u ut = *(LAS const v2u*)(urow + (32 * ct + 8 * i) * 2);
            pw[i >> 1][2 * (i & 1)] = pk2(X[4 * i] * inv - bf_lo(ut.x), X[4 * i + 1] * inv - bf_hi(ut.x));
            pw[i >> 1][2 * (i & 1) + 1] = pk2(X[4 * i + 2] * inv - bf_lo(ut.y), X[4 * i + 3] * inv - bf_hi(ut.y)); }
#pragma unroll
        for (int s2 = 0; s2 < 2; ++s2) { const int S = 2 * ct + s2;
            const v4u pv = (v4u){pw[s2][0], pw[s2][1], pw[s2][2], pw[s2][3]};
            const bf16x8 pfr = __builtin_bit_cast(bf16x8, pv);
#pragma unroll
            for (int n = 0; n < 4; ++n) { const v2u w0 = *(LAS const v2u*)(wl + n * 32 * UP + 32 * S), w1 = *(LAS const v2u*)(wl + n * 32 * UP + 32 * S + 16);
                const v4u wv = (v4u){w0.x, w0.y, w1.x, w1.y};
                acc[n] = __builtin_amdgcn_mfma_f32_32x32x16_bf16(__builtin_bit_cast(bf16x8, wv), pfr, acc[n], 0, 0, 0); }
        }
    }
    __syncthreads();
    {
        LAS char* st = shm + wid * 16384;
        const size_t tokw = (size_t)t0 + wid * 32;
        const int rr = lane >> 3, ch = lane & 7;
#pragma unroll
        for (int half = 0; half < 2; ++half) {
#pragma unroll
            for (int nn = 0; nn < 2; ++nn)
#pragma unroll
                for (int i = 0; i < 4; ++i) { const int n = 2 * half + nn;
                    *(LAS f32x4*)(st + r32 * 272 + (32 * nn + 8 * i + 4 * hi) * 4) = (f32x4){acc[n][4 * i], acc[n][4 * i + 1], acc[n][4 * i + 2], acc[n][4 * i + 3]}; }
            asm volatile("s_waitcnt lgkmcnt(0)" ::: "memory");
            const int col = g * 128 + 64 * half + ch * 8;
            const f32x4 b0 = *(const f32x4*)(bp + col), b1 = *(const f32x4*)(bp + col + 4), s0 = *(const f32x4*)(ps + col), s1 = *(const f32x4*)(ps + col + 4);
#pragma unroll
            for (int k = 0; k < 4; ++k) { const int row = 8 * k + rr;
                const f32x4 a0 = (*(LAS const f32x4*)(st + row * 272 + ch * 32) + b0) * s0, a1 = (*(LAS const f32x4*)(st + row * 272 + ch * 32 + 16) + b1) * s1;
                const v4u gv = gpre[half][k];
                v4u w; w.x = pk2(a0[0] * bf_lo(gv.x), a0[1] * bf_hi(gv.x)); w.y = pk2(a0[2] * bf_lo(gv.y), a0[3] * bf_hi(gv.y));
                w.z = pk2(a1[0] * bf_lo(gv.z), a1[1] * bf_hi(gv.z)); w.w = pk2(a1[2] * bf_lo(gv.w), a1[3] * bf_hi(gv.w));
                cat_store16(CAT, (tokw + row) * DM + 512 + col, w); }
            asm volatile("s_waitcnt lgkmcnt(0)" ::: "memory");
        }
    }
    asm volatile("s_waitcnt vmcnt(0)" ::: "memory");
    __syncthreads();
}
__device__ __forceinline__ void pool_unit(int pm, int g, const bf16* U, const bf16* GP, const bf16* WpT, const float* bp, const float* ps, bf16* CAT, LAS char* shm) {
    if (g == 0) pool_unit_w<2>(pm, g, U, GP, WpT, bp, ps, CAT, shm);
    else if (g == 1) pool_unit_w<4>(pm, g, U, GP, WpT, bp, ps, CAT, shm);
    else if (g == 2) pool_unit_w<8>(pm, g, U, GP, WpT, bp, ps, CAT, shm);
    else pool_unit_w<16>(pm, g, U, GP, WpT, bp, ps, CAT, shm);
}
}

__device__ __forceinline__ float wave_sum(float v) {
#pragma unroll
    for (int o = 1; o < 64; o <<= 1) v += __shfl_xor(v, o);
    return v;
}
struct TrItem { const float* W; bf16* WT; int K, N, item; bool permn; };
__device__ __forceinline__ void tr_load(const TrItem& t, float (&v)[32], int lane) {
    const int nblk = t.N / 32, kb = t.item / nblk, nb = t.item % nblk, k0 = 64 * kb, n0 = 32 * nb;
#pragma unroll
    for (int i = 0; i < 32; ++i) { const int kk = 2 * i + (lane >> 5); v[i] = t.W[(size_t)(k0 + kk) * t.N + n0 + (lane & 31)]; }
}
__device__ __forceinline__ void tr_finish(const TrItem& t, const float (&v)[32], LAS float* scr, int lane) {
    const int nblk = t.N / 32, kb = t.item / nblk, nb = t.item % nblk, k0 = 64 * kb, n0 = 32 * nb;
#pragma unroll
    for (int i = 0; i < 32; ++i) { const int kk = 2 * i + (lane >> 5); scr[kk * 33 + (lane & 31)] = v[i]; }
    LDS_WAIT(); asm volatile("" ::: "memory");
    const int c = lane & 7;
#pragma unroll
    for (int j = 0; j < 4; ++j) { const int n = (lane >> 3) + 8 * j; const LAS float* s = scr + (8 * c) * 33 + n;
        v4u o; o.x = pk2(s[0 * 33], s[1 * 33]); o.y = pk2(s[2 * 33], s[3 * 33]); o.z = pk2(s[4 * 33], s[5 * 33]); o.w = pk2(s[6 * 33], s[7 * 33]);
        int na = n0 + n;
        if (t.permn) na = (na & ~255) + 128 * ((na >> 5) & 1) + 32 * ((na >> 6) & 3) + (na & 31);
        *(GAS v4u*)(t.WT + (size_t)na * t.K + k0 + 8 * c) = o; }
    LDS_WAIT(); asm volatile("" ::: "memory");
}

struct Args { const float* in[12]; float* out; unsigned char* ws; int ph_lo, ph_hi; int coop, pad; };
constexpr int N_PHASES = 5;

__global__ void __launch_bounds__(NWAVES * 64, 2) hybrid_fwd(Args args) {
    extern __shared__ __attribute__((aligned(16))) unsigned char lds[];
    LAS unsigned char* L = (LAS unsigned char*)lds;
    const int tid = threadIdx.x, lane = tid & 63, wave = __builtin_amdgcn_readfirstlane(tid >> 6);
    const int G = gridDim.x, bx = blockIdx.x;
    const int vcu = (G % 8 == 0) ? (bx % 8) * (G / 8) + bx / 8 : bx;
    const float* x = args.in[0]; const float* c = args.in[1]; const float* w_ada = args.in[2]; const float* b_ada = args.in[3]; const float* norm_g = args.in[4];
    const float* w_in = args.in[5]; const float* qg = args.in[6]; const float* kg = args.in[7]; const float* w_pool = args.in[8]; const float* b_pool = args.in[9];
    const float* pool_scale = args.in[10]; const float* w_out = args.in[11];
    unsigned char* ws = args.ws;
    float* mod = (float*)(ws + WS_MOD);
    bf16* Win_t = (bf16*)(ws + WS_WIN); bf16* Wout_t = (bf16*)(ws + WS_WOUT); bf16* WpT = (bf16*)(ws + WS_WPOOL);
    bf16* XN = (bf16*)(ws + WS_XN); bf16* PROJ = (bf16*)(ws + WS_PROJ); bf16* CAT = (bf16*)(ws + WS_CAT);
    const int lo = args.ph_lo, hi = args.ph_hi;
#define IN(k) (lo <= (k) && (k) < hi)
#define BOTH(k) (IN(k) && IN((k) + 1))
#if MK_COOP
    if (tid < 32) ((LAS unsigned*)(L + MISC_OFF))[tid] = 0u;
    __syncthreads();
    XcdBarrier bar = xcd_barrier_post((unsigned*)(ws + WS_CTL) + CW_BAR, (volatile LAS unsigned*)(L + MISC_OFF) + 8);
#define GRID_BAR() do { if (args.coop == 2) cg::this_grid().sync(); else xcd_barrier(bar); } while (0)
#else
#define GRID_BAR() do { } while (0)
#endif
    const int gw = vcu * NWAVES + wave, NGW = G * NWAVES;
    unsigned* ctl = (unsigned*)(ws + WS_CTL); constexpr int CW_SEAM_B = 12288;
    const bool pseamB = MK_SEAMB && MK_COOP && G == 256 && lo == 0 && hi == N_PHASES && MK_STAMP < 0 && MK_REP3 == 1;
    constexpr int CW_SEAM_A = 8192;
    const bool pseamA = pseamB && MK_REP1 == 1;
    pg8::Unit u2; u2.pm = 0; u2.pn = 0; if (pseamA) { pg8::StaticOrder S2; S2.init(M, DIN, G, bx); S2.next(0, u2); }
#define PANEL_ARRIVE(p_) do { if (pseamB && tid == 0) __hip_atomic_fetch_add(ctl + CW_SEAM_B + 64 * (p_), 1u, __ATOMIC_RELAXED, __HIP_MEMORY_SCOPE_AGENT); } while (0)
#if MK_STAMP >= 0
    unsigned long long ts_[8]; ts_[0] = __builtin_amdgcn_s_memrealtime();
#define STAMP(k) do { ts_[k] = __builtin_amdgcn_s_memrealtime(); } while (0)
    unsigned long long tsub_[4] = {0, 0, 0, 0}; unsigned long long tk2_ = 0, tk2e_ = 0;
#define SUBSTAMP(k) do { tsub_[k] = __builtin_amdgcn_s_memrealtime(); } while (0)
#else
#define STAMP(k) do { } while (0)
#define SUBSTAMP(k) do { } while (0)
#endif

    const bool fuse01 = false;
    f32x4 xr_[8][4]; float xs_[8];
    if (fuse01) {
#pragma unroll
        for (int q = 0; q < 8; ++q) { const GAS f32x4* xp = (const GAS f32x4*)(x + (size_t)(gw + q * NGW) * DM) + lane;
#pragma unroll
            for (int j = 0; j < 4; ++j) xr_[q][j] = xp[64 * j]; }
    }
    if (IN(0)) { for (int rep_ = 0; rep_ < MK_REP0; ++rep_) {
        LAS float* cact = (LAS float*)L;
        LAS float* red = (LAS float*)(L + 32768);
        LAS float* scr = (LAS float*)(L + 40960 + wave * 8448);
        constexpr int I_IN = (DM / 64) * (DIN / 32), I_OUT = (DM / 64) * (DM / 32), I_P = 4 * (128 / 64) * (128 / 32), I_ALL = I_IN + I_OUT + I_P;
        auto mk_item = [&](int it) { TrItem t; int r = it;
            if (r < I_IN) { t.W = w_in; t.WT = Win_t; t.K = DM; t.N = DIN; t.item = r; t.permn = true; return t; } r -= I_IN;
            if (r < I_OUT) { t.W = w_out; t.WT = Wout_t; t.K = DM; t.N = DM; t.item = r; t.permn = false; return t; } r -= I_OUT;
            const int g = r >> 3; t.W = w_pool + (size_t)g * 16384; t.WT = WpT + (size_t)g * 16384; t.K = 128; t.N = 128; t.item = r & 7; t.permn = false; return t; };
        const int kq = tid >> 2, cq = tid & 3, cgp0 = bx < 256 ? bx : 0;
        float cv[16], wv[8][3], tv[32]; const int it0 = gw; const TrItem ti0 = mk_item(it0 < I_ALL ? it0 : 0);
#pragma unroll
        for (int i = 0; i < 16; ++i) cv[i] = c[tid + i * 512];
#pragma unroll
        for (int kk = 0; kk < 8; ++kk) { const float* wr = w_ada + (size_t)(kq * 8 + kk) * DIN + cgp0 * 12 + cq * 3; wv[kk][0] = wr[0]; wv[kk][1] = wr[1]; wv[kk][2] = wr[2]; }
        const float bias0 = (tid < 96) ? b_ada[cgp0 * 12 + tid % 12] : 0.f;
        if (it0 < I_ALL) tr_load(ti0, tv, lane);
#pragma unroll
        for (int i = 0; i < 16; ++i) { const float v = cv[i]; cact[tid + i * 512] = v / (1.0f + __expf(-v)); }
        __syncthreads();
        for (int cgp = bx; cgp < 256; cgp += G) {
            float a[8][3];
#pragma unroll
            for (int b = 0; b < 8; ++b) { a[b][0] = 0.f; a[b][1] = 0.f; a[b][2] = 0.f; }
            if (cgp != cgp0) {
#pragma unroll
                for (int kk = 0; kk < 8; ++kk) { const float* wr = w_ada + (size_t)(kq * 8 + kk) * DIN + cgp * 12 + cq * 3; wv[kk][0] = wr[0]; wv[kk][1] = wr[1]; wv[kk][2] = wr[2]; } }
#pragma unroll
            for (int kk = 0; kk < 8; ++kk) { const int k = kq * 8 + kk;
#pragma unroll
                for (int b = 0; b < 8; ++b) { const float ca = cact[b * DM + k]; a[b][0] += ca * wv[kk][0]; a[b][1] += ca * wv[kk][1]; a[b][2] += ca * wv[kk][2]; } }
            float v24[24];
#pragma unroll
            for (int b = 0; b < 8; ++b)
#pragma unroll
                for (int j = 0; j < 3; ++j) v24[b * 3 + j] = a[b][j];
#pragma unroll
            for (int i = 0; i < 12; ++i) { const bool up = (lane & 32) != 0; const float keep = up ? v24[i + 12] : v24[i], give = up ? v24[i] : v24[i + 12]; v24[i] = keep + __shfl_xor(give, 32); }
#pragma unroll
            for (int i = 0; i < 6; ++i) { const bool up = (lane & 16) != 0; const float keep = up ? v24[i + 6] : v24[i], give = up ? v24[i] : v24[i + 6]; v24[i] = keep + __shfl_xor(give, 16); }
#pragma unroll
            for (int i = 0; i < 3; ++i) { const bool up = (lane & 8) != 0; const float keep = up ? v24[i + 3] : v24[i], give = up ? v24[i] : v24[i + 3]; v24[i] = keep + __shfl_xor(give, 8); }
#pragma unroll
            for (int i = 0; i < 3; ++i) { v24[i] += __shfl_xor(v24[i], 4);
                const int idx = 12 * ((lane >> 5) & 1) + 6 * ((lane >> 4) & 1) + 3 * ((lane >> 3) & 1) + i;
                if ((lane & 4) == 0) red[wave * 96 + (idx / 3) * 12 + cq * 3 + (idx % 3)] = v24[i]; }
            __syncthreads();
            if (tid < 96) { float s = 0.f;
#pragma unroll
                for (int w = 0; w < 8; ++w) s += red[w * 96 + tid];
                const int b = tid / 12, n = cgp * 12 + tid % 12; mod[b * DIN + n] = s + (cgp == cgp0 ? bias0 : b_ada[n]); }
            __syncthreads();
        }
        if (it0 < I_ALL) tr_finish(ti0, tv, scr, lane);
        for (int it = gw + NGW; it < I_ALL; it += NGW) { float tv[32]; const TrItem ti = mk_item(it); tr_load(ti, tv, lane); tr_finish(ti, tv, scr, lane); }
        __syncthreads(); }
        if (BOTH(0)) GRID_BAR();
        STAMP(1);
    }
    if (IN(1) && fuse01) {
#pragma unroll
        for (int q = 0; q < 8; ++q) { float t = 0.f;
#pragma unroll
            for (int j = 0; j < 4; ++j) t += (xr_[q][j].x * xr_[q][j].x + xr_[q][j].y * xr_[q][j].y) + (xr_[q][j].z * xr_[q][j].z + xr_[q][j].w * xr_[q][j].w);
            xs_[q] = t; }
#pragma unroll
        for (int q = 0; q < 8; ++q) { const int m = gw + q * NGW;
            const float* mb = mod + (size_t)(m >> 11) * DIN;
            const float inv = 1.0f / sqrtf(wave_sum(xs_[q]) * (1.0f / DM) + 1e-6f);
            GAS unsigned long long* o8 = (GAS unsigned long long*)(XN + (size_t)m * DM) + lane;
#pragma unroll
            for (int j = 0; j < 4; ++j) { const int k = 4 * lane + 256 * j;
                const f32x4 gg = *(const f32x4*)(norm_g + k), sh = *(const f32x4*)(mb + k), sc = *(const f32x4*)(mb + DM + k);
                const f32x4 y = xr_[q][j] * inv * gg * (sc + 1.0f) + sh;
                o8[64 * j] = (unsigned long long)pk2(y.x, y.y) | ((unsigned long long)pk2(y.z, y.w) << 32); } }
        if (BOTH(1)) GRID_BAR();
        STAMP(2);
    } else
    if (IN(1)) { for (int rep_ = 0; rep_ < MK_REP1; ++rep_) {
        if (pseamA) {
            const int mb0 = 256 * u2.pm + 64 * u2.pn + 8 * wave; const float* mb = mod + (size_t)(mb0 >> 11) * DIN;
            f32x4 v[8][4], ga[4], sh4[4];
#pragma unroll
            for (int q = 0; q < 8; ++q) { const GAS f32x4* xr = (const GAS f32x4*)(x + (size_t)(mb0 + q) * DM) + lane;
#pragma unroll
                for (int j = 0; j < 4; ++j) v[q][j] = xr[64 * j]; }
#pragma unroll
            for (int j = 0; j < 4; ++j) { const int k = 4 * lane + 256 * j; ga[j] = *(const f32x4*)(norm_g + k) * (*(const f32x4*)(mb + DM + k) + 1.0f); sh4[j] = *(const f32x4*)(mb + k); }
#pragma unroll
            for (int q = 0; q < 8; ++q) { float t = 0.f;
#pragma unroll
                for (int j = 0; j < 4; ++j) t += (v[q][j].x * v[q][j].x + v[q][j].y * v[q][j].y) + (v[q][j].z * v[q][j].z + v[q][j].w * v[q][j].w);
                const float inv = 1.0f / sqrtf(wave_sum(t) * (1.0f / DM) + 1e-6f);
                GAS unsigned long long* o8 = (GAS unsigned long long*)(XN + (size_t)(mb0 + q) * DM) + lane;
#pragma unroll
                for (int j = 0; j < 4; ++j) { const f32x4 y = v[q][j] * inv * ga[j] + sh4[j];
                    __hip_atomic_store(o8 + 64 * j, (unsigned long long)pk2(y.x, y.y) | ((unsigned long long)pk2(y.z, y.w) << 32), __ATOMIC_RELAXED, __HIP_MEMORY_SCOPE_AGENT); } }
        }
        const int mfirst = pseamA ? M : gw, mstep = NGW, mend = M;
        for (int m0 = mfirst; m0 < mend; m0 += 4 * mstep) {
            f32x4 v[4][4]; float s[4];
#pragma unroll
            for (int q = 0; q < 4; ++q) { const int m = m0 + q * mstep; const GAS f32x4* xr = (const GAS f32x4*)(x + (size_t)(m < M ? m : m0) * DM) + lane;
#pragma unroll
                for (int j = 0; j < 4; ++j) v[q][j] = xr[64 * j]; }
#pragma unroll
            for (int q = 0; q < 4; ++q) { float t = 0.f;
#pragma unroll
                for (int j = 0; j < 4; ++j) t += (v[q][j].x * v[q][j].x + v[q][j].y * v[q][j].y) + (v[q][j].z * v[q][j].z + v[q][j].w * v[q][j].w);
                s[q] = t; }
#pragma unroll
            for (int q = 0; q < 4; ++q) { const int m = m0 + q * mstep; if (m >= M) break;
                const float* mb = mod + (size_t)(m >> 11) * DIN;
                const float inv = 1.0f / sqrtf(wave_sum(s[q]) * (1.0f / DM) + 1e-6f);
                GAS unsigned long long* o8 = (GAS unsigned long long*)(XN + (size_t)m * DM) + lane;
#pragma unroll
                for (int j = 0; j < 4; ++j) { const int k = 4 * lane + 256 * j;
                    const f32x4 gg = *(const f32x4*)(norm_g + k), sh = *(const f32x4*)(mb + k), sc = *(const f32x4*)(mb + DM + k);
                    const f32x4 y = v[q][j] * inv * gg * (sc + 1.0f) + sh;
                    const unsigned long long pk8 = (unsigned long long)pk2(y.x, y.y) | ((unsigned long long)pk2(y.z, y.w) << 32);
                    if (pseamA) __hip_atomic_store(o8 + 64 * j, pk8, __ATOMIC_RELAXED, __HIP_MEMORY_SCOPE_AGENT); else o8[64 * j] = pk8; } }
        }
        }
        if (pseamA) {
            asm volatile("s_waitcnt vmcnt(0)" ::: "memory");
            __syncthreads();
            if (tid == 0) { unsigned* cnt = ctl + CW_SEAM_A + 64 * u2.pm;
                __hip_atomic_fetch_add(cnt, 1u, __ATOMIC_RELAXED, __HIP_MEMORY_SCOPE_AGENT);
                while (__hip_atomic_load(cnt, __ATOMIC_RELAXED, __HIP_MEMORY_SCOPE_AGENT) < 4u) __builtin_amdgcn_s_sleep(1);
                __builtin_amdgcn_fence(__ATOMIC_ACQUIRE, "agent"); asm volatile("s_waitcnt vmcnt(0)" ::: "memory"); }
            __syncthreads();
        } else if (BOTH(1)) GRID_BAR();
        STAMP(2);
    }
    if (IN(2)) { for (int rep_ = 0; rep_ < MK_REP2; ++rep_) {
        pg8::Gemm g{XN, Win_t, M, DIN, DM}; pg8::StaticOrder S; S.init(M, DIN, G, bx);
        pg8::EpiInProj E{__builtin_amdgcn_make_buffer_rsrc(ws + WS_PROJ, 0, (int)(6 * PROJ_STRIDE * 2), 0x00020000), PROJ_STRIDE, qg, kg};
        pg8::gemm_phase<pg8::EpiInProj, pg8::StaticOrder, true, true>(L, g, S, E);
#if MK_STAMP == 22 || MK_STAMP == 23
        tk2_ = *(volatile LAS unsigned long long*)(L + 147392); tk2e_ = __builtin_amdgcn_s_memrealtime();
#endif
        }
        if (pseamB) {
            __syncthreads();
            if (tid == 0) { unsigned* cnt = ctl + 6144 + 64 * (bx & 7);
                __hip_atomic_fetch_add(cnt, 1u, __ATOMIC_RELAXED, __HIP_MEMORY_SCOPE_AGENT);
                while (__hip_atomic_load(cnt, __ATOMIC_RELAXED, __HIP_MEMORY_SCOPE_AGENT) < 32u) __builtin_amdgcn_s_sleep(1);
                __builtin_amdgcn_fence(__ATOMIC_ACQUIRE, "agent"); asm volatile("s_waitcnt vmcnt(0)" ::: "memory"); }
            __syncthreads();
        } else if (BOTH(2)) GRID_BAR();
        STAMP(3);
    }
    if (IN(3)) { for (int rep_ = 0; rep_ < MK_REP3; ++rep_) {
        const bf16* Qb = PROJ; const bf16* Kb = PROJ + PROJ_STRIDE; const bf16* Vb = PROJ + 2 * PROJ_STRIDE; const bf16* GAb = PROJ + 3 * PROJ_STRIDE;
        const bf16* Ub = PROJ + 4 * PROJ_STRIDE; const bf16* GPb = PROJ + 5 * PROJ_STRIDE;
        for (int i = vcu; i < 256; i += G) {
            const int bh = i >> 2, qq = i & 3;
            if (i & 1) { pool::pool_unit(i >> 2, i & 3, Ub, GPb, WpT, b_pool, pool_scale, CAT, (LAS char*)L); PANEL_ARRIVE(i >> 2); }
            SUBSTAMP(0);
            att::attn_pass<MK_EARLY>(bh >> 3, bh & 7, 16 * qq + 8, Qb, Kb, Vb, GAb, CAT, (LAS char*)L);
            PANEL_ARRIVE((bh >> 3) * 8 + 2 * qq + 1);
            SUBSTAMP(1);
            att::attn_pass<MK_EARLY>(bh >> 3, bh & 7, 16 * qq, Qb, Kb, Vb, GAb, CAT, (LAS char*)L);
            PANEL_ARRIVE((bh >> 3) * 8 + 2 * qq);
            VM_WAIT(); __syncthreads();
            SUBSTAMP(2);
            if (!(i & 1)) { pool::pool_unit(i >> 2, i & 3, Ub, GPb, WpT, b_pool, pool_scale, CAT, (LAS char*)L); PANEL_ARRIVE(i >> 2); }
            VM_WAIT(); SUBSTAMP(3);
        }
        }
        if (!pseamB && BOTH(3)) GRID_BAR();
        STAMP(4);
    }
    if (IN(4)) { for (int rep_ = 0; rep_ < MK_REP4; ++rep_) {
        pg8::Gemm g{CAT, Wout_t, M, DM, DM}; pg8::StaticOrder S; S.init(M, DM, G, bx);
        if (pseamB) { pg8::Unit u4; S.next(0, u4);
            if (tid == 0) { unsigned* cnt = ctl + CW_SEAM_B + 64 * u4.pm;
                while (__hip_atomic_load(cnt, __ATOMIC_RELAXED, __HIP_MEMORY_SCOPE_AGENT) < 12u) __builtin_amdgcn_s_sleep(1);
                __builtin_amdgcn_fence(__ATOMIC_ACQUIRE, "agent"); asm volatile("s_waitcnt vmcnt(0)" ::: "memory"); }
            __syncthreads(); }
        pg8::EpiOutRes E{x, args.out, mod + 2 * DM};
        pg8::gemm_phase<pg8::EpiOutRes, pg8::StaticOrder, true, true>(L, g, S, E);
    } }
#if MK_STAMP >= 0
    GRID_BAR(); STAMP(5);
#if MK_STAMP == 22 || MK_STAMP == 23
    if (bx == 0 && tid == 0) args.out[0] += (MK_STAMP == 22) ? (float)(tk2e_ - tk2_) * 0.01f : (float)(ts_[3] - tk2e_) * 0.01f;
    if (false)
#endif
#if MK_STAMP == 20 || MK_STAMP == 21
    if (bx == 0 && tid == 0) { const unsigned long long tk = *(volatile LAS unsigned long long*)(L + 147392);
        args.out[0] += (MK_STAMP == 20) ? (float)(tk - ts_[4]) * 0.01f : (float)(ts_[5] - tk) * 0.01f; }
    if (false)
#endif
    if (bx == 0 && tid == 0) { const float T = (MK_STAMP >= 10) ? (float)((MK_STAMP == 13 ? ts_[4] : tsub_[(MK_STAMP - 9) & 3]) - tsub_[(MK_STAMP - 10) & 3]) * 0.01f : (float)(ts_[(MK_STAMP + 1) & 7] - ts_[MK_STAMP & 7]) * 0.01f; args.out[0] += (MK_STAMP == 5 ? (float)(ts_[5] - ts_[0]) * 0.01f : T); }
#endif
#undef IN
#undef BOTH
}

extern "C" void kernel_launch(void* const* d_in, const int* in_sizes, int n_in, void* d_out, int out_size, void* d_ws, size_t ws_size, hipStream_t stream) {
    static int grid = 0;
    if (grid == 0) {
        if (n_in != 12 || out_size != M * DM || ws_size < WS_END) { fprintf(stderr, "kernel_launch: unexpected shapes (n_in %d out %d ws %zu)\n", n_in, out_size, ws_size); grid = -1; return; }
        int dev = 0, cus = 0, per_cu = 0;
        if (hipGetDevice(&dev) != hipSuccess || hipDeviceGetAttribute(&cus, hipDeviceAttributeMultiprocessorCount, dev) != hipSuccess) { grid = -1; return; }
        if (hipFuncSetAttribute((const void*)hybrid_fwd, hipFuncAttributeMaxDynamicSharedMemorySize, LDS_BYTES) != hipSuccess) { fprintf(stderr, "kernel_launch: hipFuncSetAttribute failed\n"); grid = -1; return; }
        if (hipOccupancyMaxActiveBlocksPerMultiprocessor(&per_cu, (const void*)hybrid_fwd, NWAVES * 64, LDS_BYTES) != hipSuccess || per_cu < 1) { fprintf(stderr, "kernel_launch: occupancy query says %d\n", per_cu); per_cu = 1; }
        (void)hipGetLastError();
        grid = cus;
    }
    if (grid < 0) return;
#if MK_COOP
    if (hipMemsetAsync((char*)d_ws + WS_CTL, 0, CTL_ZERO_BYTES, stream) != hipSuccess) { fprintf(stderr, "kernel_launch: hipMemsetAsync failed\n"); return; }
#endif
    Args a{};
    for (int i = 0; i < 12; ++i) a.in[i] = (const float*)d_in[i];
    a.out = (float*)d_out; a.ws = (unsigned char*)d_ws;
#if MK_COOP
    a.ph_lo = 0; a.ph_hi = N_PHASES; a.coop = 1;
    void* kargs[] = {&a};
    hipError_t e = hipLaunchCooperativeKernel((const void*)hybrid_fwd, dim3(grid), dim3(NWAVES * 64), kargs, LDS_BYTES, stream);
    if (e != hipSuccess) fprintf(stderr, "kernel_launch: cooperative launch failed: %s (grid %d)\n", hipGetErrorString(e), grid);
#else
    for (int p = 0; p < N_PHASES; ++p) { a.ph_lo = p; a.ph_hi = p + 1; a.coop = 0;
        hipLaunchKernelGGL(hybrid_fwd, dim3(grid), dim3(NWAVES * 64), LDS_BYTES, stream, a); }
#endif
}
```

```cpp
#include <hip/hip_runtime.h>
#include <hip/hip_cooperative_groups.h>
#include <cstdio>
#include <cstdint>
namespace cg = cooperative_groups;
#ifndef MK_COOP
#define MK_COOP 1
#endif
#ifndef MK_EARLY
#define MK_EARLY true
#endif
#define PG8_SP2 true
#define PG8_ALIGN true
#ifndef MK_REP0
#define MK_REP0 1
#endif
#ifndef MK_REP1
#define MK_REP1 1
#endif
#ifndef MK_REP2
#define MK_REP2 1
#endif
#ifndef MK_REP3
#define MK_REP3 1
#endif
#ifndef MK_REP4
#define MK_REP4 1
#endif
#ifndef MK_REP3A
#define MK_REP3A 1
#endif
#ifndef MK_REP3P
#define MK_REP3P 1
#endif
#ifndef MK_STAMP
#define MK_STAMP -1
#endif
namespace pg8 {
#define PG8_LAS __attribute__((address_space(3)))
typedef unsigned short bf16_t;
typedef short bf16x8 __attribute__((ext_vector_type(8)));
typedef float f32x4 __attribute__((ext_vector_type(4)));
typedef unsigned u32x4 __attribute__((ext_vector_type(4)));
constexpr int BM = 256, BK = 64, HALF = 128, HTB = HALF * BK * 2  , STAGE_BYTES = 8 * HTB, NXCD = 8, WGM = 8;

__host__ __device__ __forceinline__ int lds_byte(int r, int c) { const int st = (r >> 4) * 2 + (c >> 5), rr = r & 15, cc = c & 31, ob = rr * 64 + cc * 2; return st * 1024 + (ob ^ (((ob >> 9) & 1) << 5)); }
__host__ __device__ __forceinline__ void stage_rc(int b, int& R, int& C) { const int st = b / 1024, sb = b % 1024, swz = sb ^ (((sb >> 9) & 1) << 5); R = (st >> 1) * 16 + swz / 64; C = (st & 1) * 32 + (swz % 64) / 2; }
__host__ __device__ __forceinline__ int perm32(int rho) { const int n = rho >> 4, i = rho & 15; return 8 * (i >> 2) + 4 * n + (i & 3); }

struct Unit { int pm, pn; };
struct Gemm { const bf16_t* A; const bf16_t* Bt; int M, N, K; };

struct StaticOrder {
    int nM, nN, nwg, G, c;
    __host__ __device__ void init(int M, int N, int G_, int c_) { nM = M / BM; nN = N / BM; nwg = nM * nN; G = G_; c = c_; }
    __host__ __device__ bool next(int i, Unit& u) const {
        const long L = (long)i * G + c; if (L >= nwg) return false;
        int wgid = (int)L; { const int q = nwg / NXCD, r = nwg % NXCD, xcd = wgid % NXCD, off = wgid / NXCD; wgid = (xcd < r ? xcd * (q + 1) : r * (q + 1) + (xcd - r) * q) + off; }
        const int nig = WGM * nN, gid = wgid / nig, fm = gid * WGM, gsz = (nM - fm) < WGM ? (nM - fm) : WGM;
        u.pm = fm + ((wgid % nig) % gsz); u.pn = (wgid % nig) / gsz; return true;
    }
    __device__ __forceinline__ void a_ready(const Unit&) const {}
    __device__ __forceinline__ void done(const Unit&) const {}
};
__device__ __forceinline__ unsigned cvt_pk_bf16(float lo, float hi) { unsigned r; asm volatile("v_cvt_pk_bf16_f32 %0, %1, %2" : "=v"(r) : "v"(lo), "v"(hi)); return r; }
typedef float f32x2 __attribute__((ext_vector_type(2)));
__device__ __forceinline__ float silu_f(float v) { return v * __builtin_amdgcn_rcpf(1.0f + __builtin_amdgcn_exp2f(-1.4426950408889634f * v)); }
constexpr float QSCALE = 0.125f * 1.4426950408889634f;
__device__ __forceinline__ size_t hm_off(int row, int head) { return ((size_t)((row >> 11) * 8 + head) * 2048 + (row & 2047)) * 64; }
struct EpiInProj {
    static constexpr bool PERM = true, AFTER_DRAIN = false;
    __amdgpu_buffer_rsrc_t rs; size_t stride; const float* gq; const float* gk;
    __device__ __forceinline__ void operator()(const f32x4 (&acc)[2][2][4][2], const Unit& u, int wr, int wc, int fr, int fq) const {
        const int type = u.pn >> 1;
        const size_t O = (size_t)type * stride;
        const int row0 = u.pm * BM + wr * 64 + fr;
        const int col0 = (u.pn & 1) * 256 + wc * 64 + 8 * fq;
        if (type < 2) {
            const float* g = type == 0 ? gq : gk; const float s = type == 0 ? QSCALE : 1.0f;
            f32x4 gs[2][2];
#pragma unroll
            for (int bj = 0; bj < 2; ++bj)
#pragma unroll
                for (int n = 0; n < 2; ++n) gs[bj][n] = *(const f32x4*)(g + 32 * bj + 8 * fq + 4 * n) * s;
#pragma unroll
            for (int ai = 0; ai < 2; ++ai)
#pragma unroll
                for (int m = 0; m < 4; ++m) {
                    float ss = 0.f;
#pragma unroll
                    for (int bj = 0; bj < 2; ++bj)
#pragma unroll
                        for (int n = 0; n < 2; ++n) { const f32x4 x = acc[ai][bj][m][n]; ss += (x[0] * x[0] + x[1] * x[1]) + (x[2] * x[2] + x[3] * x[3]); }
                    ss += __shfl_xor(ss, 16); ss += __shfl_xor(ss, 32);
                    const float inv = 1.0f / sqrtf(ss * (1.0f / 64.0f) + 1e-6f);
                    const size_t rowp = O + hm_off(row0 + ai * HALF + m * 16, (u.pn & 1) * 4 + wc) + 8 * fq;
#pragma unroll
                    for (int bj = 0; bj < 2; ++bj) { const f32x4 v0 = acc[ai][bj][m][0] * inv * gs[bj][0], v1 = acc[ai][bj][m][1] * inv * gs[bj][1];
                        u32x4 w; w.x = cvt_pk_bf16(v0[0], v0[1]); w.y = cvt_pk_bf16(v0[2], v0[3]); w.z = cvt_pk_bf16(v1[0], v1[1]); w.w = cvt_pk_bf16(v1[2], v1[3]);
                        __builtin_amdgcn_raw_buffer_store_b128(w, rs, (unsigned)((rowp + bj * 32) * 2), 0, 16); }
                }
        } else {
            const bool act = (type == 3) || (type == 5);
#pragma unroll
            for (int ai = 0; ai < 2; ++ai)
#pragma unroll
                for (int m = 0; m < 4; ++m) {
                    const int row = row0 + ai * HALF + m * 16;
                    const size_t rowp = (type <= 3) ? O + hm_off(row, (u.pn & 1) * 4 + wc) + 8 * fq : O + ((size_t)((u.pn & 1) * 2 + (wc >> 1)) * 16384 + row) * 128 + (wc & 1) * 64 + 8 * fq;
#pragma unroll
                    for (int bj = 0; bj < 2; ++bj) { f32x4 v0 = acc[ai][bj][m][0], v1 = acc[ai][bj][m][1];
                        if (act) { v0 = (f32x4){silu_f(v0[0]), silu_f(v0[1]), silu_f(v0[2]), silu_f(v0[3])}; v1 = (f32x4){silu_f(v1[0]), silu_f(v1[1]), silu_f(v1[2]), silu_f(v1[3])}; }
                        u32x4 w; w.x = cvt_pk_bf16(v0[0], v0[1]); w.y = cvt_pk_bf16(v0[2], v0[3]); w.z = cvt_pk_bf16(v1[0], v1[1]); w.w = cvt_pk_bf16(v1[2], v1[3]);
                        __builtin_amdgcn_raw_buffer_store_b128(w, rs, (unsigned)((rowp + bj * 32) * 2), 0, 16); }
                }
        }
    }
};
struct EpiOutRes {
    static constexpr bool PERM = false, AFTER_DRAIN = false;
    const float* x; float* out; const float* gate;
    __device__ __forceinline__ void operator()(const f32x4 (&acc)[2][2][4][2], const Unit& u, int wr, int wc, int fr, int fq) const {
        const int col0 = u.pn * BM + wc * 32 + 4 * fq;
        const float* gp = gate + (size_t)((u.pm * BM) >> 11) * 3072 + col0;
        f32x4 gv[2][2];
#pragma unroll
        for (int bj = 0; bj < 2; ++bj)
#pragma unroll
            for (int n = 0; n < 2; ++n) gv[bj][n] = *(const f32x4*)(gp + bj * HALF + n * 16);
#pragma unroll
        for (int ai = 0; ai < 2; ++ai) {
            f32x4 xv[4][2][2];
#pragma unroll
            for (int m = 0; m < 4; ++m) { const size_t off = (size_t)(u.pm * BM + ai * HALF + wr * 64 + m * 16 + fr) * 1024 + col0;
#pragma unroll
                for (int bj = 0; bj < 2; ++bj)
#pragma unroll
                    for (int n = 0; n < 2; ++n) xv[m][bj][n] = *(const f32x4*)(x + off + bj * HALF + n * 16); }
            asm volatile("" ::: "memory");
#pragma unroll
            for (int m = 0; m < 4; ++m) { const size_t off = (size_t)(u.pm * BM + ai * HALF + wr * 64 + m * 16 + fr) * 1024 + col0;
#pragma unroll
                for (int bj = 0; bj < 2; ++bj)
#pragma unroll
                    for (int n = 0; n < 2; ++n) *(f32x4*)(out + off + bj * HALF + n * 16) = xv[m][bj][n] + gv[bj][n] * acc[ai][bj][m][n]; }
        }
    }
};
template <class Epi, class Sched, bool ALIGN_EPI = false, bool SP2 = false>
__device__ __forceinline__ void gemm_phase(PG8_LAS unsigned char* lds, const Gemm g, const Sched& S, const Epi& E) {
    const int tid = threadIdx.x, wid = __builtin_amdgcn_readfirstlane(tid >> 6), lane = tid & 63, wr = wid >> 2, wc = wid & 3, fr = lane & 15, fq = lane >> 4;
    const int K = g.K, nt = K / BK;
    unsigned voffA[2], voffB[2];
#pragma unroll
    for (int i = 0; i < 2; ++i) { int R, C; stage_rc(tid * 16 + i * 8192, R, C); const int Rb = Epi::PERM ? ((R & ~31) + perm32(R & 31)) : R;
        voffA[i] = (unsigned)(R * K + C) * 2u; voffB[i] = (unsigned)(Rb * K + C) * 2u; }
    const size_t kstep = (size_t)(BK * 2);
    const size_t hstep = (size_t)HALF * K * 2;
    const size_t tstep = 2 * hstep;
    const unsigned ldsw = (unsigned)wid * 1024u;
    const int aoff = lds_byte(wr * 64 + fr, fq * 8), boff = lds_byte(wc * 32 + fr, fq * 8);
#define PG8_SA(b, h) (((b) * 2 + (h)) * HTB)
#define PG8_SB(b, h) ((4 + (b) * 2 + (h)) * HTB)
#define PG8_STAGE(bufoff, gbase, voff) do { _Pragma("unroll") for (int _i = 0; _i < 2; ++_i) \
        __builtin_amdgcn_global_load_lds((const unsigned*)((const char*)(gbase) + (voff)[_i]), (PG8_LAS unsigned*)(lds + (bufoff) + ldsw + _i * 8192), 16, 0, 0); } while (0)
#define PG8_LDA(dst, b, h) do { _Pragma("unroll") for (int m = 0; m < 4; ++m) _Pragma("unroll") for (int k = 0; k < 2; ++k) dst[m][k] = *(const PG8_LAS bf16x8*)(lds + PG8_SA(b, h) + aoff + m * 2048 + k * 1024); } while (0)
#define PG8_LDB(dst, b, h) do { _Pragma("unroll") for (int n = 0; n < 2; ++n) _Pragma("unroll") for (int k = 0; k < 2; ++k) dst[n][k] = *(const PG8_LAS bf16x8*)(lds + PG8_SB(b, h) + boff + n * 2048 + k * 1024); } while (0)
#define PG8_MMA(ai, bj, At, Bt) do { __builtin_amdgcn_s_setprio(1); _Pragma("unroll") for (int m = 0; m < 4; ++m) _Pragma("unroll") for (int n = 0; n < 2; ++n) _Pragma("unroll") for (int k = 0; k < 2; ++k) \
        acc[ai][bj][m][n] = __builtin_amdgcn_mfma_f32_16x16x32_bf16(Bt[n][k], At[m][k], acc[ai][bj][m][n], 0, 0, 0); __builtin_amdgcn_s_setprio(0); } while (0)
#define PG8_WAIT_V(n) asm volatile("s_waitcnt vmcnt(" #n ")" ::: "memory")
#define PG8_WAIT_L(n) asm volatile("s_waitcnt lgkmcnt(" #n ")" ::: "memory")
#define PG8_BAR __builtin_amdgcn_s_barrier()
#define PG8_SCHED __builtin_amdgcn_sched_barrier(0)
    Unit cur, nxt; int ui = 0;
    if (!S.next(0, cur)) return;
    f32x4 acc[2][2][4][2];
#pragma unroll
    for (int a = 0; a < 2; ++a)
#pragma unroll
        for (int b = 0; b < 2; ++b)
#pragma unroll
            for (int m = 0; m < 4; ++m)
#pragma unroll
                for (int n = 0; n < 2; ++n) acc[a][b][m][n] = (f32x4){0.f, 0.f, 0.f, 0.f};
    bf16x8 At[4][2], B0[2][2], B1[2][2];
    const char* cA = (const char*)g.A + (size_t)cur.pm * tstep; const char* cB = (const char*)g.Bt + (size_t)cur.pn * tstep;
    S.a_ready(cur);
    if constexpr (SP2) {
        PG8_STAGE(PG8_SB(0, 0), cB, voffB); PG8_STAGE(PG8_SB(0, 1), cB + hstep, voffB); PG8_STAGE(PG8_SA(0, 0), cA, voffA); PG8_STAGE(PG8_SA(0, 1), cA + hstep, voffA);
        if (wr == 1) PG8_BAR;
        PG8_WAIT_V(2); PG8_BAR;
        PG8_STAGE(PG8_SB(1, 0), cB + kstep, voffB); PG8_STAGE(PG8_SA(1, 0), cA + kstep, voffA); PG8_STAGE(PG8_SB(1, 1), cB + hstep + kstep, voffB);
        PG8_WAIT_V(6); PG8_BAR;
    } else {
        PG8_STAGE(PG8_SB(0, 0), cB, voffB); PG8_STAGE(PG8_SA(0, 0), cA, voffA); PG8_STAGE(PG8_SB(0, 1), cB + hstep, voffB); PG8_STAGE(PG8_SA(0, 1), cA + hstep, voffA);
        if (wr == 1) PG8_BAR;
        PG8_WAIT_V(4); PG8_BAR;
        PG8_STAGE(PG8_SB(1, 0), cB + kstep, voffB); PG8_STAGE(PG8_SA(1, 0), cA + kstep, voffA); PG8_STAGE(PG8_SB(1, 1), cB + hstep + kstep, voffB);
        PG8_WAIT_V(6); PG8_BAR;
    }
    for (;;) {
        const bool has_next = S.next(ui + 1, nxt);
        const char* nA = has_next ? (const char*)g.A + (size_t)nxt.pm * tstep : cA; const char* nB = has_next ? (const char*)g.Bt + (size_t)nxt.pn * tstep : cB;
        for (int t = 0; t < nt; t += 2) {
            const bool last = (t == nt - 2);
            const char* a1 = cA + (size_t)(t + 1) * kstep;
            const char* a2 = last ? nA : cA + (size_t)(t + 2) * kstep; const char* b2 = last ? nB : cB + (size_t)(t + 2) * kstep;
            const char* a3 = a2 + kstep; const char* b3 = b2 + kstep;
            if (last && has_next) S.a_ready(nxt);
            if constexpr (SP2) {
            PG8_LDB(B0, 0, 0); PG8_LDB(B1, 0, 1); PG8_SCHED; PG8_LDA(At, 0, 0); PG8_STAGE(PG8_SA(1, 1), a1 + hstep, voffA);
            PG8_WAIT_V(8); PG8_WAIT_L(0); PG8_BAR; PG8_MMA(0, 0, At, B0); PG8_MMA(0, 1, At, B1); PG8_BAR; PG8_SCHED;
            PG8_LDA(At, 0, 1); PG8_STAGE(PG8_SB(0, 0), b2, voffB); PG8_STAGE(PG8_SB(0, 1), b2 + hstep, voffB); PG8_STAGE(PG8_SA(0, 0), a2, voffA);
            PG8_WAIT_V(8); PG8_WAIT_L(0); PG8_BAR; PG8_MMA(1, 0, At, B0); PG8_MMA(1, 1, At, B1); PG8_BAR; PG8_SCHED;
            PG8_LDB(B0, 1, 0); PG8_LDB(B1, 1, 1); PG8_SCHED; PG8_LDA(At, 1, 0); PG8_STAGE(PG8_SA(0, 1), a2 + hstep, voffA);
            PG8_WAIT_V(8); PG8_WAIT_L(0); PG8_BAR; PG8_MMA(0, 0, At, B0); PG8_MMA(0, 1, At, B1); PG8_BAR; PG8_SCHED;
            PG8_LDA(At, 1, 1); PG8_STAGE(PG8_SB(1, 0), b3, voffB); PG8_STAGE(PG8_SB(1, 1), b3 + hstep, voffB); PG8_STAGE(PG8_SA(1, 0), a3, voffA);
            PG8_WAIT_V(8); PG8_WAIT_L(0); PG8_BAR; PG8_MMA(1, 0, At, B0); PG8_MMA(1, 1, At, B1); PG8_BAR; PG8_SCHED;
            } else {
            PG8_LDB(B0, 0, 0); PG8_SCHED; PG8_LDA(At, 0, 0); PG8_STAGE(PG8_SA(1, 1), a1 + hstep, voffA);
            PG8_WAIT_L(8); PG8_BAR; PG8_WAIT_L(0); PG8_MMA(0, 0, At, B0); PG8_BAR; PG8_SCHED;
            PG8_LDB(B1, 0, 1); PG8_STAGE(PG8_SB(0, 0), b2, voffB);
            PG8_BAR; PG8_WAIT_L(0); PG8_MMA(0, 1, At, B1); PG8_BAR;
            PG8_LDA(At, 0, 1); PG8_STAGE(PG8_SA(0, 0), a2, voffA);
            PG8_BAR; PG8_WAIT_L(0); PG8_MMA(1, 0, At, B0); PG8_BAR; PG8_SCHED;
            PG8_STAGE(PG8_SB(0, 1), b2 + hstep, voffB);
            PG8_WAIT_V(6); PG8_BAR; PG8_MMA(1, 1, At, B1); PG8_BAR;
            PG8_LDB(B0, 1, 0); PG8_SCHED; PG8_LDA(At, 1, 0); PG8_STAGE(PG8_SA(0, 1), a2 + hstep, voffA);
            PG8_WAIT_L(8); PG8_BAR; PG8_WAIT_L(0); PG8_MMA(0, 0, At, B0); PG8_BAR; PG8_SCHED;
            PG8_LDB(B1, 1, 1); PG8_STAGE(PG8_SB(1, 0), b3, voffB);
            PG8_BAR; PG8_WAIT_L(0); PG8_MMA(0, 1, At, B1); PG8_BAR;
            PG8_LDA(At, 1, 1); PG8_STAGE(PG8_SA(1, 0), a3, voffA);
            PG8_BAR; PG8_WAIT_L(0); PG8_MMA(1, 0, At, B0); PG8_BAR; PG8_SCHED;
            PG8_STAGE(PG8_SB(1, 1), b3 + hstep, voffB);
            PG8_WAIT_V(6); PG8_BAR; PG8_MMA(1, 1, At, B1); PG8_BAR;
            }
        }
        if constexpr (ALIGN_EPI) { if (wr == 0) PG8_BAR; }
#if MK_STAMP == 20 || MK_STAMP == 21 || MK_STAMP == 22 || MK_STAMP == 23
        if (threadIdx.x == 0) *(volatile PG8_LAS unsigned long long*)(lds + 147392) = __builtin_amdgcn_s_memrealtime();
#endif
        if constexpr (!Epi::AFTER_DRAIN) { E(acc, cur, wr, wc, fr, fq); S.done(cur); }
        if (!has_next) break;
#pragma unroll
        for (int a = 0; a < 2; ++a)
#pragma unroll
            for (int b = 0; b < 2; ++b)
#pragma unroll
                for (int m = 0; m < 4; ++m)
#pragma unroll
                    for (int n = 0; n < 2; ++n) acc[a][b][m][n] = (f32x4){0.f, 0.f, 0.f, 0.f};
        cur = nxt; cA = nA; cB = nB; ++ui;
        if constexpr (ALIGN_EPI) { if (wr == 1) PG8_BAR; }
    }
    PG8_WAIT_V(0);
    if constexpr (!ALIGN_EPI) { if (wr == 0) PG8_BAR; }
    PG8_BAR;
    if constexpr (Epi::AFTER_DRAIN) { E.fused(acc, cur, wr, wc, fr, fq, lds, wid, lane); S.done(cur); }
#undef PG8_SA
#undef PG8_SB
#undef PG8_STAGE
#undef PG8_LDA
#undef PG8_LDB
#undef PG8_MMA
#undef PG8_WAIT_V
#undef PG8_WAIT_L
#undef PG8_BAR
#undef PG8_SCHED
}
}

constexpr int NWAVES = 8;
constexpr int BATCH = 8, SEQ = 2048, DM = 1024, M = BATCH * SEQ, DIN = 3072, DH = 64, NH = 8, DA = 512;
constexpr size_t MiB = 1u << 20;
constexpr size_t WS_CTL = 0, CTL_ZERO_BYTES = 64 * 1024;
constexpr size_t WS_MOD = 1 * MiB;
constexpr size_t WS_WIN = 2 * MiB;
constexpr size_t WS_WOUT = 8 * MiB;
constexpr size_t WS_WPOOL = 10 * MiB;
constexpr size_t WS_XN = 16 * MiB;
constexpr size_t WS_PROJ = 48 * MiB;
constexpr size_t PROJ_STRIDE = (size_t)M * 512;
constexpr size_t WS_CAT = 144 * MiB;
constexpr size_t WS_END = 176 * MiB;
constexpr int RING_BYTES = 131072, LDS_BYTES = 147456, MISC_OFF = LDS_BYTES - 128;
constexpr int CW_BAR = 1024;

#define GAS __attribute__((address_space(1)))
#define LAS __attribute__((address_space(3)))
typedef unsigned short bf16;
typedef unsigned v4u __attribute__((ext_vector_type(4)));
typedef unsigned v2u __attribute__((ext_vector_type(2)));
typedef float f32x4 __attribute__((ext_vector_type(4)));
typedef float f32x16 __attribute__((ext_vector_type(16)));
typedef short bf16x8 __attribute__((ext_vector_type(8)));
typedef short s16x4 __attribute__((ext_vector_type(4)));
#define LDS_WAIT() asm volatile("s_waitcnt lgkmcnt(0)" ::: "memory")
#define VM_WAIT() asm volatile("s_waitcnt vmcnt(0)" ::: "memory")
__device__ __forceinline__ unsigned pk2(float lo, float hi) { return pg8::cvt_pk_bf16(lo, hi); }
__device__ __forceinline__ float bf_lo(unsigned u) { return __builtin_bit_cast(float, u << 16); }
__device__ __forceinline__ float bf_hi(unsigned u) { return __builtin_bit_cast(float, u & 0xffff0000u); }
#define XB_TMO      128
#define XB_XCNT(j)  (256  + 64 * (j))
#define XB_XSUB(j)  (1280 + 64 * (j))
#define XB_XGEN(j)  (2304 + 64 * (j))
#define XB_TOP      3328
#define XB_TOPGEN   3392
#define XCD_BAR_WORDS 3456
#define XB_SPIN_CAP (1u << 18)

__device__ __forceinline__ unsigned xb_ld(unsigned* p)              { return __hip_atomic_load(p, __ATOMIC_RELAXED, __HIP_MEMORY_SCOPE_AGENT); }
__device__ __forceinline__ unsigned xb_add(unsigned* p, unsigned v) { return __hip_atomic_fetch_add(p, v, __ATOMIC_RELAXED, __HIP_MEMORY_SCOPE_AGENT); }
__device__ __forceinline__ unsigned xb_xcc_id() { return (unsigned)__builtin_amdgcn_s_getreg((3 << 11) | 20) & 0xFu; }
#define XB_SPIN(cond, bar) do { unsigned _sp = 0; while (cond) { __builtin_amdgcn_s_sleep(1); \
    if ((++_sp & 255u) == 0u) { if (xb_ld(&(bar)[XB_TMO])) break; if (_sp > XB_SPIN_CAP) { atomicAdd(&(bar)[XB_TMO], 1u); break; } } } } while (0)

struct XcdBarrier {
    unsigned* bar; unsigned x;
    volatile LAS unsigned* st;
};

__device__ __forceinline__ XcdBarrier xcd_barrier_post(unsigned* bar, volatile LAS unsigned* st) {
    XcdBarrier b; b.bar = bar; b.x = xb_xcc_id(); b.st = st;
    if (threadIdx.x == 0) (void)xb_add(&bar[XB_XCNT(b.x)], 1u);
    return b;
}
__device__ __forceinline__ void xcd_barrier_complete(unsigned* bar, unsigned x, unsigned& nloc, unsigned& nx) {
    const unsigned G = gridDim.x * gridDim.y * gridDim.z;
    unsigned sum, cnt, mine, sp = 0u;
    for (;;) {
        sum = 0u; cnt = 0u; mine = 0u;
#pragma unroll
        for (unsigned j = 0; j < 16; ++j) { const unsigned c = xb_ld(&bar[XB_XCNT(j)]); sum += c; cnt += (c > 0u) ? 1u : 0u; mine = (j == x) ? c : mine; }
        if (sum == G) break;
        __builtin_amdgcn_s_sleep(1);
        if ((++sp & 255u) == 0u) { if (xb_ld(&bar[XB_TMO])) break; if (sp > XB_SPIN_CAP) { atomicAdd(&bar[XB_TMO], 1u); break; } }
    }
    nloc = mine > 0u ? mine : 1u; nx = cnt > 0u ? cnt : 1u;
}

__device__ __forceinline__ void xcd_barrier(const XcdBarrier& b) {
    asm volatile("s_waitcnt vmcnt(0)" ::: "memory");
    __syncthreads();
    if (threadIdx.x == 0) {
        unsigned* bar = b.bar;
        __builtin_amdgcn_s_waitcnt(0);
        unsigned nloc = b.st[0], nx = b.st[1];
        if (nloc == 0u) { xcd_barrier_complete(bar, b.x, nloc, nx); b.st[0] = nloc; b.st[1] = nx; }
        const unsigned old = xb_add(&bar[XB_XSUB(b.x)], 1u);
        const unsigned gen = old / nloc;
        if (old + 1u == (gen + 1u) * nloc) {
            __builtin_amdgcn_fence(__ATOMIC_RELEASE, "agent");
            asm volatile("s_waitcnt vmcnt(0)" ::: "memory");
            const unsigned og = xb_add(&bar[XB_TOP], 1u);
            const unsigned tg = og / nx;
            if (og + 1u == (tg + 1u) * nx) xb_add(&bar[XB_TOPGEN], 1u);
            else XB_SPIN(xb_ld(&bar[XB_TOPGEN]) == tg, bar);
            __builtin_amdgcn_fence(__ATOMIC_ACQUIRE, "agent");
            xb_add(&bar[XB_XGEN(b.x)], 1u);
            asm volatile("s_waitcnt vmcnt(0)" ::: "memory");
        } else {
            XB_SPIN(xb_ld(&bar[XB_XGEN(b.x)]) == gen, bar);
            __builtin_amdgcn_fence(__ATOMIC_ACQUIRE, "agent");
            asm volatile("s_waitcnt vmcnt(0)" ::: "memory");
        }
    }
    __syncthreads();
}

#ifndef MK_SEAMB
#define MK_SEAMB 1
#endif
__device__ __forceinline__ void cat_store16(bf16* CAT, size_t elem, v4u w) {
#if MK_SEAMB
    const __amdgpu_buffer_rsrc_t rs = __builtin_amdgcn_make_buffer_rsrc(CAT, 0, (int)((size_t)M * DM * 2), 0x00020000);
    __builtin_amdgcn_raw_buffer_store_b128(w, rs, (unsigned)(elem * 2), 0, 16);
#else
    *(v4u*)(CAT + elem) = w;
#endif
}
namespace att {
__device__ __forceinline__ void glds16(const void* gsrc, unsigned lds_dst) { unsigned keep;
    asm volatile("s_mov_b32 %0, m0\n\ts_mov_b32 m0, %2\n\ts_nop 0\n\tglobal_load_lds_dwordx4 %1, off\n\ts_mov_b32 m0, %0" : "=&s"(keep) : "v"(gsrc), "s"(lds_dst) : "memory"); }
typedef short v4i16_t __attribute__((ext_vector_type(4)));
__device__ __forceinline__ s16x4 vtr(LAS const char* p) { return __builtin_bit_cast(s16x4, __builtin_amdgcn_ds_read_tr16_b64_v4i16((LAS v4i16_t*)p)); }
constexpr int TILEB = 8192, VOFF = 4096, STAGE_OFF = 12 * TILEB, STAGE_B = 4608;
#ifndef ATT_HIST
#define ATT_HIST 0
#endif

template <bool DIAG>
__device__ __forceinline__ void tile_weights(f32x16& p0, float& carry, unsigned (&pw)[2][4], int kv0, int qabs, int hi) {
    float G[4];
#pragma unroll
    for (int i = 0; i < 4; ++i) {
        float rr[4], be[4];
#pragma unroll
        for (int j = 0; j < 4; ++j) {
            const float e = __builtin_amdgcn_exp2f(p0[4 * i + j]);
            float rv = __builtin_amdgcn_rcpf(1.0f + e); float bv = e * rv;
            if (DIAG) { const int kv = kv0 + 8 * i + 4 * hi + j; if (kv >= qabs) { rv = 1.0f; bv = 0.0f; } }
            rr[j] = rv; be[j] = bv;
        }
        const float s2 = rr[3], s1 = s2 * rr[2], s0 = s1 * rr[1];
        G[i] = s0 * rr[0];
        p0[4 * i + 3] = be[3]; p0[4 * i + 2] = be[2] * s2; p0[4 * i + 1] = be[1] * s1; p0[4 * i] = be[0] * s0;
    }
    float F[4]; float run = carry;
#pragma unroll
    for (int p = 3; p >= 0; --p) {
        auto sw = __builtin_amdgcn_permlane32_swap(__float_as_uint(G[p]), __float_as_uint(G[p]), false, false);
        const float g0 = __uint_as_float(sw[0]), g1 = __uint_as_float(sw[1]);
        F[p] = run * (hi ? 1.0f : g1);
        run = run * (g0 * g1);
    }
    carry = run;
#pragma unroll
    for (int i = 0; i < 4; ++i) { const float f = F[i];
        pw[i >> 1][2 * (i & 1)] = pk2(p0[4 * i] * f, p0[4 * i + 1] * f); pw[i >> 1][2 * (i & 1) + 1] = pk2(p0[4 * i + 2] * f, p0[4 * i + 3] * f); }
}

template <bool EARLY>
__device__ __forceinline__ void attn_pass(int b, int h, int qb0, const bf16* Q, const bf16* K, const bf16* V, const bf16* GA, bf16* CAT, LAS char* shm) {
    const int tid = threadIdx.x, lane = tid & 63, r32 = lane & 31, hi = lane >> 5; const int wid = __builtin_amdgcn_readfirstlane(tid >> 6);
    const size_t hb = ((size_t)(b * NH + h) * SEQ) * DH;
    const bf16* Qh = Q + hb; const bf16* Kh = K + hb; const bf16* Vh = V + hb;
    const unsigned lds0 = (unsigned)__builtin_amdgcn_readfirstlane((int)(unsigned)(uintptr_t)shm);
    const int wb = qb0 - ATT_HIST > 0 ? qb0 - ATT_HIST : 0, nw = qb0 + 8 - wb;
    const bf16* ksrc = Kh + (size_t)(lane >> 3) * DH + (((lane & 7) ^ ((lane >> 3) & 7)) * 8);
    const bf16* vsrc = Vh + (size_t)(lane >> 2) * DH + (lane & 3) * 8;
    for (int p = wid; p < nw * 8; p += NWAVES) {
        const int w = p >> 3, pc = p & 7; const size_t trow = (size_t)(wb + w) * 32;
        const unsigned dst = lds0 + w * TILEB + pc * 1024;
        if (pc < 4) glds16(ksrc + (trow + 8 * pc) * DH, dst);
        else glds16(vsrc + (trow + 16 * ((pc - 4) & 1)) * DH + 32 * ((pc - 4) >> 1), dst);
    }
    const int qblk = qb0 + wid, q0 = qblk * 32, qabs = q0 + r32;
    bf16x8 qr[4];
#pragma unroll
    for (int d0 = 0; d0 < 4; ++d0) qr[d0] = *reinterpret_cast<const bf16x8*>(&Qh[(size_t)qabs * DH + d0 * 16 + hi * 8]);
    const size_t tok0 = (size_t)b * SEQ + q0;
    v4u gpre[2][2];
#pragma unroll
    for (int dh = 0; dh < 2; ++dh)
#pragma unroll
        for (int k = 0; k < 2; ++k) gpre[dh][k] = *(const v4u*)(GA + hb + (size_t)(q0 + 16 * k + (lane >> 2)) * DH + 32 * dh + (lane & 3) * 8);
    asm volatile("s_waitcnt vmcnt(0)" ::: "memory");
    __syncthreads();
    f32x16 o[2]; o[0] = f32x16{}; o[1] = f32x16{};
    float carry = 1.0f; bool dead = false;
    LAS const char* kp0 = shm + r32 * 128;
    LAS const char* vp0 = shm + VOFF + ((lane >> 4) & 1) * 32 + (lane & 3) * 8 + (4 * hi + ((lane & 15) >> 2)) * 64;
#define ATT_TILE(DG) do { \
        const int w = t - wb; LAS const char* kp = kp0 + w * TILEB; f32x16 p0 = f32x16{}; \
        _Pragma("unroll") for (int d0 = 0; d0 < 4; ++d0) { const bf16x8 kf = *(LAS const bf16x8*)(kp + (((2 * d0 + hi) ^ (r32 & 7)) * 16)); p0 = __builtin_amdgcn_mfma_f32_32x32x16_bf16(kf, qr[d0], p0, 0, 0, 0); } \
        unsigned pw[2][4]; tile_weights<DG>(p0, carry, pw, t * 32, qabs, hi); \
        LAS const char* vp = vp0 + w * TILEB; \
        _Pragma("unroll") for (int dh = 0; dh < 2; ++dh) _Pragma("unroll") for (int ks = 0; ks < 2; ++ks) { \
            const s16x4 lo = vtr(vp + dh * 2048 + ks * 1024), hh = vtr(vp + dh * 2048 + ks * 1024 + 512); \
            const bf16x8 vf = (bf16x8){lo[0], lo[1], lo[2], lo[3], hh[0], hh[1], hh[2], hh[3]}; \
            const v4u pwv = (v4u){pw[ks][0], pw[ks][1], pw[ks][2], pw[ks][3]}; \
            o[dh] = __builtin_amdgcn_mfma_f32_32x32x16_bf16(vf, __builtin_bit_cast(bf16x8, pwv), o[dh], 0, 0, 0); } } while (0)
    int t = qblk;
    ATT_TILE(true);
    if (EARLY && __all(carry < 1e-30f)) dead = true;
    if (!dead) for (t = qblk - 1; t >= wb; --t) {
        ATT_TILE(false);
        if (EARLY) { if (__all(carry < 1e-30f)) { dead = true; break; } }
    }
#undef ATT_TILE
    if (!dead) {
        for (t = wb - 1; t >= 0; --t) {
            f32x16 p0 = f32x16{};
#pragma unroll
            for (int d0 = 0; d0 < 4; ++d0) {
                const bf16x8 kf = *reinterpret_cast<const bf16x8*>(&Kh[((size_t)t * 32 + r32) * DH + (2 * d0 + hi) * 8]);
                p0 = __builtin_amdgcn_mfma_f32_32x32x16_bf16(kf, qr[d0], p0, 0, 0, 0);
            }
            unsigned pw[2][4];
            tile_weights<false>(p0, carry, pw, t * 32, qabs, hi);
#pragma unroll
            for (int dh = 0; dh < 2; ++dh)
#pragma unroll
                for (int ks = 0; ks < 2; ++ks) {
                    bf16x8 vf;
#pragma unroll
                    for (int j = 0; j < 8; ++j) vf[j] = (short)Vh[((size_t)t * 32 + 16 * ks + 8 * (j >> 2) + 4 * hi + (j & 3)) * DH + 32 * dh + r32];
                    const v4u pwv = (v4u){pw[ks][0], pw[ks][1], pw[ks][2], pw[ks][3]};
                    o[dh] = __builtin_amdgcn_mfma_f32_32x32x16_bf16(vf, __builtin_bit_cast(bf16x8, pwv), o[dh], 0, 0, 0);
                }
            if (EARLY) { if (__all(carry < 1e-30f)) break; }
        }
    }
    {
        LAS char* st = shm + STAGE_OFF + wid * STAGE_B;
        const int rr = lane >> 2, ch = lane & 3;
#pragma unroll
        for (int dh = 0; dh < 2; ++dh) {
#pragma unroll
            for (int i = 0; i < 4; ++i) *(LAS f32x4*)(st + r32 * 144 + (8 * i + 4 * hi) * 4) = (f32x4){o[dh][4 * i], o[dh][4 * i + 1], o[dh][4 * i + 2], o[dh][4 * i + 3]};
            asm volatile("s_waitcnt lgkmcnt(0)" ::: "memory");
#pragma unroll
            for (int k = 0; k < 2; ++k) { const int row = 16 * k + rr;
                const f32x4 a0 = *(LAS const f32x4*)(st + row * 144 + ch * 32), a1 = *(LAS const f32x4*)(st + row * 144 + ch * 32 + 16);
                const v4u g = gpre[dh][k];
                v4u w; w.x = pk2(a0[0] * bf_lo(g.x), a0[1] * bf_hi(g.x)); w.y = pk2(a0[2] * bf_lo(g.y), a0[3] * bf_hi(g.y));
                w.z = pk2(a1[0] * bf_lo(g.z), a1[1] * bf_hi(g.z)); w.w = pk2(a1[2] * bf_lo(g.w), a1[3] * bf_hi(g.w));
                cat_store16(CAT, (tok0 + row) * DM + h * DH + 32 * dh + ch * 8, w); }
            asm volatile("s_waitcnt lgkmcnt(0)" ::: "memory");
        }
    }
    asm volatile("s_waitcnt vmcnt(0)" ::: "memory");
    __syncthreads();
}
}

namespace pool {
constexpr int UP = 272;
constexpr int UROWS = 272;
constexpr int WOFF = UROWS * UP;
typedef short v4i16_t __attribute__((ext_vector_type(4)));
__device__ __forceinline__ s16x4 vtr(LAS const char* p) { return __builtin_bit_cast(s16x4, __builtin_amdgcn_ds_read_tr16_b64_v4i16((LAS v4i16_t*)p)); }
template <int WIN>
__device__ __forceinline__ void pool_unit_w(int pm, int g, const bf16* U, const bf16* GP, const bf16* WpT, const float* bp, const float* ps, bf16* CAT, LAS char* shm) {
    const int tid = threadIdx.x, lane = tid & 63, r32 = lane & 31, hi = lane >> 5; const int wid = __builtin_amdgcn_readfirstlane(tid >> 6);
    asm volatile("" : "+s"(pm), "+s"(g));
    const int t0 = pm * 256, tpos0 = t0 & (SEQ - 1);
    v4u tu[9], tw[4];
#pragma unroll
    for (int k = 0; k < 9; ++k) { const int c = tid + k * 512, row = c >> 4, ch = c & 15; tu[k] = (v4u){0u, 0u, 0u, 0u};
        if (c < UROWS * 16 && tpos0 - 16 + row >= 0) tu[k] = *(const v4u*)(U + ((size_t)g * M + (t0 - 16 + row)) * 128 + ch * 8); }
#pragma unroll
    for (int k = 0; k < 4; ++k) { const int c = tid + k * 512; tw[k] = *(const v4u*)(WpT + (size_t)g * 16384 + (size_t)c * 8); }
#pragma unroll
    for (int k = 0; k < 9; ++k) { const int c = tid + k * 512, row = c >> 4, ch = c & 15; if (c < UROWS * 16) *(LAS v4u*)(shm + row * UP + ch * 16) = tu[k]; }
#pragma unroll
    for (int k = 0; k < 4; ++k) { const int c = tid + k * 512, row = c >> 4, ch = c & 15; *(LAS v4u*)(shm + WOFF + row * UP + ch * 16) = tw[k]; }
    v4u gpre[2][4];
#pragma unroll
    for (int half = 0; half < 2; ++half)
#pragma unroll
        for (int k = 0; k < 4; ++k) gpre[half][k] = *(const v4u*)(GP + ((size_t)g * M + t0 + wid * 32 + 8 * k + (lane >> 3)) * 128 + 64 * half + (lane & 7) * 8);
    __syncthreads();
    const int r = wid * 32 + r32, tpos = tpos0 + r;
    const float inv = 1.0f / (float)(tpos + 1 < WIN ? tpos + 1 : WIN);
    bf16x8 band[3];
#pragma unroll
    for (int ks = 0; ks < 3; ++ks)
#pragma unroll
        for (int j = 0; j < 8; ++j) { const int dlt = (r32 + 16) - (16 * ks + 8 * (j >> 2) + 4 * hi + (j & 3));
            band[ks][j] = (dlt >= 0 && dlt < WIN) ? (short)0x3F80 : (short)0; }
    LAS const char* ub = shm + (32 * wid + 4 * hi + ((lane & 15) >> 2)) * UP + (16 * ((lane >> 4) & 1) + 4 * (lane & 3)) * 2;
    LAS const char* urow = shm + (32 * wid + r32 + 16) * UP + 8 * hi;
    LAS const char* wl = shm + WOFF + r32 * UP + 8 * hi;
    f32x16 acc[4]; acc[0] = f32x16{}; acc[1] = f32x16{}; acc[2] = f32x16{}; acc[3] = f32x16{};
#pragma unroll 1
    for (int ct = 0; ct < 4; ++ct) {
        f32x16 X = f32x16{};
#pragma unroll
        for (int ks = 0; ks < 3; ++ks) {
            const s16x4 lo = vtr(ub + (16 * ks) * UP + ct * 64), hh = vtr(ub + (16 * ks + 8) * UP + ct * 64);
            const bf16x8 uf = (bf16x8){lo[0], lo[1], lo[2], lo[3], hh[0], hh[1], hh[2], hh[3]};
            X = __builtin_amdgcn_mfma_f32_32x32x16_bf16(uf, band[ks], X, 0, 0, 0);
        }
        unsigned pw[2][4];
#pragma unroll
        for (int i = 0; i < 4; ++i) { const v2u ut = *(LAS const v2u*)(urow + (32 * ct + 8 * i) * 2);
            pw[i >> 1][2 * (i & 1)] = pk2(X[4 * i] * inv - bf_lo(ut.x), X[4 * i + 1] * inv - bf_hi(ut.x));
            pw[i >> 1][2 * (i & 1) + 1] = pk2(X[4 * i + 2] * inv - bf_lo(ut.y), X[4 * i + 3] * inv - bf_hi(ut.y)); }
#pragma unroll
        for (int s2 = 0; s2 < 2; ++s2) { const int S = 2 * ct + s2;
            const v4u pv = (v4u){pw[s2][0], pw[s2][1], pw[s2][2], pw[s2][3]};
            const bf16x8 pfr = __builtin_bit_cast(bf16x8, pv);
#pragma unroll
            for (int n = 0; n < 4; ++n) { const v2u w0 = *(LAS const v2u*)(wl + n * 32 * UP + 32 * S), w1 = *(LAS const v2u*)(wl + n * 32 * UP + 32 * S + 16);
                const v4u wv = (v4u){w0.x, w0.y, w1.x, w1.y};
                acc[n] = __builtin_amdgcn_mfma_f32_32x32x16_bf16(__builtin_bit_cast(bf16x8, wv), pfr, acc[n], 0, 0, 0); }
        }
    }
    __syncthreads();
    {
        LAS char* st = shm + wid * 16384;
        const size_t tokw = (size_t)t0 + wid * 32;
        const int rr = lane >> 3, ch = lane & 7;
#pragma unroll
        for (int half = 0; half < 2; ++half) {
#pragma unroll
            for (int nn = 0; nn < 2; ++nn)
#pragma unroll
                for (int i = 0; i < 4; ++i) { const int n = 2 * half + nn;
                    *(LAS f32x4*)(st + r32 * 272 + (32 * nn + 8 * i + 4 * hi) * 4) = (f32x4){acc[n][4 * i], acc[n][4 * i + 1], acc[n][4 * i + 2], acc[n][4 * i + 3]}; }
            asm volatile("s_waitcnt lgkmcnt(0)" ::: "memory");
            const int col = g * 128 + 64 * half + ch * 8;
            const f32x4 b0 = *(const f32x4*)(bp + col), b1 = *(const f32x4*)(bp + col + 4), s0 = *(const f32x4*)(ps + col), s1 = *(const f32x4*)(ps + col + 4);
#pragma unroll
            for (int k = 0; k < 4; ++k) { const int row = 8 * k + rr;
                const f32x4 a0 = (*(LAS const f32x4*)(st + row * 272 + ch * 32) + b0) * s0, a1 = (*(LAS const f32x4*)(st + row * 272 + ch * 32 + 16) + b1) * s1;
                const v4u gv = gpre[half][k];
                v4u w; w.x = pk2(a0[0] * bf_lo(gv.x), a0[1] * bf_hi(gv.x)); w.y = pk2(a0[2] * bf_lo(gv.y), a0[3] * bf_hi(gv.y));
                w.z = pk2(a1[0] * bf_lo(gv.z), a1[1] * bf_hi(gv.z)); w.w = pk2(a1[2] * bf_lo(gv.w), a1[3] * bf_hi(gv.w));
                cat_store16(CAT, (tokw + row) * DM + 512 + col, w); }
            asm volatile("s_waitcnt lgkmcnt(0)" ::: "memory");
        }
    }
    asm volatile("s_waitcnt vmcnt(0)" ::: "memory");
    __syncthreads();
}
__device__ __forceinline__ void pool_unit(int pm, int g, const bf16* U, const bf16* GP, const bf16* WpT, const float* bp, const float* ps, bf16* CAT, LAS char* shm) {
    if (g == 0) pool_unit_w<2>(pm, g, U, GP, WpT, bp, ps, CAT, shm);
    else if (g == 1) pool_unit_w<4>(pm, g, U, GP, WpT, bp, ps, CAT, shm);
    else if (g == 2) pool_unit_w<8>(pm, g, U, GP, WpT, bp, ps, CAT, shm);
    else pool_unit_w<16>(pm, g, U, GP, WpT, bp, ps, CAT, shm);
}
}

__device__ __forceinline__ float wave_sum(float v) {
#pragma unroll
    for (int o = 1; o < 64; o <<= 1) v += __shfl_xor(v, o);
    return v;
}
struct TrItem { const float* W; bf16* WT; int K, N, item; bool permn; };
__device__ __forceinline__ void tr_load(const TrItem& t, float (&v)[32], int lane) {
    const int nblk = t.N / 32, kb = t.item / nblk, nb = t.item % nblk, k0 = 64 * kb, n0 = 32 * nb;
#pragma unroll
    for (int i = 0; i < 32; ++i) { const int kk = 2 * i + (lane >> 5); v[i] = t.W[(size_t)(k0 + kk) * t.N + n0 + (lane & 31)]; }
}
__device__ __forceinline__ void tr_finish(const TrItem& t, const float (&v)[32], LAS float* scr, int lane) {
    const int nblk = t.N / 32, kb = t.item / nblk, nb = t.item % nblk, k0 = 64 * kb, n0 = 32 * nb;
#pragma unroll
    for (int i = 0; i < 32; ++i) { const int kk = 2 * i + (lane >> 5); scr[kk * 33 + (lane & 31)] = v[i]; }
    LDS_WAIT(); asm volatile("" ::: "memory");
    const int c = lane & 7;
#pragma unroll
    for (int j = 0; j < 4; ++j) { const int n = (lane >> 3) + 8 * j; const LAS float* s = scr + (8 * c) * 33 + n;
        v4u o; o.x = pk2(s[0 * 33], s[1 * 33]); o.y = pk2(s[2 * 33], s[3 * 33]); o.z = pk2(s[4 * 33], s[5 * 33]); o.w = pk2(s[6 * 33], s[7 * 33]);
        int na = n0 + n;
        if (t.permn) na = (na & ~255) + 128 * ((na >> 5) & 1) + 32 * ((na >> 6) & 3) + (na & 31);
        *(GAS v4u*)(t.WT + (size_t)na * t.K + k0 + 8 * c) = o; }
    LDS_WAIT(); asm volatile("" ::: "memory");
}

struct Args { const float* in[12]; float* out; unsigned char* ws; int ph_lo, ph_hi; int coop, pad; };
constexpr int N_PHASES = 5;

__global__ void __launch_bounds__(NWAVES * 64, 2) hybrid_fwd(Args args) {
    extern __shared__ __attribute__((aligned(16))) unsigned char lds[];
    LAS unsigned char* L = (LAS unsigned char*)lds;
    const int tid = threadIdx.x, lane = tid & 63, wave = __builtin_amdgcn_readfirstlane(tid >> 6);
    const int G = gridDim.x, bx = blockIdx.x;
    const int vcu = (G % 8 == 0) ? (bx % 8) * (G / 8) + bx / 8 : bx;
    const float* x = args.in[0]; const float* c = args.in[1]; const float* w_ada = args.in[2]; const float* b_ada = args.in[3]; const float* norm_g = args.in[4];
    const float* w_in = args.in[5]; const float* qg = args.in[6]; const float* kg = args.in[7]; const float* w_pool = args.in[8]; const float* b_pool = args.in[9];
    const float* pool_scale = args.in[10]; const float* w_out = args.in[11];
    unsigned char* ws = args.ws;
    float* mod = (float*)(ws + WS_MOD);
    bf16* Win_t = (bf16*)(ws + WS_WIN); bf16* Wout_t = (bf16*)(ws + WS_WOUT); bf16* WpT = (bf16*)(ws + WS_WPOOL);
    bf16* XN = (bf16*)(ws + WS_XN); bf16* PROJ = (bf16*)(ws + WS_PROJ); bf16* CAT = (bf16*)(ws + WS_CAT);
    const int lo = args.ph_lo, hi = args.ph_hi;
#define IN(k) (lo <= (k) && (k) < hi)
#define BOTH(k) (IN(k) && IN((k) + 1))
#if MK_COOP
    if (tid < 32) ((LAS unsigned*)(L + MISC_OFF))[tid] = 0u;
    __syncthreads();
    XcdBarrier bar = xcd_barrier_post((unsigned*)(ws + WS_CTL) + CW_BAR, (volatile LAS unsigned*)(L + MISC_OFF) + 8);
#define GRID_BAR() do { if (args.coop == 2) cg::this_grid().sync(); else xcd_barrier(bar); } while (0)
#else
#define GRID_BAR() do { } while (0)
#endif
    const int gw = vcu * NWAVES + wave, NGW = G * NWAVES;
    unsigned* ctl = (unsigned*)(ws + WS_CTL); constexpr int CW_SEAM_B = 12288;
    const bool pseamB = MK_SEAMB && MK_COOP && G == 256 && lo == 0 && hi == N_PHASES && MK_STAMP < 0 && MK_REP3 == 1;
    constexpr int CW_SEAM_A = 8192;
    const bool pseamA = pseamB && MK_REP1 == 1;
    pg8::Unit u2; u2.pm = 0; u2.pn = 0; if (pseamA) { pg8::StaticOrder S2; S2.init(M, DIN, G, bx); S2.next(0, u2); }
#define PANEL_ARRIVE(p_) do { if (pseamB && tid == 0) __hip_atomic_fetch_add(ctl + CW_SEAM_B + 64 * (p_), 1u, __ATOMIC_RELAXED, __HIP_MEMORY_SCOPE_AGENT); } while (0)
#if MK_STAMP >= 0
    unsigned long long ts_[8]; ts_[0] = __builtin_amdgcn_s_memrealtime();
#define STAMP(k) do { ts_[k] = __builtin_amdgcn_s_memrealtime(); } while (0)
    unsigned long long tsub_[4] = {0, 0, 0, 0}; unsigned long long tk2_ = 0, tk2e_ = 0;
#define SUBSTAMP(k) do { tsub_[k] = __builtin_amdgcn_s_memrealtime(); } while (0)
#else
#define STAMP(k) do { } while (0)
#define SUBSTAMP(k) do { } while (0)
#endif

    const bool fuse01 = false;
    f32x4 xr_[8][4]; float xs_[8];
    if (fuse01) {
#pragma unroll
        for (int q = 0; q < 8; ++q) { const GAS f32x4* xp = (const GAS f32x4*)(x + (size_t)(gw + q * NGW) * DM) + lane;
#pragma unroll
            for (int j = 0; j < 4; ++j) xr_[q][j] = xp[64 * j]; }
    }
    if (IN(0)) { for (int rep_ = 0; rep_ < MK_REP0; ++rep_) {
        LAS float* cact = (LAS float*)L;
        LAS float* red = (LAS float*)(L + 32768);
        LAS float* scr = (LAS float*)(L + 40960 + wave * 8448);
        constexpr int I_IN = (DM / 64) * (DIN / 32), I_OUT = (DM / 64) * (DM / 32), I_P = 4 * (128 / 64) * (128 / 32), I_ALL = I_IN + I_OUT + I_P;
        auto mk_item = [&](int it) { TrItem t; int r = it;
            if (r < I_IN) { t.W = w_in; t.WT = Win_t; t.K = DM; t.N = DIN; t.item = r; t.permn = true; return t; } r -= I_IN;
            if (r < I_OUT) { t.W = w_out; t.WT = Wout_t; t.K = DM; t.N = DM; t.item = r; t.permn = false; return t; } r -= I_OUT;
            const int g = r >> 3; t.W = w_pool + (size_t)g * 16384; t.WT = WpT + (size_t)g * 16384; t.K = 128; t.N = 128; t.item = r & 7; t.permn = false; return t; };
        const int kq = tid >> 2, cq = tid & 3, cgp0 = bx < 256 ? bx : 0;
        float cv[16], wv[8][3], tv[32]; const int it0 = gw; const TrItem ti0 = mk_item(it0 < I_ALL ? it0 : 0);
#pragma unroll
        for (int i = 0; i < 16; ++i) cv[i] = c[tid + i * 512];
#pragma unroll
        for (int kk = 0; kk < 8; ++kk) { const float* wr = w_ada + (size_t)(kq * 8 + kk) * DIN + cgp0 * 12 + cq * 3; wv[kk][0] = wr[0]; wv[kk][1] = wr[1]; wv[kk][2] = wr[2]; }
        const float bias0 = (tid < 96) ? b_ada[cgp0 * 12 + tid % 12] : 0.f;
        if (it0 < I_ALL) tr_load(ti0, tv, lane);
#pragma unroll
        for (int i = 0; i < 16; ++i) { const float v = cv[i]; cact[tid + i * 512] = v / (1.0f + __expf(-v)); }
        __syncthreads();
        for (int cgp = bx; cgp < 256; cgp += G) {
            float a[8][3];
#pragma unroll
            for (int b = 0; b < 8; ++b) { a[b][0] = 0.f; a[b][1] = 0.f; a[b][2] = 0.f; }
            if (cgp != cgp0) {
#pragma unroll
                for (int kk = 0; kk < 8; ++kk) { const float* wr = w_ada + (size_t)(kq * 8 + kk) * DIN + cgp * 12 + cq * 3; wv[kk][0] = wr[0]; wv[kk][1] = wr[1]; wv[kk][2] = wr[2]; } }
#pragma unroll
            for (int kk = 0; kk < 8; ++kk) { const int k = kq * 8 + kk;
#pragma unroll
                for (int b = 0; b < 8; ++b) { const float ca = cact[b * DM + k]; a[b][0] += ca * wv[kk][0]; a[b][1] += ca * wv[kk][1]; a[b][2] += ca * wv[kk][2]; } }
            float v24[24];
#pragma unroll
            for (int b = 0; b < 8; ++b)
#pragma unroll
                for (int j = 0; j < 3; ++j) v24[b * 3 + j] = a[b][j];
#pragma unroll
            for (int i = 0; i < 12; ++i) { const bool up = (lane & 32) != 0; const float keep = up ? v24[i + 12] : v24[i], give = up ? v24[i] : v24[i + 12]; v24[i] = keep + __shfl_xor(give, 32); }
#pragma unroll
            for (int i = 0; i < 6; ++i) { const bool up = (lane & 16) != 0; const float keep = up ? v24[i + 6] : v24[i], give = up ? v24[i] : v24[i + 6]; v24[i] = keep + __shfl_xor(give, 16); }
#pragma unroll
            for (int i = 0; i < 3; ++i) { const bool up = (lane & 8) != 0; const float keep = up ? v24[i + 3] : v24[i], give = up ? v24[i] : v24[i + 3]; v24[i] = keep + __shfl_xor(give, 8); }
#pragma unroll
            for (int i = 0; i < 3; ++i) { v24[i] += __shfl_xor(v24[i], 4);
                const int idx = 12 * ((lane >> 5) & 1) + 6 * ((lane >> 4) & 1) + 3 * ((lane >> 3) & 1) + i;
                if ((lane & 4) == 0) red[wave * 96 + (idx / 3) * 12 + cq * 3 + (idx % 3)] = v24[i]; }
            __syncthreads();
            if (tid < 96) { float s = 0.f;
#pragma unroll
                for (int w = 0; w < 8; ++w) s += red[w * 96 + tid];
                const int b = tid / 12, n = cgp * 12 + tid % 12; mod[b * DIN + n] = s + (cgp == cgp0 ? bias0 : b_ada[n]); }
            __syncthreads();
        }
        if (it0 < I_ALL) tr_finish(ti0, tv, scr, lane);
        for (int it = gw + NGW; it < I_ALL; it += NGW) { float tv[32]; const TrItem ti = mk_item(it); tr_load(ti, tv, lane); tr_finish(ti, tv, scr, lane); }
        __syncthreads(); }
        if (BOTH(0)) GRID_BAR();
        STAMP(1);
    }
    if (IN(1) && fuse01) {
#pragma unroll
        for (int q = 0; q < 8; ++q) { float t = 0.f;
#pragma unroll
            for (int j = 0; j < 4; ++j) t += (xr_[q][j].x * xr_[q][j].x + xr_[q][j].y * xr_[q][j].y) + (xr_[q][j].z * xr_[q][j].z + xr_[q][j].w * xr_[q][j].w);
            xs_[q] = t; }
#pragma unroll
        for (int q = 0; q < 8; ++q) { const int m = gw + q * NGW;
            const float* mb = mod + (size_t)(m >> 11) * DIN;
            const float inv = 1.0f / sqrtf(wave_sum(xs_[q]) * (1.0f / DM) + 1e-6f);
            GAS unsigned long long* o8 = (GAS unsigned long long*)(XN + (size_t)m * DM) + lane;
#pragma unroll
            for (int j = 0; j < 4; ++j) { const int k = 4 * lane + 256 * j;
                const f32x4 gg = *(const f32x4*)(norm_g + k), sh = *(const f32x4*)(mb + k), sc = *(const f32x4*)(mb + DM + k);
                const f32x4 y = xr_[q][j] * inv * gg * (sc + 1.0f) + sh;
                o8[64 * j] = (unsigned long long)pk2(y.x, y.y) | ((unsigned long long)pk2(y.z, y.w) << 32); } }
        if (BOTH(1)) GRID_BAR();
        STAMP(2);
    } else
    if (IN(1)) { for (int rep_ = 0; rep_ < MK_REP1; ++rep_) {
        if (pseamA) {
            const int mb0 = 256 * u2.pm + 64 * u2.pn + 8 * wave; const float* mb = mod + (size_t)(mb0 >> 11) * DIN;
            f32x4 v[8][4], ga[4], sh4[4];
#pragma unroll
            for (int q = 0; q < 8; ++q) { const GAS f32x4* xr = (const GAS f32x4*)(x + (size_t)(mb0 + q) * DM) + lane;
#pragma unroll
                for (int j = 0; j < 4; ++j) v[q][j] = __builtin_nontemporal_load(xr + 64 * j); }
#pragma unroll
            for (int j = 0; j < 4; ++j) { const int k = 4 * lane + 256 * j; ga[j] = *(const f32x4*)(norm_g + k) * (*(const f32x4*)(mb + DM + k) + 1.0f); sh4[j] = *(const f32x4*)(mb + k); }
#pragma unroll
            for (int q = 0; q < 8; ++q) { float t = 0.f;
#pragma unroll
                for (int j = 0; j < 4; ++j) t += (v[q][j].x * v[q][j].x + v[q][j].y * v[q][j].y) + (v[q][j].z * v[q][j].z + v[q][j].w * v[q][j].w);
                const float inv = 1.0f / sqrtf(wave_sum(t) * (1.0f / DM) + 1e-6f);
                GAS unsigned long long* o8 = (GAS unsigned long long*)(XN + (size_t)(mb0 + q) * DM) + lane;
#pragma unroll
                for (int j = 0; j < 4; ++j) { const f32x4 y = v[q][j] * inv * ga[j] + sh4[j];
                    __hip_atomic_store(o8 + 64 * j, (unsigned long long)pk2(y.x, y.y) | ((unsigned long long)pk2(y.z, y.w) << 32), __ATOMIC_RELAXED, __HIP_MEMORY_SCOPE_AGENT); } }
        }
        const int mfirst = pseamA ? M : gw, mstep = NGW, mend = M;
        for (int m0 = mfirst; m0 < mend; m0 += 4 * mstep) {
            f32x4 v[4][4]; float s[4];
#pragma unroll
            for (int q = 0; q < 4; ++q) { const int m = m0 + q * mstep; const GAS f32x4* xr = (const GAS f32x4*)(x + (size_t)(m < M ? m : m0) * DM) + lane;
#pragma unroll
                for (int j = 0; j < 4; ++j) v[q][j] = xr[64 * j]; }
#pragma unroll
            for (int q = 0; q < 4; ++q) { float t = 0.f;
#pragma unroll
                for (int j = 0; j < 4; ++j) t += (v[q][j].x * v[q][j].x + v[q][j].y * v[q][j].y) + (v[q][j].z * v[q][j].z + v[q][j].w * v[q][j].w);
                s[q] = t; }
#pragma unroll
            for (int q = 0; q < 4; ++q) { const int m = m0 + q * mstep; if (m >= M) break;
                const float* mb = mod + (size_t)(m >> 11) * DIN;
                const float inv = 1.0f / sqrtf(wave_sum(s[q]) * (1.0f / DM) + 1e-6f);
                GAS unsigned long long* o8 = (GAS unsigned long long*)(XN + (size_t)m * DM) + lane;
#pragma unroll
                for (int j = 0; j < 4; ++j) { const int k = 4 * lane + 256 * j;
                    const f32x4 gg = *(const f32x4*)(norm_g + k), sh = *(const f32x4*)(mb + k), sc = *(const f32x4*)(mb + DM + k);
                    const f32x4 y = v[q][j] * inv * gg * (sc + 1.0f) + sh;
                    const unsigned long long pk8 = (unsigned long long)pk2(y.x, y.y) | ((unsigned long long)pk2(y.z, y.w) << 32);
                    if (pseamA) __hip_atomic_store(o8 + 64 * j, pk8, __ATOMIC_RELAXED, __HIP_MEMORY_SCOPE_AGENT); else o8[64 * j] = pk8; } }
        }
        }
        if (pseamA) {
            asm volatile("s_waitcnt vmcnt(0)" ::: "memory");
            __syncthreads();
            if (tid == 0) { unsigned* cnt = ctl + CW_SEAM_A + 64 * u2.pm;
                __hip_atomic_fetch_add(cnt, 1u, __ATOMIC_RELAXED, __HIP_MEMORY_SCOPE_AGENT);
                while (__hip_atomic_load(cnt, __ATOMIC_RELAXED, __HIP_MEMORY_SCOPE_AGENT) < 4u) __builtin_amdgcn_s_sleep(1);
                __builtin_amdgcn_fence(__ATOMIC_ACQUIRE, "agent"); asm volatile("s_waitcnt vmcnt(0)" ::: "memory"); }
            __syncthreads();
        } else if (BOTH(1)) GRID_BAR();
        STAMP(2);
    }
    if (IN(2)) { for (int rep_ = 0; rep_ < MK_REP2; ++rep_) {
        pg8::Gemm g{XN, Win_t, M, DIN, DM}; pg8::StaticOrder S; S.init(M, DIN, G, bx);
        pg8::EpiInProj E{__builtin_amdgcn_make_buffer_rsrc(ws + WS_PROJ, 0, (int)(6 * PROJ_STRIDE * 2), 0x00020000), PROJ_STRIDE, qg, kg};
        pg8::gemm_phase<pg8::EpiInProj, pg8::StaticOrder, true, true>(L, g, S, E);
#if MK_STAMP == 22 || MK_STAMP == 23
        tk2_ = *(volatile LAS unsigned long long*)(L + 147392); tk2e_ = __builtin_amdgcn_s_memrealtime();
#endif
        }
        if (pseamB) {
            __syncthreads();
            if (tid == 0) { unsigned* cnt = ctl + 6144 + 64 * (bx & 7);
                __hip_atomic_fetch_add(cnt, 1u, __ATOMIC_RELAXED, __HIP_MEMORY_SCOPE_AGENT);
                while (__hip_atomic_load(cnt, __ATOMIC_RELAXED, __HIP_MEMORY_SCOPE_AGENT) < 32u) __builtin_amdgcn_s_sleep(1);
                __builtin_amdgcn_fence(__ATOMIC_ACQUIRE, "agent"); asm volatile("s_waitcnt vmcnt(0)" ::: "memory"); }
            __syncthreads();
        } else if (BOTH(2)) GRID_BAR();
        STAMP(3);
    }
    if (IN(3)) { for (int rep_ = 0; rep_ < MK_REP3; ++rep_) {
        const bf16* Qb = PROJ; const bf16* Kb = PROJ + PROJ_STRIDE; const bf16* Vb = PROJ + 2 * PROJ_STRIDE; const bf16* GAb = PROJ + 3 * PROJ_STRIDE;
        const bf16* Ub = PROJ + 4 * PROJ_STRIDE; const bf16* GPb = PROJ + 5 * PROJ_STRIDE;
        for (int i = vcu; i < 256; i += G) {
            const int bh = i >> 2, qq = i & 3;
            if (i & 1) { pool::pool_unit(i >> 2, i & 3, Ub, GPb, WpT, b_pool, pool_scale, CAT, (LAS char*)L); PANEL_ARRIVE(i >> 2); }
            SUBSTAMP(0);
            att::attn_pass<MK_EARLY>(bh >> 3, bh & 7, 16 * qq + 8, Qb, Kb, Vb, GAb, CAT, (LAS char*)L);
            PANEL_ARRIVE((bh >> 3) * 8 + 2 * qq + 1);
            SUBSTAMP(1);
            att::attn_pass<MK_EARLY>(bh >> 3, bh & 7, 16 * qq, Qb, Kb, Vb, GAb, CAT, (LAS char*)L);
            PANEL_ARRIVE((bh >> 3) * 8 + 2 * qq);
            VM_WAIT(); __syncthreads();
            SUBSTAMP(2);
            if (!(i & 1)) { pool::pool_unit(i >> 2, i & 3, Ub, GPb, WpT, b_pool, pool_scale, CAT, (LAS char*)L); PANEL_ARRIVE(i >> 2); }
            VM_WAIT(); SUBSTAMP(3);
        }
        }
        if (!pseamB && BOTH(3)) GRID_BAR();
        STAMP(4);
    }
    if (IN(4)) { for (int rep_ = 0; rep_ < MK_REP4; ++rep_) {
        pg8::Gemm g{CAT, Wout_t, M, DM, DM}; pg8::StaticOrder S; S.init(M, DM, G, bx);
        if (pseamB) { pg8::Unit u4; S.next(0, u4);
            if (tid == 0) { unsigned* cnt = ctl + CW_SEAM_B + 64 * u4.pm;
                while (__hip_atomic_load(cnt, __ATOMIC_RELAXED, __HIP_MEMORY_SCOPE_AGENT) < 12u) __builtin_amdgcn_s_sleep(1);
                __builtin_amdgcn_fence(__ATOMIC_ACQUIRE, "agent"); asm volatile("s_waitcnt vmcnt(0)" ::: "memory"); }
            __syncthreads(); }
        pg8::EpiOutRes E{x, args.out, mod + 2 * DM};
        pg8::gemm_phase<pg8::EpiOutRes, pg8::StaticOrder, true, true>(L, g, S, E);
    } }
#if MK_STAMP >= 0
    GRID_BAR(); STAMP(5);
#if MK_STAMP == 22 || MK_STAMP == 23
    if (bx == 0 && tid == 0) args.out[0] += (MK_STAMP == 22) ? (float)(tk2e_ - tk2_) * 0.01f : (float)(ts_[3] - tk2e_) * 0.01f;
    if (false)
#endif
#if MK_STAMP == 20 || MK_STAMP == 21
    if (bx == 0 && tid == 0) { const unsigned long long tk = *(volatile LAS unsigned long long*)(L + 147392);
        args.out[0] += (MK_STAMP == 20) ? (float)(tk - ts_[4]) * 0.01f : (float)(ts_[5] - tk) * 0.01f; }
    if (false)
#endif
    if (bx == 0 && tid == 0) { const float T = (MK_STAMP >= 10) ? (float)((MK_STAMP == 13 ? ts_[4] : tsub_[(MK_STAMP - 9) & 3]) - tsub_[(MK_STAMP - 10) & 3]) * 0.01f : (float)(ts_[(MK_STAMP + 1) & 7] - ts_[MK_STAMP & 7]) * 0.01f; args.out[0] += (MK_STAMP == 5 ? (float)(ts_[5] - ts_[0]) * 0.01f : T); }
#endif
#undef IN
#undef BOTH
}

extern "C" void kernel_launch(void* const* d_in, const int* in_sizes, int n_in, void* d_out, int out_size, void* d_ws, size_t ws_size, hipStream_t stream) {
    static int grid = 0;
    if (grid == 0) {
        if (n_in != 12 || out_size != M * DM || ws_size < WS_END) { fprintf(stderr, "kernel_launch: unexpected shapes (n_in %d out %d ws %zu)\n", n_in, out_size, ws_size); grid = -1; return; }
        int dev = 0, cus = 0, per_cu = 0;
        if (hipGetDevice(&dev) != hipSuccess || hipDeviceGetAttribute(&cus, hipDeviceAttributeMultiprocessorCount, dev) != hipSuccess) { grid = -1; return; }
        if (hipFuncSetAttribute((const void*)hybrid_fwd, hipFuncAttributeMaxDynamicSharedMemorySize, LDS_BYTES) != hipSuccess) { fprintf(stderr, "kernel_launch: hipFuncSetAttribute failed\n"); grid = -1; return; }
        if (hipOccupancyMaxActiveBlocksPerMultiprocessor(&per_cu, (const void*)hybrid_fwd, NWAVES * 64, LDS_BYTES) != hipSuccess || per_cu < 1) { fprintf(stderr, "kernel_launch: occupancy query says %d\n", per_cu); per_cu = 1; }
        (void)hipGetLastError();
        grid = cus;
    }
    if (grid < 0) return;
#if MK_COOP
    if (hipMemsetAsync((char*)d_ws + WS_CTL, 0, CTL_ZERO_BYTES, stream) != hipSuccess) { fprintf(stderr, "kernel_launch: hipMemsetAsync failed\n"); return; }
#endif
    Args a{};
    for (int i = 0; i < 12; ++i) a.in[i] = (const float*)d_in[i];
    a.out = (float*)d_out; a.ws = (unsigned char*)d_ws;
#if MK_COOP
    a.ph_lo = 0; a.ph_hi = N_PHASES; a.coop = 1;
    void* kargs[] = {&a};
    hipError_t e = hipLaunchCooperativeKernel((const void*)hybrid_fwd, dim3(grid), dim3(NWAVES * 64), kargs, LDS_BYTES, stream);
    if (e != hipSuccess) fprintf(stderr, "kernel_launch: cooperative launch failed: %s (grid %d)\n", hipGetErrorString(e), grid);
#else
    for (int p = 0; p < N_PHASES; ++p) { a.ph_lo = p; a.ph_hi = p + 1; a.coop = 0;
        hipLaunchKernelGGL(hybrid_fwd, dim3(grid), dim3(NWAVES * 64), LDS_BYTES, stream, a); }
#endif
}
```

```cpp
#include <hip/hip_runtime.h>
#include <hip/hip_cooperative_groups.h>
#include <cstdio>
#include <cstdint>
namespace cg = cooperative_groups;
#ifndef MK_COOP
#define MK_COOP 1
#endif
#ifndef MK_EARLY
#define MK_EARLY true
#endif
#define PG8_SP2 true
#define PG8_ALIGN true
#ifndef MK_REP0
#define MK_REP0 1
#endif
#ifndef MK_REP1
#define MK_REP1 1
#endif
#ifndef MK_REP2
#define MK_REP2 1
#endif
#ifndef MK_REP3
#define MK_REP3 1
#endif
#ifndef MK_REP4
#define MK_REP4 1
#endif
#ifndef MK_REP3A
#define MK_REP3A 1
#endif
#ifndef MK_REP3P
#define MK_REP3P 1
#endif
#ifndef MK_STAMP
#define MK_STAMP -1
#endif
namespace pg8 {
#define PG8_LAS __attribute__((address_space(3)))
typedef unsigned short bf16_t;
typedef short bf16x8 __attribute__((ext_vector_type(8)));
typedef float f32x4 __attribute__((ext_vector_type(4)));
typedef unsigned u32x4 __attribute__((ext_vector_type(4)));
constexpr int BM = 256, BK = 64, HALF = 128, HTB = HALF * BK * 2  , STAGE_BYTES = 8 * HTB, NXCD = 8, WGM = 8;

__host__ __device__ __forceinline__ int lds_byte(int r, int c) { const int st = (r >> 4) * 2 + (c >> 5), rr = r & 15, cc = c & 31, ob = rr * 64 + cc * 2; return st * 1024 + (ob ^ (((ob >> 9) & 1) << 5)); }
__host__ __device__ __forceinline__ void stage_rc(int b, int& R, int& C) { const int st = b / 1024, sb = b % 1024, swz = sb ^ (((sb >> 9) & 1) << 5); R = (st >> 1) * 16 + swz / 64; C = (st & 1) * 32 + (swz % 64) / 2; }
__host__ __device__ __forceinline__ int perm32(int rho) { const int n = rho >> 4, i = rho & 15; return 8 * (i >> 2) + 4 * n + (i & 3); }

struct Unit { int pm, pn; };
struct Gemm { const bf16_t* A; const bf16_t* Bt; int M, N, K; };

struct StaticOrder {
    int nM, nN, nwg, G, c;
    __host__ __device__ void init(int M, int N, int G_, int c_) { nM = M / BM; nN = N / BM; nwg = nM * nN; G = G_; c = c_; }
    __host__ __device__ bool next(int i, Unit& u) const {
        const long L = (long)i * G + c; if (L >= nwg) return false;
        int wgid = (int)L; { const int q = nwg / NXCD, r = nwg % NXCD, xcd = wgid % NXCD, off = wgid / NXCD; wgid = (xcd < r ? xcd * (q + 1) : r * (q + 1) + (xcd - r) * q) + off; }
        const int nig = WGM * nN, gid = wgid / nig, fm = gid * WGM, gsz = (nM - fm) < WGM ? (nM - fm) : WGM;
        u.pm = fm + ((wgid % nig) % gsz); u.pn = (wgid % nig) / gsz; return true;
    }
    __device__ __forceinline__ void a_ready(const Unit&) const {}
    __device__ __forceinline__ void done(const Unit&) const {}
};
__device__ __forceinline__ unsigned cvt_pk_bf16(float lo, float hi) { unsigned r; asm volatile("v_cvt_pk_bf16_f32 %0, %1, %2" : "=v"(r) : "v"(lo), "v"(hi)); return r; }
typedef float f32x2 __attribute__((ext_vector_type(2)));
__device__ __forceinline__ float silu_f(float v) { return v * __builtin_amdgcn_rcpf(1.0f + __builtin_amdgcn_exp2f(-1.4426950408889634f * v)); }
constexpr float QSCALE = 0.125f * 1.4426950408889634f;
__device__ __forceinline__ size_t hm_off(int row, int head) { return ((size_t)((row >> 11) * 8 + head) * 2048 + (row & 2047)) * 64; }
struct EpiInProj {
    static constexpr bool PERM = true, AFTER_DRAIN = false;
    __amdgpu_buffer_rsrc_t rs; size_t stride; const float* gq; const float* gk;
    __device__ __forceinline__ void operator()(const f32x4 (&acc)[2][2][4][2], const Unit& u, int wr, int wc, int fr, int fq) const {
        const int type = u.pn >> 1;
        const size_t O = (size_t)type * stride;
        const int row0 = u.pm * BM + wr * 64 + fr;
        const int col0 = (u.pn & 1) * 256 + wc * 64 + 8 * fq;
        if (type < 2) {
            const float* g = type == 0 ? gq : gk; const float s = type == 0 ? QSCALE : 1.0f;
            f32x4 gs[2][2];
#pragma unroll
            for (int bj = 0; bj < 2; ++bj)
#pragma unroll
                for (int n = 0; n < 2; ++n) gs[bj][n] = *(const f32x4*)(g + 32 * bj + 8 * fq + 4 * n) * s;
#pragma unroll
            for (int ai = 0; ai < 2; ++ai)
#pragma unroll
                for (int m = 0; m < 4; ++m) {
                    float ss = 0.f;
#pragma unroll
                    for (int bj = 0; bj < 2; ++bj)
#pragma unroll
                        for (int n = 0; n < 2; ++n) { const f32x4 x = acc[ai][bj][m][n]; ss += (x[0] * x[0] + x[1] * x[1]) + (x[2] * x[2] + x[3] * x[3]); }
                    ss += __shfl_xor(ss, 16); ss += __shfl_xor(ss, 32);
                    const float inv = 1.0f / sqrtf(ss * (1.0f / 64.0f) + 1e-6f);
                    const size_t rowp = O + hm_off(row0 + ai * HALF + m * 16, (u.pn & 1) * 4 + wc) + 8 * fq;
#pragma unroll
                    for (int bj = 0; bj < 2; ++bj) { const f32x4 v0 = acc[ai][bj][m][0] * inv * gs[bj][0], v1 = acc[ai][bj][m][1] * inv * gs[bj][1];
                        u32x4 w; w.x = cvt_pk_bf16(v0[0], v0[1]); w.y = cvt_pk_bf16(v0[2], v0[3]); w.z = cvt_pk_bf16(v1[0], v1[1]); w.w = cvt_pk_bf16(v1[2], v1[3]);
                        __builtin_amdgcn_raw_buffer_store_b128(w, rs, (unsigned)((rowp + bj * 32) * 2), 0, 16); }
                }
        } else {
            const bool act = (type == 3) || (type == 5);
#pragma unroll
            for (int ai = 0; ai < 2; ++ai)
#pragma unroll
                for (int m = 0; m < 4; ++m) {
                    const int row = row0 + ai * HALF + m * 16;
                    const size_t rowp = (type <= 3) ? O + hm_off(row, (u.pn & 1) * 4 + wc) + 8 * fq : O + ((size_t)((u.pn & 1) * 2 + (wc >> 1)) * 16384 + row) * 128 + (wc & 1) * 64 + 8 * fq;
#pragma unroll
                    for (int bj = 0; bj < 2; ++bj) { f32x4 v0 = acc[ai][bj][m][0], v1 = acc[ai][bj][m][1];
                        if (act) { v0 = (f32x4){silu_f(v0[0]), silu_f(v0[1]), silu_f(v0[2]), silu_f(v0[3])}; v1 = (f32x4){silu_f(v1[0]), silu_f(v1[1]), silu_f(v1[2]), silu_f(v1[3])}; }
                        u32x4 w; w.x = cvt_pk_bf16(v0[0], v0[1]); w.y = cvt_pk_bf16(v0[2], v0[3]); w.z = cvt_pk_bf16(v1[0], v1[1]); w.w = cvt_pk_bf16(v1[2], v1[3]);
                        __builtin_amdgcn_raw_buffer_store_b128(w, rs, (unsigned)((rowp + bj * 32) * 2), 0, 16); }
                }
        }
    }
};
struct EpiOutRes {
    static constexpr bool PERM = false, AFTER_DRAIN = false;
    const float* x; float* out; const float* gate;
    __device__ __forceinline__ void operator()(const f32x4 (&acc)[2][2][4][2], const Unit& u, int wr, int wc, int fr, int fq) const {
        const int col0 = u.pn * BM + wc * 32 + 4 * fq;
        const float* gp = gate + (size_t)((u.pm * BM) >> 11) * 3072 + col0;
        f32x4 gv[2][2];
#pragma unroll
        for (int bj = 0; bj < 2; ++bj)
#pragma unroll
            for (int n = 0; n < 2; ++n) gv[bj][n] = *(const f32x4*)(gp + bj * HALF + n * 16);
#pragma unroll
        for (int ai = 0; ai < 2; ++ai) {
            f32x4 xv[4][2][2];
#pragma unroll
            for (int m = 0; m < 4; ++m) { const size_t off = (size_t)(u.pm * BM + ai * HALF + wr * 64 + m * 16 + fr) * 1024 + col0;
#pragma unroll
                for (int bj = 0; bj < 2; ++bj)
#pragma unroll
                    for (int n = 0; n < 2; ++n) xv[m][bj][n] = __builtin_nontemporal_load((const f32x4*)(x + off + bj * HALF + n * 16)); }
            asm volatile("" ::: "memory");
#pragma unroll
            for (int m = 0; m < 4; ++m) { const size_t off = (size_t)(u.pm * BM + ai * HALF + wr * 64 + m * 16 + fr) * 1024 + col0;
#pragma unroll
                for (int bj = 0; bj < 2; ++bj)
#pragma unroll
                    for (int n = 0; n < 2; ++n) *(f32x4*)(out + off + bj * HALF + n * 16) = xv[m][bj][n] + gv[bj][n] * acc[ai][bj][m][n]; }
        }
    }
};
template <class Epi, class Sched, bool ALIGN_EPI = false, bool SP2 = false>
__device__ __forceinline__ void gemm_phase(PG8_LAS unsigned char* lds, const Gemm g, const Sched& S, const Epi& E) {
    const int tid = threadIdx.x, wid = __builtin_amdgcn_readfirstlane(tid >> 6), lane = tid & 63, wr = wid >> 2, wc = wid & 3, fr = lane & 15, fq = lane >> 4;
    const int K = g.K, nt = K / BK;
    unsigned voffA[2], voffB[2];
#pragma unroll
    for (int i = 0; i < 2; ++i) { int R, C; stage_rc(tid * 16 + i * 8192, R, C); const int Rb = Epi::PERM ? ((R & ~31) + perm32(R & 31)) : R;
        voffA[i] = (unsigned)(R * K + C) * 2u; voffB[i] = (unsigned)(Rb * K + C) * 2u; }
    const size_t kstep = (size_t)(BK * 2);
    const size_t hstep = (size_t)HALF * K * 2;
    const size_t tstep = 2 * hstep;
    const unsigned ldsw = (unsigned)wid * 1024u;
    const int aoff = lds_byte(wr * 64 + fr, fq * 8), boff = lds_byte(wc * 32 + fr, fq * 8);
#define PG8_SA(b, h) (((b) * 2 + (h)) * HTB)
#define PG8_SB(b, h) ((4 + (b) * 2 + (h)) * HTB)
#define PG8_STAGE(bufoff, gbase, voff) do { _Pragma("unroll") for (int _i = 0; _i < 2; ++_i) \
        __builtin_amdgcn_global_load_lds((const unsigned*)((const char*)(gbase) + (voff)[_i]), (PG8_LAS unsigned*)(lds + (bufoff) + ldsw + _i * 8192), 16, 0, 0); } while (0)
#define PG8_LDA(dst, b, h) do { _Pragma("unroll") for (int m = 0; m < 4; ++m) _Pragma("unroll") for (int k = 0; k < 2; ++k) dst[m][k] = *(const PG8_LAS bf16x8*)(lds + PG8_SA(b, h) + aoff + m * 2048 + k * 1024); } while (0)
#define PG8_LDB(dst, b, h) do { _Pragma("unroll") for (int n = 0; n < 2; ++n) _Pragma("unroll") for (int k = 0; k < 2; ++k) dst[n][k] = *(const PG8_LAS bf16x8*)(lds + PG8_SB(b, h) + boff + n * 2048 + k * 1024); } while (0)
#define PG8_MMA(ai, bj, At, Bt) do { __builtin_amdgcn_s_setprio(1); _Pragma("unroll") for (int m = 0; m < 4; ++m) _Pragma("unroll") for (int n = 0; n < 2; ++n) _Pragma("unroll") for (int k = 0; k < 2; ++k) \
        acc[ai][bj][m][n] = __builtin_amdgcn_mfma_f32_16x16x32_bf16(Bt[n][k], At[m][k], acc[ai][bj][m][n], 0, 0, 0); __builtin_amdgcn_s_setprio(0); } while (0)
#define PG8_WAIT_V(n) asm volatile("s_waitcnt vmcnt(" #n ")" ::: "memory")
#define PG8_WAIT_L(n) asm volatile("s_waitcnt lgkmcnt(" #n ")" ::: "memory")
#define PG8_BAR __builtin_amdgcn_s_barrier()
#define PG8_SCHED __builtin_amdgcn_sched_barrier(0)
    Unit cur, nxt; int ui = 0;
    if (!S.next(0, cur)) return;
    f32x4 acc[2][2][4][2];
#pragma unroll
    for (int a = 0; a < 2; ++a)
#pragma unroll
        for (int b = 0; b < 2; ++b)
#pragma unroll
            for (int m = 0; m < 4; ++m)
#pragma unroll
                for (int n = 0; n < 2; ++n) acc[a][b][m][n] = (f32x4){0.f, 0.f, 0.f, 0.f};
    bf16x8 At[4][2], B0[2][2], B1[2][2];
    const char* cA = (const char*)g.A + (size_t)cur.pm * tstep; const char* cB = (const char*)g.Bt + (size_t)cur.pn * tstep;
    S.a_ready(cur);
    if constexpr (SP2) {
        PG8_STAGE(PG8_SB(0, 0), cB, voffB); PG8_STAGE(PG8_SB(0, 1), cB + hstep, voffB); PG8_STAGE(PG8_SA(0, 0), cA, voffA); PG8_STAGE(PG8_SA(0, 1), cA + hstep, voffA);
        if (wr == 1) PG8_BAR;
        PG8_WAIT_V(2); PG8_BAR;
        PG8_STAGE(PG8_SB(1, 0), cB + kstep, voffB); PG8_STAGE(PG8_SA(1, 0), cA + kstep, voffA); PG8_STAGE(PG8_SB(1, 1), cB + hstep + kstep, voffB);
        PG8_WAIT_V(6); PG8_BAR;
    } else {
        PG8_STAGE(PG8_SB(0, 0), cB, voffB); PG8_STAGE(PG8_SA(0, 0), cA, voffA); PG8_STAGE(PG8_SB(0, 1), cB + hstep, voffB); PG8_STAGE(PG8_SA(0, 1), cA + hstep, voffA);
        if (wr == 1) PG8_BAR;
        PG8_WAIT_V(4); PG8_BAR;
        PG8_STAGE(PG8_SB(1, 0), cB + kstep, voffB); PG8_STAGE(PG8_SA(1, 0), cA + kstep, voffA); PG8_STAGE(PG8_SB(1, 1), cB + hstep + kstep, voffB);
        PG8_WAIT_V(6); PG8_BAR;
    }
    for (;;) {
        const bool has_next = S.next(ui + 1, nxt);
        const char* nA = has_next ? (const char*)g.A + (size_t)nxt.pm * tstep : cA; const char* nB = has_next ? (const char*)g.Bt + (size_t)nxt.pn * tstep : cB;
        for (int t = 0; t < nt; t += 2) {
            const bool last = (t == nt - 2);
            const char* a1 = cA + (size_t)(t + 1) * kstep;
            const char* a2 = last ? nA : cA + (size_t)(t + 2) * kstep; const char* b2 = last ? nB : cB + (size_t)(t + 2) * kstep;
            const char* a3 = a2 + kstep; const char* b3 = b2 + kstep;
            if (last && has_next) S.a_ready(nxt);
            if constexpr (SP2) {
            PG8_LDB(B0, 0, 0); PG8_LDB(B1, 0, 1); PG8_SCHED; PG8_LDA(At, 0, 0); PG8_STAGE(PG8_SA(1, 1), a1 + hstep, voffA);
            PG8_WAIT_V(8); PG8_WAIT_L(0); PG8_BAR; PG8_MMA(0, 0, At, B0); PG8_MMA(0, 1, At, B1); PG8_BAR; PG8_SCHED;
            PG8_LDA(At, 0, 1); PG8_STAGE(PG8_SB(0, 0), b2, voffB); PG8_STAGE(PG8_SB(0, 1), b2 + hstep, voffB); PG8_STAGE(PG8_SA(0, 0), a2, voffA);
            PG8_WAIT_V(8); PG8_WAIT_L(0); PG8_BAR; PG8_MMA(1, 0, At, B0); PG8_MMA(1, 1, At, B1); PG8_BAR; PG8_SCHED;
            PG8_LDB(B0, 1, 0); PG8_LDB(B1, 1, 1); PG8_SCHED; PG8_LDA(At, 1, 0); PG8_STAGE(PG8_SA(0, 1), a2 + hstep, voffA);
            PG8_WAIT_V(8); PG8_WAIT_L(0); PG8_BAR; PG8_MMA(0, 0, At, B0); PG8_MMA(0, 1, At, B1); PG8_BAR; PG8_SCHED;
            PG8_LDA(At, 1, 1); PG8_STAGE(PG8_SB(1, 0), b3, voffB); PG8_STAGE(PG8_SB(1, 1), b3 + hstep, voffB); PG8_STAGE(PG8_SA(1, 0), a3, voffA);
            PG8_WAIT_V(8); PG8_WAIT_L(0); PG8_BAR; PG8_MMA(1, 0, At, B0); PG8_MMA(1, 1, At, B1); PG8_BAR; PG8_SCHED;
            } else {
            PG8_LDB(B0, 0, 0); PG8_SCHED; PG8_LDA(At, 0, 0); PG8_STAGE(PG8_SA(1, 1), a1 + hstep, voffA);
            PG8_WAIT_L(8); PG8_BAR; PG8_WAIT_L(0); PG8_MMA(0, 0, At, B0); PG8_BAR; PG8_SCHED;
            PG8_LDB(B1, 0, 1); PG8_STAGE(PG8_SB(0, 0), b2, voffB);
            PG8_BAR; PG8_WAIT_L(0); PG8_MMA(0, 1, At, B1); PG8_BAR;
            PG8_LDA(At, 0, 1); PG8_STAGE(PG8_SA(0, 0), a2, voffA);
            PG8_BAR; PG8_WAIT_L(0); PG8_MMA(1, 0, At, B0); PG8_BAR; PG8_SCHED;
            PG8_STAGE(PG8_SB(0, 1), b2 + hstep, voffB);
            PG8_WAIT_V(6); PG8_BAR; PG8_MMA(1, 1, At, B1); PG8_BAR;
            PG8_LDB(B0, 1, 0); PG8_SCHED; PG8_LDA(At, 1, 0); PG8_STAGE(PG8_SA(0, 1), a2 + hstep, voffA);
            PG8_WAIT_L(8); PG8_BAR; PG8_WAIT_L(0); PG8_MMA(0, 0, At, B0); PG8_BAR; PG8_SCHED;
            PG8_LDB(B1, 1, 1); PG8_STAGE(PG8_SB(1, 0), b3, voffB);
            PG8_BAR; PG8_WAIT_L(0); PG8_MMA(0, 1, At, B1); PG8_BAR;
            PG8_LDA(At, 1, 1); PG8_STAGE(PG8_SA(1, 0), a3, voffA);
            PG8_BAR; PG8_WAIT_L(0); PG8_MMA(1, 0, At, B0); PG8_BAR; PG8_SCHED;
            PG8_STAGE(PG8_SB(1, 1), b3 + hstep, voffB);
            PG8_WAIT_V(6); PG8_BAR; PG8_MMA(1, 1, At, B1); PG8_BAR;
            }
        }
        if constexpr (ALIGN_EPI) { if (wr == 0) PG8_BAR; }
#if MK_STAMP == 20 || MK_STAMP == 21 || MK_STAMP == 22 || MK_STAMP == 23
        if (threadIdx.x == 0) *(volatile PG8_LAS unsigned long long*)(lds + 147392) = __builtin_amdgcn_s_memrealtime();
#endif
        if constexpr (!Epi::AFTER_DRAIN) { E(acc, cur, wr, wc, fr, fq); S.done(cur); }
        if (!has_next) break;
#pragma unroll
        for (int a = 0; a < 2; ++a)
#pragma unroll
            for (int b = 0; b < 2; ++b)
#pragma unroll
                for (int m = 0; m < 4; ++m)
#pragma unroll
                    for (int n = 0; n < 2; ++n) acc[a][b][m][n] = (f32x4){0.f, 0.f, 0.f, 0.f};
        cur = nxt; cA = nA; cB = nB; ++ui;
        if constexpr (ALIGN_EPI) { if (wr == 1) PG8_BAR; }
    }
    PG8_WAIT_V(0);
    if constexpr (!ALIGN_EPI) { if (wr == 0) PG8_BAR; }
    PG8_BAR;
    if constexpr (Epi::AFTER_DRAIN) { E.fused(acc, cur, wr, wc, fr, fq, lds, wid, lane); S.done(cur); }
#undef PG8_SA
#undef PG8_SB
#undef PG8_STAGE
#undef PG8_LDA
#undef PG8_LDB
#undef PG8_MMA
#undef PG8_WAIT_V
#undef PG8_WAIT_L
#undef PG8_BAR
#undef PG8_SCHED
}
}

constexpr int NWAVES = 8;
constexpr int BATCH = 8, SEQ = 2048, DM = 1024, M = BATCH * SEQ, DIN = 3072, DH = 64, NH = 8, DA = 512;
constexpr size_t MiB = 1u << 20;
constexpr size_t WS_CTL = 0, CTL_ZERO_BYTES = 64 * 1024;
constexpr size_t WS_MOD = 1 * MiB;
constexpr size_t WS_WIN = 2 * MiB;
constexpr size_t WS_WOUT = 8 * MiB;
constexpr size_t WS_WPOOL = 10 * MiB;
constexpr size_t WS_XN = 16 * MiB;
constexpr size_t WS_PROJ = 48 * MiB;
constexpr size_t PROJ_STRIDE = (size_t)M * 512;
constexpr size_t WS_CAT = 144 * MiB;
constexpr size_t WS_END = 176 * MiB;
constexpr int RING_BYTES = 131072, LDS_BYTES = 147456, MISC_OFF = LDS_BYTES - 128;
constexpr int CW_BAR = 1024;

#define GAS __attribute__((address_space(1)))
#define LAS __attribute__((address_space(3)))
typedef unsigned short bf16;
typedef unsigned v4u __attribute__((ext_vector_type(4)));
typedef unsigned v2u __attribute__((ext_vector_type(2)));
typedef float f32x4 __attribute__((ext_vector_type(4)));
typedef float f32x16 __attribute__((ext_vector_type(16)));
typedef short bf16x8 __attribute__((ext_vector_type(8)));
typedef short s16x4 __attribute__((ext_vector_type(4)));
#define LDS_WAIT() asm volatile("s_waitcnt lgkmcnt(0)" ::: "memory")
#define VM_WAIT() asm volatile("s_waitcnt vmcnt(0)" ::: "memory")
__device__ __forceinline__ unsigned pk2(float lo, float hi) { return pg8::cvt_pk_bf16(lo, hi); }
__device__ __forceinline__ float bf_lo(unsigned u) { return __builtin_bit_cast(float, u << 16); }
__device__ __forceinline__ float bf_hi(unsigned u) { return __builtin_bit_cast(float, u & 0xffff0000u); }
#define XB_TMO      128
#define XB_XCNT(j)  (256  + 64 * (j))
#define XB_XSUB(j)  (1280 + 64 * (j))
#define XB_XGEN(j)  (2304 + 64 * (j))
#define XB_TOP      3328
#define XB_TOPGEN   3392
#define XCD_BAR_WORDS 3456
#define XB_SPIN_CAP (1u << 18)

__device__ __forceinline__ unsigned xb_ld(unsigned* p)              { return __hip_atomic_load(p, __ATOMIC_RELAXED, __HIP_MEMORY_SCOPE_AGENT); }
__device__ __forceinline__ unsigned xb_add(unsigned* p, unsigned v) { return __hip_atomic_fetch_add(p, v, __ATOMIC_RELAXED, __HIP_MEMORY_SCOPE_AGENT); }
__device__ __forceinline__ unsigned xb_xcc_id() { return (unsigned)__builtin_amdgcn_s_getreg((3 << 11) | 20) & 0xFu; }
#define XB_SPIN(cond, bar) do { unsigned _sp = 0; while (cond) { __builtin_amdgcn_s_sleep(1); \
    if ((++_sp & 255u) == 0u) { if (xb_ld(&(bar)[XB_TMO])) break; if (_sp > XB_SPIN_CAP) { atomicAdd(&(bar)[XB_TMO], 1u); break; } } } } while (0)

struct XcdBarrier {
    unsigned* bar; unsigned x;
    volatile LAS unsigned* st;
};

__device__ __forceinline__ XcdBarrier xcd_barrier_post(unsigned* bar, volatile LAS unsigned* st) {
    XcdBarrier b; b.bar = bar; b.x = xb_xcc_id(); b.st = st;
    if (threadIdx.x == 0) (void)xb_add(&bar[XB_XCNT(b.x)], 1u);
    return b;
}
__device__ __forceinline__ void xcd_barrier_complete(unsigned* bar, unsigned x, unsigned& nloc, unsigned& nx) {
    const unsigned G = gridDim.x * gridDim.y * gridDim.z;
    unsigned sum, cnt, mine, sp = 0u;
    for (;;) {
        sum = 0u; cnt = 0u; mine = 0u;
#pragma unroll
        for (unsigned j = 0; j < 16; ++j) { const unsigned c = xb_ld(&bar[XB_XCNT(j)]); sum += c; cnt += (c > 0u) ? 1u : 0u; mine = (j == x) ? c : mine; }
        if (sum == G) break;
        __builtin_amdgcn_s_sleep(1);
        if ((++sp & 255u) == 0u) { if (xb_ld(&bar[XB_TMO])) break; if (sp > XB_SPIN_CAP) { atomicAdd(&bar[XB_TMO], 1u); break; } }
    }
    nloc = mine > 0u ? mine : 1u; nx = cnt > 0u ? cnt : 1u;
}

__device__ __forceinline__ void xcd_barrier(const XcdBarrier& b) {
    asm volatile("s_waitcnt vmcnt(0)" ::: "memory");
    __syncthreads();
    if (threadIdx.x == 0) {
        unsigned* bar = b.bar;
        __builtin_amdgcn_s_waitcnt(0);
        unsigned nloc = b.st[0], nx = b.st[1];
        if (nloc == 0u) { xcd_barrier_complete(bar, b.x, nloc, nx); b.st[0] = nloc; b.st[1] = nx; }
        const unsigned old = xb_add(&bar[XB_XSUB(b.x)], 1u);
        const unsigned gen = old / nloc;
        if (old + 1u == (gen + 1u) * nloc) {
            __builtin_amdgcn_fence(__ATOMIC_RELEASE, "agent");
            asm volatile("s_waitcnt vmcnt(0)" ::: "memory");
            const unsigned og = xb_add(&bar[XB_TOP], 1u);
            const unsigned tg = og / nx;
            if (og + 1u == (tg + 1u) * nx) xb_add(&bar[XB_TOPGEN], 1u);
            else XB_SPIN(xb_ld(&bar[XB_TOPGEN]) == tg, bar);
            __builtin_amdgcn_fence(__ATOMIC_ACQUIRE, "agent");
            xb_add(&bar[XB_XGEN(b.x)], 1u);
            asm volatile("s_waitcnt vmcnt(0)" ::: "memory");
        } else {
            XB_SPIN(xb_ld(&bar[XB_XGEN(b.x)]) == gen, bar);
            __builtin_amdgcn_fence(__ATOMIC_ACQUIRE, "agent");
            asm volatile("s_waitcnt vmcnt(0)" ::: "memory");
        }
    }
    __syncthreads();
}

#ifndef MK_SEAMB
#define MK_SEAMB 1
#endif
__device__ __forceinline__ void cat_store16(bf16* CAT, size_t elem, v4u w) {
#if MK_SEAMB
    const __amdgpu_buffer_rsrc_t rs = __builtin_amdgcn_make_buffer_rsrc(CAT, 0, (int)((size_t)M * DM * 2), 0x00020000);
    __builtin_amdgcn_raw_buffer_store_b128(w, rs, (unsigned)(elem * 2), 0, 16);
#else
    *(v4u*)(CAT + elem) = w;
#endif
}
namespace att {
__device__ __forceinline__ void glds16(const void* gsrc, unsigned lds_dst) { unsigned keep;
    asm volatile("s_mov_b32 %0, m0\n\ts_mov_b32 m0, %2\n\ts_nop 0\n\tglobal_load_lds_dwordx4 %1, off\n\ts_mov_b32 m0, %0" : "=&s"(keep) : "v"(gsrc), "s"(lds_dst) : "memory"); }
typedef short v4i16_t __attribute__((ext_vector_type(4)));
__device__ __forceinline__ s16x4 vtr(LAS const char* p) { return __builtin_bit_cast(s16x4, __builtin_amdgcn_ds_read_tr16_b64_v4i16((LAS v4i16_t*)p)); }
constexpr int TILEB = 8192, VOFF = 4096, STAGE_OFF = 12 * TILEB, STAGE_B = 4608;
#ifndef ATT_HIST
#define ATT_HIST 0
#endif

template <bool DIAG>
__device__ __forceinline__ void tile_weights(f32x16& p0, float& carry, unsigned (&pw)[2][4], int kv0, int qabs, int hi) {
    float G[4];
#pragma unroll
    for (int i = 0; i < 4; ++i) {
        float rr[4], be[4];
#pragma unroll
        for (int j = 0; j < 4; ++j) {
            const float e = __builtin_amdgcn_exp2f(p0[4 * i + j]);
            float rv = __builtin_amdgcn_rcpf(1.0f + e); float bv = e * rv;
            if (DIAG) { const int kv = kv0 + 8 * i + 4 * hi + j; if (kv >= qabs) { rv = 1.0f; bv = 0.0f; } }
            rr[j] = rv; be[j] = bv;
        }
        const float s2 = rr[3], s1 = s2 * rr[2], s0 = s1 * rr[1];
        G[i] = s0 * rr[0];
        p0[4 * i + 3] = be[3]; p0[4 * i + 2] = be[2] * s2; p0[4 * i + 1] = be[1] * s1; p0[4 * i] = be[0] * s0;
    }
    float F[4]; float run = carry;
#pragma unroll
    for (int p = 3; p >= 0; --p) {
        auto sw = __builtin_amdgcn_permlane32_swap(__float_as_uint(G[p]), __float_as_uint(G[p]), false, false);
        const float g0 = __uint_as_float(sw[0]), g1 = __uint_as_float(sw[1]);
        F[p] = run * (hi ? 1.0f : g1);
        run = run * (g0 * g1);
    }
    carry = run;
#pragma unroll
    for (int i = 0; i < 4; ++i) { const float f = F[i];
        pw[i >> 1][2 * (i & 1)] = pk2(p0[4 * i] * f, p0[4 * i + 1] * f); pw[i >> 1][2 * (i & 1) + 1] = pk2(p0[4 * i + 2] * f, p0[4 * i + 3] * f); }
}

template <bool EARLY>
__device__ __forceinline__ void attn_pass(int b, int h, int qb0, const bf16* Q, const bf16* K, const bf16* V, const bf16* GA, bf16* CAT, LAS char* shm) {
    const int tid = threadIdx.x, lane = tid & 63, r32 = lane & 31, hi = lane >> 5; const int wid = __builtin_amdgcn_readfirstlane(tid >> 6);
    const size_t hb = ((size_t)(b * NH + h) * SEQ) * DH;
    const bf16* Qh = Q + hb; const bf16* Kh = K + hb; const bf16* Vh = V + hb;
    const unsigned lds0 = (unsigned)__builtin_amdgcn_readfirstlane((int)(unsigned)(uintptr_t)shm);
    const int wb = qb0 - ATT_HIST > 0 ? qb0 - ATT_HIST : 0, nw = qb0 + 8 - wb;
    const bf16* ksrc = Kh + (size_t)(lane >> 3) * DH + (((lane & 7) ^ ((lane >> 3) & 7)) * 8);
    const bf16* vsrc = Vh + (size_t)(lane >> 2) * DH + (lane & 3) * 8;
    for (int p = wid; p < nw * 8; p += NWAVES) {
        const int w = p >> 3, pc = p & 7; const size_t trow = (size_t)(wb + w) * 32;
        const unsigned dst = lds0 + w * TILEB + pc * 1024;
        if (pc < 4) glds16(ksrc + (trow + 8 * pc) * DH, dst);
        else glds16(vsrc + (trow + 16 * ((pc - 4) & 1)) * DH + 32 * ((pc - 4) >> 1), dst);
    }
    const int qblk = qb0 + wid, q0 = qblk * 32, qabs = q0 + r32;
    bf16x8 qr[4];
#pragma unroll
    for (int d0 = 0; d0 < 4; ++d0) qr[d0] = *reinterpret_cast<const bf16x8*>(&Qh[(size_t)qabs * DH + d0 * 16 + hi * 8]);
    const size_t tok0 = (size_t)b * SEQ + q0;
    v4u gpre[2][2];
#pragma unroll
    for (int dh = 0; dh < 2; ++dh)
#pragma unroll
        for (int k = 0; k < 2; ++k) gpre[dh][k] = __builtin_nontemporal_load((const v4u*)(GA + hb + (size_t)(q0 + 16 * k + (lane >> 2)) * DH + 32 * dh + (lane & 3) * 8));
    asm volatile("s_waitcnt vmcnt(0)" ::: "memory");
    __syncthreads();
    f32x16 o[2]; o[0] = f32x16{}; o[1] = f32x16{};
    float carry = 1.0f; bool dead = false;
    LAS const char* kp0 = shm + r32 * 128;
    LAS const char* vp0 = shm + VOFF + ((lane >> 4) & 1) * 32 + (lane & 3) * 8 + (4 * hi + ((lane & 15) >> 2)) * 64;
#define ATT_TILE(DG) do { \
        const int w = t - wb; LAS const char* kp = kp0 + w * TILEB; f32x16 p0 = f32x16{}; \
        _Pragma("unroll") for (int d0 = 0; d0 < 4; ++d0) { const bf16x8 kf = *(LAS const bf16x8*)(kp + (((2 * d0 + hi) ^ (r32 & 7)) * 16)); p0 = __builtin_amdgcn_mfma_f32_32x32x16_bf16(kf, qr[d0], p0, 0, 0, 0); } \
        unsigned pw[2][4]; tile_weights<DG>(p0, carry, pw, t * 32, qabs, hi); \
        LAS const char* vp = vp0 + w * TILEB; \
        _Pragma("unroll") for (int dh = 0; dh < 2; ++dh) _Pragma("unroll") for (int ks = 0; ks < 2; ++ks) { \
            const s16x4 lo = vtr(vp + dh * 2048 + ks * 1024), hh = vtr(vp + dh * 2048 + ks * 1024 + 512); \
            const bf16x8 vf = (bf16x8){lo[0], lo[1], lo[2], lo[3], hh[0], hh[1], hh[2], hh[3]}; \
            const v4u pwv = (v4u){pw[ks][0], pw[ks][1], pw[ks][2], pw[ks][3]}; \
            o[dh] = __builtin_amdgcn_mfma_f32_32x32x16_bf16(vf, __builtin_bit_cast(bf16x8, pwv), o[dh], 0, 0, 0); } } while (0)
    int t = qblk;
    ATT_TILE(true);
    if (EARLY && __all(carry < 1e-30f)) dead = true;
    if (!dead) for (t = qblk - 1; t >= wb; --t) {
        ATT_TILE(false);
        if (EARLY) { if (__all(carry < 1e-30f)) { dead = true; break; } }
    }
#undef ATT_TILE
    if (!dead) {
        for (t = wb - 1; t >= 0; --t) {
            f32x16 p0 = f32x16{};
#pragma unroll
            for (int d0 = 0; d0 < 4; ++d0) {
                const bf16x8 kf = *reinterpret_cast<const bf16x8*>(&Kh[((size_t)t * 32 + r32) * DH + (2 * d0 + hi) * 8]);
                p0 = __builtin_amdgcn_mfma_f32_32x32x16_bf16(kf, qr[d0], p0, 0, 0, 0);
            }
            unsigned pw[2][4];
            tile_weights<false>(p0, carry, pw, t * 32, qabs, hi);
#pragma unroll
            for (int dh = 0; dh < 2; ++dh)
#pragma unroll
                for (int ks = 0; ks < 2; ++ks) {
                    bf16x8 vf;
#pragma unroll
                    for (int j = 0; j < 8; ++j) vf[j] = (short)Vh[((size_t)t * 32 + 16 * ks + 8 * (j >> 2) + 4 * hi + (j & 3)) * DH + 32 * dh + r32];
                    const v4u pwv = (v4u){pw[ks][0], pw[ks][1], pw[ks][2], pw[ks][3]};
                    o[dh] = __builtin_amdgcn_mfma_f32_32x32x16_bf16(vf, __builtin_bit_cast(bf16x8, pwv), o[dh], 0, 0, 0);
                }
            if (EARLY) { if (__all(carry < 1e-30f)) break; }
        }
    }
    {
        LAS char* st = shm + STAGE_OFF + wid * STAGE_B;
        const int rr = lane >> 2, ch = lane & 3;
#pragma unroll
        for (int dh = 0; dh < 2; ++dh) {
#pragma unroll
            for (int i = 0; i < 4; ++i) *(LAS f32x4*)(st + r32 * 144 + (8 * i + 4 * hi) * 4) = (f32x4){o[dh][4 * i], o[dh][4 * i + 1], o[dh][4 * i + 2], o[dh][4 * i + 3]};
            asm volatile("s_waitcnt lgkmcnt(0)" ::: "memory");
#pragma unroll
            for (int k = 0; k < 2; ++k) { const int row = 16 * k + rr;
                const f32x4 a0 = *(LAS const f32x4*)(st + row * 144 + ch * 32), a1 = *(LAS const f32x4*)(st + row * 144 + ch * 32 + 16);
                const v4u g = gpre[dh][k];
                v4u w; w.x = pk2(a0[0] * bf_lo(g.x), a0[1] * bf_hi(g.x)); w.y = pk2(a0[2] * bf_lo(g.y), a0[3] * bf_hi(g.y));
                w.z = pk2(a1[0] * bf_lo(g.z), a1[1] * bf_hi(g.z)); w.w = pk2(a1[2] * bf_lo(g.w), a1[3] * bf_hi(g.w));
                cat_store16(CAT, (tok0 + row) * DM + h * DH + 32 * dh + ch * 8, w); }
            asm volatile("s_waitcnt lgkmcnt(0)" ::: "memory");
        }
    }
    asm volatile("s_waitcnt vmcnt(0)" ::: "memory");
    __syncthreads();
}
}

namespace pool {
constexpr int UP = 272;
constexpr int UROWS = 272;
constexpr int WOFF = UROWS * UP;
typedef short v4i16_t __attribute__((ext_vector_type(4)));
__device__ __forceinline__ s16x4 vtr(LAS const char* p) { return __builtin_bit_cast(s16x4, __builtin_amdgcn_ds_read_tr16_b64_v4i16((LAS v4i16_t*)p)); }
template <int WIN>
__device__ __forceinline__ void pool_unit_w(int pm, int g, const bf16* U, const bf16* GP, const bf16* WpT, const float* bp, const float* ps, bf16* CAT, LAS char* shm) {
    const int tid = threadIdx.x, lane = tid & 63, r32 = lane & 31, hi = lane >> 5; const int wid = __builtin_amdgcn_readfirstlane(tid >> 6);
    asm volatile("" : "+s"(pm), "+s"(g));
    const int t0 = pm * 256, tpos0 = t0 & (SEQ - 1);
    v4u tu[9], tw[4];
#pragma unroll
    for (int k = 0; k < 9; ++k) { const int c = tid + k * 512, row = c >> 4, ch = c & 15; tu[k] = (v4u){0u, 0u, 0u, 0u};
        if (c < UROWS * 16 && tpos0 - 16 + row >= 0) tu[k] = __builtin_nontemporal_load((const v4u*)(U + ((size_t)g * M + (t0 - 16 + row)) * 128 + ch * 8)); }
#pragma unroll
    for (int k = 0; k < 4; ++k) { const int c = tid + k * 512; tw[k] = *(const v4u*)(WpT + (size_t)g * 16384 + (size_t)c * 8); }
#pragma unroll
    for (int k = 0; k < 9; ++k) { const int c = tid + k * 512, row = c >> 4, ch = c & 15; if (c < UROWS * 16) *(LAS v4u*)(shm + row * UP + ch * 16) = tu[k]; }
#pragma unroll
    for (int k = 0; k < 4; ++k) { const int c = tid + k * 512, row = c >> 4, ch = c & 15; *(LAS v4u*)(shm + WOFF + row * UP + ch * 16) = tw[k]; }
    v4u gpre[2][4];
#pragma unroll
    for (int half = 0; half < 2; ++half)
#pragma unroll
        for (int k = 0; k < 4; ++k) gpre[half][k] = __builtin_nontemporal_load((const v4u*)(GP + ((size_t)g * M + t0 + wid * 32 + 8 * k + (lane >> 3)) * 128 + 64 * half + (lane & 7) * 8));
    __syncthreads();
    const int r = wid * 32 + r32, tpos = tpos0 + r;
    const float inv = 1.0f / (float)(tpos + 1 < WIN ? tpos + 1 : WIN);
    bf16x8 band[3];
#pragma unroll
    for (int ks = 0; ks < 3; ++ks)
#pragma unroll
        for (int j = 0; j < 8; ++j) { const int dlt = (r32 + 16) - (16 * ks + 8 * (j >> 2) + 4 * hi + (j & 3));
            band[ks][j] = (dlt >= 0 && dlt < WIN) ? (short)0x3F80 : (short)0; }
    LAS const char* ub = shm + (32 * wid + 4 * hi + ((lane & 15) >> 2)) * UP + (16 * ((lane >> 4) & 1) + 4 * (lane & 3)) * 2;
    LAS const char* urow = shm + (32 * wid + r32 + 16) * UP + 8 * hi;
    LAS const char* wl = shm + WOFF + r32 * UP + 8 * hi;
    f32x16 acc[4]; acc[0] = f32x16{}; acc[1] = f32x16{}; acc[2] = f32x16{}; acc[3] = f32x16{};
#pragma unroll 1
    for (int ct = 0; ct < 4; ++ct) {
        f32x16 X = f32x16{};
#pragma unroll
        for (int ks = 0; ks < 3; ++ks) {
            const s16x4 lo = vtr(ub + (16 * ks) * UP + ct * 64), hh = vtr(ub + (16 * ks + 8) * UP + ct * 64);
            const bf16x8 uf = (bf16x8){lo[0], lo[1], lo[2], lo[3], hh[0], hh[1], hh[2], hh[3]};
            X = __builtin_amdgcn_mfma_f32_32x32x16_bf16(uf, band[ks], X, 0, 0, 0);
        }
        unsigned pw[2][4];
#pragma unroll
        for (int i = 0; i < 4; ++i) { const v2u ut = *(LAS const v2u*)(urow + (32 * ct + 8 * i) * 2);
            pw[i >> 1][2 * (i & 1)] = pk2(X[4 * i] * inv - bf_lo(ut.x), X[4 * i + 1] * inv - bf_hi(ut.x));
            pw[i >> 1][2 * (i & 1) + 1] = pk2(X[4 * i + 2] * inv - bf_lo(ut.y), X[4 * i + 3] * inv - bf_hi(ut.y)); }
#pragma unroll
        for (int s2 = 0; s2 < 2; ++s2) { const int S = 2 * ct + s2;
            const v4u pv = (v4u){pw[s2][0], pw[s2][1], pw[s2][2], pw[s2][3]};
            const bf16x8 pfr = __builtin_bit_cast(bf16x8, pv);
#pragma unroll
            for (int n = 0; n < 4; ++n) { const v2u w0 = *(LAS const v2u*)(wl + n * 32 * UP + 32 * S), w1 = *(LAS const v2u*)(wl + n * 32 * UP + 32 * S + 16);
                const v4u wv = (v4u){w0.x, w0.y, w1.x, w1.y};
                acc[n] = __builtin_amdgcn_mfma_f32_32x32x16_bf16(__builtin_bit_cast(bf16x8, wv), pfr, acc[n], 0, 0, 0); }
        }
    }
    __syncthreads();
    {
        LAS char* st = shm + wid * 16384;
        const size_t tokw = (size_t)t0 + wid * 32;
        const int rr = lane >> 3, ch = lane & 7;
#pragma unroll
        for (int half = 0; half < 2; ++half) {
#pragma unroll
            for (int nn = 0; nn < 2; ++nn)
#pragma unroll
                for (int i = 0; i < 4; ++i) { const int n = 2 * half + nn;
                    *(LAS f32x4*)(st + r32 * 272 + (32 * nn + 8 * i + 4 * hi) * 4) = (f32x4){acc[n][4 * i], acc[n][4 * i + 1], acc[n][4 * i + 2], acc[n][4 * i + 3]}; }
            asm volatile("s_waitcnt lgkmcnt(0)" ::: "memory");
            const int col = g * 128 + 64 * half + ch * 8;
            const f32x4 b0 = *(const f32x4*)(bp + col), b1 = *(const f32x4*)(bp + col + 4), s0 = *(const f32x4*)(ps + col), s1 = *(const f32x4*)(ps + col + 4);
#pragma unroll
            for (int k = 0; k < 4; ++k) { const int row = 8 * k + rr;
                const f32x4 a0 = (*(LAS const f32x4*)(st + row * 272 + ch * 32) + b0) * s0, a1 = (*(LAS const f32x4*)(st + row * 272 + ch * 32 + 16) + b1) * s1;
                const v4u gv = gpre[half][k];
                v4u w; w.x = pk2(a0[0] * bf_lo(gv.x), a0[1] * bf_hi(gv.x)); w.y = pk2(a0[2] * bf_lo(gv.y), a0[3] * bf_hi(gv.y));
                w.z = pk2(a1[0] * bf_lo(gv.z), a1[1] * bf_hi(gv.z)); w.w = pk2(a1[2] * bf_lo(gv.w), a1[3] * bf_hi(gv.w));
                cat_store16(CAT, (tokw + row) * DM + 512 + col, w); }
            asm volatile("s_waitcnt lgkmcnt(0)" ::: "memory");
        }
    }
    asm volatile("s_waitcnt vmcnt(0)" ::: "memory");
    __syncthreads();
}
__device__ __forceinline__ void pool_unit(int pm, int g, const bf16* U, const bf16* GP, const bf16* WpT, const float* bp, const float* ps, bf16* CAT, LAS char* shm) {
    if (g == 0) pool_unit_w<2>(pm, g, U, GP, WpT, bp, ps, CAT, shm);
    else if (g == 1) pool_unit_w<4>(pm, g, U, GP, WpT, bp, ps, CAT, shm);
    else if (g == 2) pool_unit_w<8>(pm, g, U, GP, WpT, bp, ps, CAT, shm);
    else pool_unit_w<16>(pm, g, U, GP, WpT, bp, ps, CAT, shm);
}
}

__device__ __forceinline__ float wave_sum(float v) {
#pragma unroll
    for (int o = 1; o < 64; o <<= 1) v += __shfl_xor(v, o);
    return v;
}
struct TrItem { const float* W; bf16* WT; int K, N, item; bool permn; };
__device__ __forceinline__ void tr_load(const TrItem& t, float (&v)[32], int lane) {
    const int nblk = t.N / 32, kb = t.item / nblk, nb = t.item % nblk, k0 = 64 * kb, n0 = 32 * nb;
#pragma unroll
    for (int i = 0; i < 32; ++i) { const int kk = 2 * i + (lane >> 5); v[i] = t.W[(size_t)(k0 + kk) * t.N + n0 + (lane & 31)]; }
}
__device__ __forceinline__ void tr_finish(const TrItem& t, const float (&v)[32], LAS float* scr, int lane) {
    const int nblk = t.N / 32, kb = t.item / nblk, nb = t.item % nblk, k0 = 64 * kb, n0 = 32 * nb;
#pragma unroll
    for (int i = 0; i < 32; ++i) { const int kk = 2 * i + (lane >> 5); scr[kk * 33 + (lane & 31)] = v[i]; }
    LDS_WAIT(); asm volatile("" ::: "memory");
    const int c = lane & 7;
#pragma unroll
    for (int j = 0; j < 4; ++j) { const int n = (lane >> 3) + 8 * j; const LAS float* s = scr + (8 * c) * 33 + n;
        v4u o; o.x = pk2(s[0 * 33], s[1 * 33]); o.y = pk2(s[2 * 33], s[3 * 33]); o.z = pk2(s[4 * 33], s[5 * 33]); o.w = pk2(s[6 * 33], s[7 * 33]);
        int na = n0 + n;
        if (t.permn) na = (na & ~255) + 128 * ((na >> 5) & 1) + 32 * ((na >> 6) & 3) + (na & 31);
        *(GAS v4u*)(t.WT + (size_t)na * t.K + k0 + 8 * c) = o; }
    LDS_WAIT(); asm volatile("" ::: "memory");
}

struct Args { const float* in[12]; float* out; unsigned char* ws; int ph_lo, ph_hi; int coop, pad; };
constexpr int N_PHASES = 5;

__global__ void __launch_bounds__(NWAVES * 64, 2) hybrid_fwd(Args args) {
    extern __shared__ __attribute__((aligned(16))) unsigned char lds[];
    LAS unsigned char* L = (LAS unsigned char*)lds;
    const int tid = threadIdx.x, lane = tid & 63, wave = __builtin_amdgcn_readfirstlane(tid >> 6);
    const int G = gridDim.x, bx = blockIdx.x;
    const int vcu = (G % 8 == 0) ? (bx % 8) * (G / 8) + bx / 8 : bx;
    const float* x = args.in[0]; const float* c = args.in[1]; const float* w_ada = args.in[2]; const float* b_ada = args.in[3]; const float* norm_g = args.in[4];
    const float* w_in = args.in[5]; const float* qg = args.in[6]; const float* kg = args.in[7]; const float* w_pool = args.in[8]; const float* b_pool = args.in[9];
    const float* pool_scale = args.in[10]; const float* w_out = args.in[11];
    unsigned char* ws = args.ws;
    float* mod = (float*)(ws + WS_MOD);
    bf16* Win_t = (bf16*)(ws + WS_WIN); bf16* Wout_t = (bf16*)(ws + WS_WOUT); bf16* WpT = (bf16*)(ws + WS_WPOOL);
    bf16* XN = (bf16*)(ws + WS_XN); bf16* PROJ = (bf16*)(ws + WS_PROJ); bf16* CAT = (bf16*)(ws + WS_CAT);
    const int lo = args.ph_lo, hi = args.ph_hi;
#define IN(k) (lo <= (k) && (k) < hi)
#define BOTH(k) (IN(k) && IN((k) + 1))
#if MK_COOP
    if (tid < 32) ((LAS unsigned*)(L + MISC_OFF))[tid] = 0u;
    __syncthreads();
    XcdBarrier bar = xcd_barrier_post((unsigned*)(ws + WS_CTL) + CW_BAR, (volatile LAS unsigned*)(L + MISC_OFF) + 8);
#define GRID_BAR() do { if (args.coop == 2) cg::this_grid().sync(); else xcd_barrier(bar); } while (0)
#else
#define GRID_BAR() do { } while (0)
#endif
    const int gw = vcu * NWAVES + wave, NGW = G * NWAVES;
    unsigned* ctl = (unsigned*)(ws + WS_CTL); constexpr int CW_SEAM_B = 12288;
    const bool pseamB = MK_SEAMB && MK_COOP && G == 256 && lo == 0 && hi == N_PHASES && MK_STAMP < 0 && MK_REP3 == 1;
    constexpr int CW_SEAM_A = 8192;
    const bool pseamA = pseamB && MK_REP1 == 1;
    pg8::Unit u2; u2.pm = 0; u2.pn = 0; if (pseamA) { pg8::StaticOrder S2; S2.init(M, DIN, G, bx); S2.next(0, u2); }
#define PANEL_ARRIVE(p_) do { if (pseamB && tid == 0) __hip_atomic_fetch_add(ctl + CW_SEAM_B + 64 * (p_), 1u, __ATOMIC_RELAXED, __HIP_MEMORY_SCOPE_AGENT); } while (0)
#if MK_STAMP >= 0
    unsigned long long ts_[8]; ts_[0] = __builtin_amdgcn_s_memrealtime();
#define STAMP(k) do { ts_[k] = __builtin_amdgcn_s_memrealtime(); } while (0)
    unsigned long long tsub_[4] = {0, 0, 0, 0}; unsigned long long tk2_ = 0, tk2e_ = 0;
#define SUBSTAMP(k) do { tsub_[k] = __builtin_amdgcn_s_memrealtime(); } while (0)
#else
#define STAMP(k) do { } while (0)
#define SUBSTAMP(k) do { } while (0)
#endif

    const bool fuse01 = false;
    f32x4 xr_[8][4]; float xs_[8];
    if (fuse01) {
#pragma unroll
        for (int q = 0; q < 8; ++q) { const GAS f32x4* xp = (const GAS f32x4*)(x + (size_t)(gw + q * NGW) * DM) + lane;
#pragma unroll
            for (int j = 0; j < 4; ++j) xr_[q][j] = xp[64 * j]; }
    }
    if (IN(0)) { for (int rep_ = 0; rep_ < MK_REP0; ++rep_) {
        LAS float* cact = (LAS float*)L;
        LAS float* red = (LAS float*)(L + 32768);
        LAS float* scr = (LAS float*)(L + 40960 + wave * 8448);
        constexpr int I_IN = (DM / 64) * (DIN / 32), I_OUT = (DM / 64) * (DM / 32), I_P = 4 * (128 / 64) * (128 / 32), I_ALL = I_IN + I_OUT + I_P;
        auto mk_item = [&](int it) { TrItem t; int r = it;
            if (r < I_IN) { t.W = w_in; t.WT = Win_t; t.K = DM; t.N = DIN; t.item = r; t.permn = true; return t; } r -= I_IN;
            if (r < I_OUT) { t.W = w_out; t.WT = Wout_t; t.K = DM; t.N = DM; t.item = r; t.permn = false; return t; } r -= I_OUT;
            const int g = r >> 3; t.W = w_pool + (size_t)g * 16384; t.WT = WpT + (size_t)g * 16384; t.K = 128; t.N = 128; t.item = r & 7; t.permn = false; return t; };
        const int kq = tid >> 2, cq = tid & 3, cgp0 = bx < 256 ? bx : 0;
        float cv[16], wv[8][3], tv[32]; const int it0 = gw; const TrItem ti0 = mk_item(it0 < I_ALL ? it0 : 0);
#pragma unroll
        for (int i = 0; i < 16; ++i) cv[i] = c[tid + i * 512];
#pragma unroll
        for (int kk = 0; kk < 8; ++kk) { const float* wr = w_ada + (size_t)(kq * 8 + kk) * DIN + cgp0 * 12 + cq * 3; wv[kk][0] = wr[0]; wv[kk][1] = wr[1]; wv[kk][2] = wr[2]; }
        const float bias0 = (tid < 96) ? b_ada[cgp0 * 12 + tid % 12] : 0.f;
        if (it0 < I_ALL) tr_load(ti0, tv, lane);
#pragma unroll
        for (int i = 0; i < 16; ++i) { const float v = cv[i]; cact[tid + i * 512] = v / (1.0f + __expf(-v)); }
        __syncthreads();
        for (int cgp = bx; cgp < 256; cgp += G) {
            float a[8][3];
#pragma unroll
            for (int b = 0; b < 8; ++b) { a[b][0] = 0.f; a[b][1] = 0.f; a[b][2] = 0.f; }
            if (cgp != cgp0) {
#pragma unroll
                for (int kk = 0; kk < 8; ++kk) { const float* wr = w_ada + (size_t)(kq * 8 + kk) * DIN + cgp * 12 + cq * 3; wv[kk][0] = wr[0]; wv[kk][1] = wr[1]; wv[kk][2] = wr[2]; } }
#pragma unroll
            for (int kk = 0; kk < 8; ++kk) { const int k = kq * 8 + kk;
#pragma unroll
                for (int b = 0; b < 8; ++b) { const float ca = cact[b * DM + k]; a[b][0] += ca * wv[kk][0]; a[b][1] += ca * wv[kk][1]; a[b][2] += ca * wv[kk][2]; } }
            float v24[24];
#pragma unroll
            for (int b = 0; b < 8; ++b)
#pragma unroll
                for (int j = 0; j < 3; ++j) v24[b * 3 + j] = a[b][j];
#pragma unroll
            for (int i = 0; i < 12; ++i) { const bool up = (lane & 32) != 0; const float keep = up ? v24[i + 12] : v24[i], give = up ? v24[i] : v24[i + 12]; v24[i] = keep + __shfl_xor(give, 32); }
#pragma unroll
            for (int i = 0; i < 6; ++i) { const bool up = (lane & 16) != 0; const float keep = up ? v24[i + 6] : v24[i], give = up ? v24[i] : v24[i + 6]; v24[i] = keep + __shfl_xor(give, 16); }
#pragma unroll
            for (int i = 0; i < 3; ++i) { const bool up = (lane & 8) != 0; const float keep = up ? v24[i + 3] : v24[i], give = up ? v24[i] : v24[i + 3]; v24[i] = keep + __shfl_xor(give, 8); }
#pragma unroll
            for (int i = 0; i < 3; ++i) { v24[i] += __shfl_xor(v24[i], 4);
                const int idx = 12 * ((lane >> 5) & 1) + 6 * ((lane >> 4) & 1) + 3 * ((lane >> 3) & 1) + i;
                if ((lane & 4) == 0) red[wave * 96 + (idx / 3) * 12 + cq * 3 + (idx % 3)] = v24[i]; }
            __syncthreads();
            if (tid < 96) { float s = 0.f;
#pragma unroll
                for (int w = 0; w < 8; ++w) s += red[w * 96 + tid];
                const int b = tid / 12, n = cgp * 12 + tid % 12; mod[b * DIN + n] = s + (cgp == cgp0 ? bias0 : b_ada[n]); }
            __syncthreads();
        }
        if (it0 < I_ALL) tr_finish(ti0, tv, scr, lane);
        for (int it = gw + NGW; it < I_ALL; it += NGW) { float tv[32]; const TrItem ti = mk_item(it); tr_load(ti, tv, lane); tr_finish(ti, tv, scr, lane); }
        __syncthreads(); }
        if (BOTH(0)) GRID_BAR();
        STAMP(1);
    }
    if (IN(1) && fuse01) {
#pragma unroll
        for (int q = 0; q < 8; ++q) { float t = 0.f;
#pragma unroll
            for (int j = 0; j < 4; ++j) t += (xr_[q][j].x * xr_[q][j].x + xr_[q][j].y * xr_[q][j].y) + (xr_[q][j].z * xr_[q][j].z + xr_[q][j].w * xr_[q][j].w);
            xs_[q] = t; }
#pragma unroll
        for (int q = 0; q < 8; ++q) { const int m = gw + q * NGW;
            const float* mb = mod + (size_t)(m >> 11) * DIN;
            const float inv = 1.0f / sqrtf(wave_sum(xs_[q]) * (1.0f / DM) + 1e-6f);
            GAS unsigned long long* o8 = (GAS unsigned long long*)(XN + (size_t)m * DM) + lane;
#pragma unroll
            for (int j = 0; j < 4; ++j) { const int k = 4 * lane + 256 * j;
                const f32x4 gg = *(const f32x4*)(norm_g + k), sh = *(const f32x4*)(mb + k), sc = *(const f32x4*)(mb + DM + k);
                const f32x4 y = xr_[q][j] * inv * gg * (sc + 1.0f) + sh;
                o8[64 * j] = (unsigned long long)pk2(y.x, y.y) | ((unsigned long long)pk2(y.z, y.w) << 32); } }
        if (BOTH(1)) GRID_BAR();
        STAMP(2);
    } else
    if (IN(1)) { for (int rep_ = 0; rep_ < MK_REP1; ++rep_) {
        if (pseamA) {
            const int mb0 = 256 * u2.pm + 64 * u2.pn + 8 * wave; const float* mb = mod + (size_t)(mb0 >> 11) * DIN;
            f32x4 v[8][4], ga[4], sh4[4];
#pragma unroll
            for (int q = 0; q < 8; ++q) { const GAS f32x4* xr = (const GAS f32x4*)(x + (size_t)(mb0 + q) * DM) + lane;
#pragma unroll
                for (int j = 0; j < 4; ++j) v[q][j] = __builtin_nontemporal_load(xr + 64 * j); }
#pragma unroll
            for (int j = 0; j < 4; ++j) { const int k = 4 * lane + 256 * j; ga[j] = *(const f32x4*)(norm_g + k) * (*(const f32x4*)(mb + DM + k) + 1.0f); sh4[j] = *(const f32x4*)(mb + k); }
#pragma unroll
            for (int q = 0; q < 8; ++q) { float t = 0.f;
#pragma unroll
                for (int j = 0; j < 4; ++j) t += (v[q][j].x * v[q][j].x + v[q][j].y * v[q][j].y) + (v[q][j].z * v[q][j].z + v[q][j].w * v[q][j].w);
                const float inv = 1.0f / sqrtf(wave_sum(t) * (1.0f / DM) + 1e-6f);
                GAS unsigned long long* o8 = (GAS unsigned long long*)(XN + (size_t)(mb0 + q) * DM) + lane;
#pragma unroll
                for (int j = 0; j < 4; ++j) { const f32x4 y = v[q][j] * inv * ga[j] + sh4[j];
                    __hip_atomic_store(o8 + 64 * j, (unsigned long long)pk2(y.x, y.y) | ((unsigned long long)pk2(y.z, y.w) << 32), __ATOMIC_RELAXED, __HIP_MEMORY_SCOPE_AGENT); } }
        }
        const int mfirst = pseamA ? M : gw, mstep = NGW, mend = M;
        for (int m0 = mfirst; m0 < mend; m0 += 4 * mstep) {
            f32x4 v[4][4]; float s[4];
#pragma unroll
            for (int q = 0; q < 4; ++q) { const int m = m0 + q * mstep; const GAS f32x4* xr = (const GAS f32x4*)(x + (size_t)(m < M ? m : m0) * DM) + lane;
#pragma unroll
                for (int j = 0; j < 4; ++j) v[q][j] = xr[64 * j]; }
#pragma unroll
            for (int q = 0; q < 4; ++q) { float t = 0.f;
#pragma unroll
                for (int j = 0; j < 4; ++j) t += (v[q][j].x * v[q][j].x + v[q][j].y * v[q][j].y) + (v[q][j].z * v[q][j].z + v[q][j].w * v[q][j].w);
                s[q] = t; }
#pragma unroll
            for (int q = 0; q < 4; ++q) { const int m = m0 + q * mstep; if (m >= M) break;
                const float* mb = mod + (size_t)(m >> 11) * DIN;
                const float inv = 1.0f / sqrtf(wave_sum(s[q]) * (1.0f / DM) + 1e-6f);
                GAS unsigned long long* o8 = (GAS unsigned long long*)(XN + (size_t)m * DM) + lane;
#pragma unroll
                for (int j = 0; j < 4; ++j) { const int k = 4 * lane + 256 * j;
                    const f32x4 gg = *(const f32x4*)(norm_g + k), sh = *(const f32x4*)(mb + k), sc = *(const f32x4*)(mb + DM + k);
                    const f32x4 y = v[q][j] * inv * gg * (sc + 1.0f) + sh;
                    const unsigned long long pk8 = (unsigned long long)pk2(y.x, y.y) | ((unsigned long long)pk2(y.z, y.w) << 32);
                    if (pseamA) __hip_atomic_store(o8 + 64 * j, pk8, __ATOMIC_RELAXED, __HIP_MEMORY_SCOPE_AGENT); else o8[64 * j] = pk8; } }
        }
        }
        if (pseamA) {
            asm volatile("s_waitcnt vmcnt(0)" ::: "memory");
            __syncthreads();
            if (tid == 0) { unsigned* cnt = ctl + CW_SEAM_A + 64 * u2.pm;
                __hip_atomic_fetch_add(cnt, 1u, __ATOMIC_RELAXED, __HIP_MEMORY_SCOPE_AGENT);
                while (__hip_atomic_load(cnt, __ATOMIC_RELAXED, __HIP_MEMORY_SCOPE_AGENT) < 4u) __builtin_amdgcn_s_sleep(1);
                __builtin_amdgcn_fence(__ATOMIC_ACQUIRE, "agent"); asm volatile("s_waitcnt vmcnt(0)" ::: "memory"); }
            __syncthreads();
        } else if (BOTH(1)) GRID_BAR();
        STAMP(2);
    }
    if (IN(2)) { for (int rep_ = 0; rep_ < MK_REP2; ++rep_) {
        pg8::Gemm g{XN, Win_t, M, DIN, DM}; pg8::StaticOrder S; S.init(M, DIN, G, bx);
        pg8::EpiInProj E{__builtin_amdgcn_make_buffer_rsrc(ws + WS_PROJ, 0, (int)(6 * PROJ_STRIDE * 2), 0x00020000), PROJ_STRIDE, qg, kg};
        pg8::gemm_phase<pg8::EpiInProj, pg8::StaticOrder, true, true>(L, g, S, E);
#if MK_STAMP == 22 || MK_STAMP == 23
        tk2_ = *(volatile LAS unsigned long long*)(L + 147392); tk2e_ = __builtin_amdgcn_s_memrealtime();
#endif
        }
        if (pseamB) {
            __syncthreads();
            if (tid == 0) { unsigned* cnt = ctl + 6144 + 64 * (bx & 7);
                __hip_atomic_fetch_add(cnt, 1u, __ATOMIC_RELAXED, __HIP_MEMORY_SCOPE_AGENT);
                while (__hip_atomic_load(cnt, __ATOMIC_RELAXED, __HIP_MEMORY_SCOPE_AGENT) < 32u) __builtin_amdgcn_s_sleep(1);
                __builtin_amdgcn_fence(__ATOMIC_ACQUIRE, "agent"); asm volatile("s_waitcnt vmcnt(0)" ::: "memory"); }
            __syncthreads();
        } else if (BOTH(2)) GRID_BAR();
        STAMP(3);
    }
    if (IN(3)) { for (int rep_ = 0; rep_ < MK_REP3; ++rep_) {
        const bf16* Qb = PROJ; const bf16* Kb = PROJ + PROJ_STRIDE; const bf16* Vb = PROJ + 2 * PROJ_STRIDE; const bf16* GAb = PROJ + 3 * PROJ_STRIDE;
        const bf16* Ub = PROJ + 4 * PROJ_STRIDE; const bf16* GPb = PROJ + 5 * PROJ_STRIDE;
        for (int i = vcu; i < 256; i += G) {
            const int bh = i >> 2, qq = i & 3;
            if (i & 1) { pool::pool_unit(i >> 2, i & 3, Ub, GPb, WpT, b_pool, pool_scale, CAT, (LAS char*)L); PANEL_ARRIVE(i >> 2); }
            SUBSTAMP(0);
            att::attn_pass<MK_EARLY>(bh >> 3, bh & 7, 16 * qq + 8, Qb, Kb, Vb, GAb, CAT, (LAS char*)L);
            PANEL_ARRIVE((bh >> 3) * 8 + 2 * qq + 1);
            SUBSTAMP(1);
            att::attn_pass<MK_EARLY>(bh >> 3, bh & 7, 16 * qq, Qb, Kb, Vb, GAb, CAT, (LAS char*)L);
            PANEL_ARRIVE((bh >> 3) * 8 + 2 * qq);
            VM_WAIT(); __syncthreads();
            SUBSTAMP(2);
            if (!(i & 1)) { pool::pool_unit(i >> 2, i & 3, Ub, GPb, WpT, b_pool, pool_scale, CAT, (LAS char*)L); PANEL_ARRIVE(i >> 2); }
            VM_WAIT(); SUBSTAMP(3);
        }
        }
        if (!pseamB && BOTH(3)) GRID_BAR();
        STAMP(4);
    }
    if (IN(4)) { for (int rep_ = 0; rep_ < MK_REP4; ++rep_) {
        pg8::Gemm g{CAT, Wout_t, M, DM, DM}; pg8::StaticOrder S; S.init(M, DM, G, bx);
        if (pseamB) { pg8::Unit u4; S.next(0, u4);
            if (tid == 0) { unsigned* cnt = ctl + CW_SEAM_B + 64 * u4.pm;
                while (__hip_atomic_load(cnt, __ATOMIC_RELAXED, __HIP_MEMORY_SCOPE_AGENT) < 12u) __builtin_amdgcn_s_sleep(1);
                __builtin_amdgcn_fence(__ATOMIC_ACQUIRE, "agent"); asm volatile("s_waitcnt vmcnt(0)" ::: "memory"); }
            __syncthreads(); }
        pg8::EpiOutRes E{x, args.out, mod + 2 * DM};
        pg8::gemm_phase<pg8::EpiOutRes, pg8::StaticOrder, true, true>(L, g, S, E);
    } }
#if MK_STAMP >= 0
    GRID_BAR(); STAMP(5);
#if MK_STAMP == 22 || MK_STAMP == 23
    if (bx == 0 && tid == 0) args.out[0] += (MK_STAMP == 22) ? (float)(tk2e_ - tk2_) * 0.01f : (float)(ts_[3] - tk2e_) * 0.01f;
    if (false)
#endif
#if MK_STAMP == 20 || MK_STAMP == 21
    if (bx == 0 && tid == 0) { const unsigned long long tk = *(volatile LAS unsigned long long*)(L + 147392);
        args.out[0] += (MK_STAMP == 20) ? (float)(tk - ts_[4]) * 0.01f : (float)(ts_[5] - tk) * 0.01f; }
    if (false)
#endif
    if (bx == 0 && tid == 0) { const float T = (MK_STAMP >= 10) ? (float)((MK_STAMP == 13 ? ts_[4] : tsub_[(MK_STAMP - 9) & 3]) - tsub_[(MK_STAMP - 10) & 3]) * 0.01f : (float)(ts_[(MK_STAMP + 1) & 7] - ts_[MK_STAMP & 7]) * 0.01f; args.out[0] += (MK_STAMP == 5 ? (float)(ts_[5] - ts_[0]) * 0.01f : T); }
#endif
#undef IN
#undef BOTH
}

extern "C" void kernel_launch(void* const* d_in, const int* in_sizes, int n_in, void* d_out, int out_size, void* d_ws, size_t ws_size, hipStream_t stream) {
    static int grid = 0;
    if (grid == 0) {
        if (n_in != 12 || out_size != M * DM || ws_size < WS_END) { fprintf(stderr, "kernel_launch: unexpected shapes (n_in %d out %d ws %zu)\n", n_in, out_size, ws_size); grid = -1; return; }
        int dev = 0, cus = 0, per_cu = 0;
        if (hipGetDevice(&dev) != hipSuccess || hipDeviceGetAttribute(&cus, hipDeviceAttributeMultiprocessorCount, dev) != hipSuccess) { grid = -1; return; }
        if (hipFuncSetAttribute((const void*)hybrid_fwd, hipFuncAttributeMaxDynamicSharedMemorySize, LDS_BYTES) != hipSuccess) { fprintf(stderr, "kernel_launch: hipFuncSetAttribute failed\n"); grid = -1; return; }
        if (hipOccupancyMaxActiveBlocksPerMultiprocessor(&per_cu, (const void*)hybrid_fwd, NWAVES * 64, LDS_BYTES) != hipSuccess || per_cu < 1) { fprintf(stderr, "kernel_launch: occupancy query says %d\n", per_cu); per_cu = 1; }
        (void)hipGetLastError();
        grid = cus;
    }
    if (grid < 0) return;
#if MK_COOP
    if (hipMemsetAsync((char*)d_ws + WS_CTL, 0, CTL_ZERO_BYTES, stream) != hipSuccess) { fprintf(stderr, "kernel_launch: hipMemsetAsync failed\n"); return; }
#endif
    Args a{};
    for (int i = 0; i < 12; ++i) a.in[i] = (const float*)d_in[i];
    a.out = (float*)d_out; a.ws = (unsigned char*)d_ws;
#if MK_COOP
    a.ph_lo = 0; a.ph_hi = N_PHASES; a.coop = 1;
    void* kargs[] = {&a};
    hipError_t e = hipLaunchCooperativeKernel((const void*)hybrid_fwd, dim3(grid), dim3(NWAVES * 64), kargs, LDS_BYTES, stream);
    if (e != hipSuccess) fprintf(stderr, "kernel_launch: cooperative launch failed: %s (grid %d)\n", hipGetErrorString(e), grid);
#else
    for (int p = 0; p < N_PHASES; ++p) { a.ph_lo = p; a.ph_hi = p + 1; a.coop = 0;
        hipLaunchKernelGGL(hybrid_fwd, dim3(grid), dim3(NWAVES * 64), LDS_BYTES, stream, a); }
#endif
}
```
